# Optimizing an MI355X kernel written in HIP

```python
import math
import jax
import jax.numpy as jnp
from jax import lax
import numpy as np

D_MODEL = 1024
BATCH = 8
SEQ = 4096
DEPTH = 2

HEAD_DIM = 64
D_MIX = D_MODEL
N_HEADS_TOTAL = D_MIX // HEAD_DIM
N_HEADS_SB = N_HEADS_TOTAL // 4
N_HEADS_FOX = N_HEADS_TOTAL // 4
N_HEADS_NSA = N_HEADS_TOTAL - N_HEADS_SB - N_HEADS_FOX
NSA_KV_GROUPS = 2
NSA_HPG = N_HEADS_NSA // NSA_KV_GROUPS
D_SB = N_HEADS_SB * HEAD_DIM
D_FOX = N_HEADS_FOX * HEAD_DIM
D_NSA = N_HEADS_NSA * HEAD_DIM
D_NSA_KV = NSA_KV_GROUPS * HEAD_DIM
CMP_BLOCK = 32
CMP_STRIDE = 16
CMP_HIDDEN = 256
SLC_BLOCK = 64
SLC_TOP = 16
WINDOW = 512
NSA_QBLOCK = 32
ATTN_QBLOCK = 128
REL_BUCKETS = 32
REL_MAX_DIST = 128
FORCE_SCORE = 1e4
RMS_EPS = 1e-6
IN_WIDTH = 4 * D_SB + 2 * D_NSA + 6 * D_NSA_KV + 3 * N_HEADS_NSA + 4 * D_FOX + N_HEADS_FOX

kernel_name = 'hybrid_sb_nsa_fox_parallel_heads'


def _rmsnorm(x, g):
    xf = x.astype(jnp.float32)
    y = xf * lax.rsqrt(jnp.mean(xf * xf, axis=-1, keepdims=True) + RMS_EPS)
    return (y * g.astype(jnp.float32)).astype(x.dtype)


def _heads(x, n):
    b, t, _ = x.shape
    return x.reshape(b, t, n, HEAD_DIM).transpose(0, 2, 1, 3)


def _merge(o):
    b, n, t, d = o.shape
    return o.transpose(0, 2, 1, 3).reshape(b, t, n * d)


def _split_proj(proj):
    widths = [D_SB, D_SB, D_SB, D_SB,
              D_NSA, D_NSA_KV, D_NSA_KV, D_NSA_KV, D_NSA_KV, D_NSA_KV, D_NSA_KV, 3 * N_HEADS_NSA, D_NSA,
              D_FOX, D_FOX, D_FOX, N_HEADS_FOX, D_FOX]
    idx, acc = [], 0
    for w in widths[:-1]:
        acc += w
        idx.append(acc)
    return jnp.split(proj, idx, axis=-1)


def _rel_bucket(dist):
    n = jnp.maximum(dist, 0)
    max_exact = REL_BUCKETS // 2
    nf = jnp.maximum(n, 1).astype(jnp.float32)
    large = max_exact + (jnp.log(nf / max_exact) / math.log(REL_MAX_DIST / max_exact)
                         * (REL_BUCKETS - max_exact)).astype(jnp.int32)
    large = jnp.minimum(large, REL_BUCKETS - 1)
    return jnp.where(n < max_exact, n, large)


def _masked_softmax(s, mask):
    p = jax.nn.softmax(jnp.where(mask, s, -1e30), axis=-1)
    return jnp.where(mask, p, 0.0)


def _stick_breaking(q, k, v):
    b, h, t, d = q.shape
    scale = d ** -0.5
    kpos = jnp.arange(t)

    def block(i):
        t0 = i * ATTN_QBLOCK
        qb = lax.dynamic_slice_in_dim(q, t0, ATTN_QBLOCK, axis=2)
        z = jnp.einsum('bhqd,bhkd->bhqk', qb, k).astype(jnp.float32) * scale
        qpos = t0 + jnp.arange(ATTN_QBLOCK)
        mask = kpos[None, :] < qpos[:, None]
        log1m = jnp.where(mask, -jax.nn.softplus(z), 0.0)
        cs = lax.cumsum(log1m, axis=3)
        log_w = jax.nn.log_sigmoid(z) + cs[..., -1:] - cs
        w = jnp.where(mask, jnp.exp(log_w), 0.0)
        return jnp.einsum('bhqk,bhkd->bhqd', w.astype(v.dtype), v)

    o = lax.map(block, jnp.arange(t // ATTN_QBLOCK))
    return o.transpose(1, 2, 0, 3, 4).reshape(b, h, t, d)


def _forgetting_attention(q, k, v, log_f):
    b, h, t, d = q.shape
    scale = d ** -0.5
    c = lax.cumsum(log_f, axis=2)
    kpos = jnp.arange(t)

    def block(i):
        t0 = i * ATTN_QBLOCK
        qb = lax.dynamic_slice_in_dim(q, t0, ATTN_QBLOCK, axis=2)
        cq = lax.dynamic_slice_in_dim(c, t0, ATTN_QBLOCK, axis=2)
        s = (jnp.einsum('bhqd,bhkd->bhqk', qb, k).astype(jnp.float32) * scale
             + cq[..., :, None] - c[..., None, :])
        qpos = t0 + jnp.arange(ATTN_QBLOCK)
        s = jnp.where(kpos[None, :] <= qpos[:, None], s, -jnp.inf)
        p = jax.nn.softmax(s, axis=-1)
        return jnp.einsum('bhqk,bhkd->bhqd', p.astype(v.dtype), v)

    o = lax.map(block, jnp.arange(t // ATTN_QBLOCK))
    return o.transpose(1, 2, 0, 3, 4).reshape(b, h, t, d)


def _compress(x, w1, b1, w2, pe):
    b, g, t, d = x.shape
    halves = x.reshape(b, g, t // CMP_STRIDE, CMP_STRIDE * d)
    w1a, w1b = w1[:CMP_STRIDE * d], w1[CMP_STRIDE * d:]
    h = halves[:, :, :-1] @ w1a + halves[:, :, 1:] @ w1b + (pe.reshape(-1) @ w1 + b1)
    return jax.nn.silu(h) @ w2


def _nsa(q, kc, vc, ks, vs, kw, vw, gate_logits, rel_table, w1, b1, w2, pe):
    b, hb, t, d = q.shape
    G, HPG = NSA_KV_GROUPS, NSA_HPG
    dt = q.dtype
    scale = d ** -0.5
    qg = q.reshape(b, G, HPG, t, d)
    k_cmp = _compress(kc, w1[0], b1[0], w2[0], pe[0])
    v_cmp = _compress(vc, w1[1], b1[1], w2[1], pe[1])
    n_cmp = k_cmp.shape[2]
    cmp_end = jnp.arange(n_cmp) * CMP_STRIDE + CMP_BLOCK - 1
    cmp_start = cmp_end - (CMP_BLOCK - 1)
    n_slc = t // SLC_BLOCK
    n_top = min(SLC_TOP, n_slc)
    slc_start = jnp.arange(n_slc) * SLC_BLOCK
    overlap = jnp.clip(jnp.minimum(cmp_end[:, None], slc_start[None, :] + SLC_BLOCK - 1)
                       - jnp.maximum(cmp_start[:, None], slc_start[None, :]) + 1, 0, None
                       ).astype(jnp.float32) / CMP_BLOCK
    ks_blk = ks.reshape(b, G, n_slc, SLC_BLOCK, d)
    vs_blk = vs.reshape(b, G, n_slc, SLC_BLOCK, d)
    kw_pad = jnp.pad(kw, ((0, 0), (0, 0), (WINDOW, 0), (0, 0)))
    vw_pad = jnp.pad(vw, ((0, 0), (0, 0), (WINDOW, 0), (0, 0)))
    table = rel_table.reshape(REL_BUCKETS, G, HPG)
    bi = jnp.arange(b)[:, None, None, None]
    gi = jnp.arange(G)[None, :, None, None]
    win_off = jnp.arange(WINDOW + NSA_QBLOCK) - WINDOW
    tok_in_blk = jnp.arange(SLC_BLOCK)
    blk_ids = jnp.arange(n_slc)

    def bias_2d(dist):
        return table[_rel_bucket(dist)].transpose(2, 3, 0, 1)

    def block(i):
        t0 = i * NSA_QBLOCK
        qpos = t0 + jnp.arange(NSA_QBLOCK)
        qb = lax.dynamic_slice_in_dim(qg, t0, NSA_QBLOCK, axis=3)
        s_c = (jnp.einsum('bghqd,bgcd->bghqc', qb, k_cmp).astype(jnp.float32) * scale
               + bias_2d(qpos[:, None] - cmp_end[None, :]))
        p_c = _masked_softmax(s_c, cmp_end[None, :] <= qpos[:, None])
        o_c = jnp.einsum('bghqc,bgcd->bghqd', p_c.astype(dt), v_cmp)
        imp = jnp.einsum('bghqc,cs->bgqs', p_c, overlap)
        cur = qpos // SLC_BLOCK
        forced = ((blk_ids[None, :] == 0) | (blk_ids[None, :] == cur[:, None])
                  | (blk_ids[None, :] == cur[:, None] - 1))
        future = slc_start[None, :] > qpos[:, None]
        imp = jnp.where(forced, FORCE_SCORE, imp)
        imp = jnp.where(future, -FORCE_SCORE, imp)
        _, idx = lax.top_k(imp, n_top)
        k_sel = ks_blk[bi, gi, idx].reshape(b, G, NSA_QBLOCK, n_top * SLC_BLOCK, d)
        v_sel = vs_blk[bi, gi, idx].reshape(b, G, NSA_QBLOCK, n_top * SLC_BLOCK, d)
        pos_sel = (idx[..., None] * SLC_BLOCK + tok_in_blk).reshape(b, G, NSA_QBLOCK, n_top * SLC_BLOCK)
        bias_sel = table[_rel_bucket(qpos[:, None] - pos_sel), gi].transpose(0, 1, 4, 2, 3)
        s_s = jnp.einsum('bghqd,bgqkd->bghqk', qb, k_sel).astype(jnp.float32) * scale + bias_sel
        p_s = _masked_softmax(s_s, (pos_sel <= qpos[:, None])[:, :, None])
        o_s = jnp.einsum('bghqk,bgqkd->bghqd', p_s.astype(dt), v_sel)
        kwb = lax.dynamic_slice_in_dim(kw_pad, t0, WINDOW + NSA_QBLOCK, axis=2)
        vwb = lax.dynamic_slice_in_dim(vw_pad, t0, WINDOW + NSA_QBLOCK, axis=2)
        pos_w = t0 + win_off
        dist_w = qpos[:, None] - pos_w[None, :]
        m_w = (pos_w[None, :] >= 0) & (dist_w >= 0) & (dist_w < WINDOW)
        s_w = jnp.einsum('bghqd,bgkd->bghqk', qb, kwb).astype(jnp.float32) * scale + bias_2d(dist_w)
        p_w = _masked_softmax(s_w, m_w)
        o_w = jnp.einsum('bghqk,bgkd->bghqd', p_w.astype(dt), vwb)
        return o_c, o_s, o_w

    o_c, o_s, o_w = lax.map(block, jnp.arange(t // NSA_QBLOCK))

    def to_btHd(o):
        return o.transpose(1, 0, 4, 2, 3, 5).reshape(b, t, hb, d)

    g = jax.nn.sigmoid(gate_logits).reshape(b, t, hb, 3)
    o = (g[..., 0:1] * to_btHd(o_c) + g[..., 1:2] * to_btHd(o_s) + g[..., 2:3] * to_btHd(o_w))
    return o.reshape(b, t, hb * d)


def setup_inputs(seed: int = 0) -> dict:
    key = jax.random.key(seed)
    ks = jax.random.split(key, 11)
    f32 = jnp.float32
    x = jax.random.normal(ks[0], (BATCH, SEQ, D_MODEL), f32)
    norm_g = 1.0 + 0.02 * jax.random.normal(ks[1], (DEPTH, D_MODEL), f32)
    w_in = jax.random.normal(ks[2], (DEPTH, D_MODEL, IN_WIDTH), f32) * D_MODEL ** -0.5
    w_out = jax.random.normal(ks[3], (DEPTH, D_MIX, D_MODEL), f32) * D_MIX ** -0.5
    forget_b = 2.0 + 0.5 * jax.random.normal(ks[4], (DEPTH, N_HEADS_FOX), f32)
    cmp_w1 = jax.random.normal(ks[5], (DEPTH, 2, CMP_BLOCK * HEAD_DIM, CMP_HIDDEN), f32) * (CMP_BLOCK * HEAD_DIM) ** -0.5
    cmp_b1 = 0.02 * jax.random.normal(ks[6], (DEPTH, 2, CMP_HIDDEN), f32)
    cmp_w2 = jax.random.normal(ks[7], (DEPTH, 2, CMP_HIDDEN, HEAD_DIM), f32) * CMP_HIDDEN ** -0.5
    cmp_pe = 0.1 * jax.random.normal(ks[8], (DEPTH, 2, CMP_BLOCK, HEAD_DIM), f32)
    rel_bias = 0.5 * jax.random.normal(ks[9], (REL_BUCKETS, N_HEADS_NSA), f32)
    final_g = 1.0 + 0.02 * jax.random.normal(ks[10], (D_MODEL,), f32)
    return {'x': x, 'norm_g': norm_g, 'w_in': w_in, 'w_out': w_out, 'forget_b': forget_b,
            'cmp_w1': cmp_w1, 'cmp_b1': cmp_b1, 'cmp_w2': cmp_w2, 'cmp_pe': cmp_pe,
            'rel_bias': rel_bias, 'final_g': final_g}


def reference(x, norm_g, w_in, w_out, forget_b, cmp_w1, cmp_b1, cmp_w2, cmp_pe, rel_bias, final_g):
    for l in range(DEPTH):
        h = _rmsnorm(x, norm_g[l])
        proj = h @ w_in[l]
        (qa, ka, va, za,
         qb, kc, vc, ksl, vsl, kwn, vwn, gb, zb,
         qc, kcf, vcf, fc, zc) = _split_proj(proj)
        o_a = _merge(_stick_breaking(_heads(qa, N_HEADS_SB), _heads(ka, N_HEADS_SB), _heads(va, N_HEADS_SB)))
        o_a = o_a * jax.nn.silu(za)
        o_b = _nsa(_heads(qb, N_HEADS_NSA), _heads(kc, NSA_KV_GROUPS), _heads(vc, NSA_KV_GROUPS),
                   _heads(ksl, NSA_KV_GROUPS), _heads(vsl, NSA_KV_GROUPS),
                   _heads(kwn, NSA_KV_GROUPS), _heads(vwn, NSA_KV_GROUPS),
                   gb, rel_bias, cmp_w1[l], cmp_b1[l], cmp_w2[l], cmp_pe[l])
        o_b = o_b * jax.nn.silu(zb)
        log_f = jax.nn.log_sigmoid((fc + forget_b[l]).astype(jnp.float32)).transpose(0, 2, 1)
        o_c = _merge(_forgetting_attention(_heads(qc, N_HEADS_FOX), _heads(kcf, N_HEADS_FOX),
                                           _heads(vcf, N_HEADS_FOX), log_f))
        o_c = o_c * jax.nn.silu(zc)
        mix = jnp.concatenate([o_a, o_b, o_c], axis=-1) @ w_out[l]
        x = x + mix
    return _rmsnorm(x, final_g)
```

```cpp
#include <hip/hip_runtime.h>
#include <hip/hip_cooperative_groups.h>
#include <cstdio>
#include <cstdint>
namespace cg = cooperative_groups;

constexpr int DM = 1024, BATCH = 8, SEQ = 4096, DEPTH = 2, HD = 64;
constexpr int INW = 3868;
constexpr int C_QA = 0, C_KA = 256, C_VA = 512, C_ZA = 768, C_QB = 1024, C_KC = 1536, C_VC = 1664, C_KSL = 1792, C_VSL = 1920,
              C_KWN = 2048, C_VWN = 2176, C_GB = 2304, C_ZB = 2328, C_QC = 2840, C_KCF = 3096, C_VCF = 3352, C_FC = 3608, C_ZC = 3612;
constexpr int CB = 2;
constexpr int CT = CB * SEQ;
constexpr int NCHUNK = BATCH / CB;
constexpr int NCMP = 255;
constexpr size_t MiB = 1u << 20;
constexpr size_t WS_PROJ = 0, WS_H = 128 * MiB, WS_CAT = 160 * MiB, WS_KCMP = 192 * MiB, WS_CFOX = 193 * MiB, WS_SEL = 194 * MiB, WS_OCMP = 196 * MiB;

__constant__ unsigned char c_bucket[128] = {0, 1, 2, 3, 4, 5, 6, 7, 8, 9, 10, 11, 12, 13, 14, 15, 16, 16, 16, 17, 17, 18, 18, 18, 19, 19, 19, 20, 20, 20, 20, 21, 21, 21, 21, 22, 22, 22, 22, 22, 23, 23, 23, 23, 23, 23, 24, 24, 24, 24, 24, 24, 25, 25, 25, 25, 25, 25, 25, 26, 26, 26, 26, 26, 26, 26, 26, 27, 27, 27, 27, 27, 27, 27, 27, 27, 27, 28, 28, 28, 28, 28, 28, 28, 28, 28, 28, 29, 29, 29, 29, 29, 29, 29, 29, 29, 29, 29, 29, 30, 30, 30, 30, 30, 30, 30, 30, 30, 30, 30, 30, 30, 30, 31, 31, 31, 31, 31, 31, 31, 31, 31, 31, 31, 31, 31, 31, 31};

struct Params {
    const float *x, *norm_g, *w_in, *w_out, *forget_b, *cmp_w1, *cmp_b1, *cmp_w2, *cmp_pe, *rel_bias, *final_g;
    float* out;
    unsigned char* ws;
};

__device__ __forceinline__ float wave_sum(float v) {
#pragma unroll
    for (int o = 32; o > 0; o >>= 1) v += __shfl_xor(v, o);
    return v;
}
__device__ __forceinline__ float wave_max(float v) {
#pragma unroll
    for (int o = 32; o > 0; o >>= 1) v = fmaxf(v, __shfl_xor(v, o));
    return v;
}
__device__ __forceinline__ float sigmoidf_(float v) { return 1.f / (1.f + expf(-v)); }
__device__ __forceinline__ float siluf_(float v) { return v / (1.f + expf(-v)); }
__device__ __forceinline__ float softplusf_(float z) { return fmaxf(z, 0.f) + log1pf(expf(-fabsf(z))); }
__device__ __forceinline__ int bucket_of(int dist) { return dist >= 128 ? 31 : (int)c_bucket[dist < 0 ? 0 : dist]; }

__device__ __forceinline__ float dot64(const float* qs, const float* krow) {
    float acc = 0.f;
#pragma unroll 4
    for (int i = 0; i < 16; ++i) {
        const float4 kv = *(const float4*)(krow + 4 * i);
        const float4 qv = *(const float4*)(qs + 4 * i);
        acc += kv.x * qv.x + kv.y * qv.y + kv.z * qv.z + kv.w * qv.w;
    }
    return acc;
}
__device__ __forceinline__ float pv64(float o, float pval, const float* vbase, size_t ld, int lane) {
#pragma unroll 4
    for (int k = 0; k < 64; ++k) {
        const float pk = __shfl(pval, k);
        o += pk * vbase[(size_t)k * ld + lane];
    }
    return o;
}

__device__ void phase_rmsnorm(const float* xin, const float* g, float* h, int rows, bool scale_only_out) {
    const int lane = threadIdx.x & 63, wv = threadIdx.x >> 6;
    const int gw = blockIdx.x * 4 + wv, ngw = gridDim.x * 4;
    for (int r = gw; r < rows; r += ngw) {
        const float4* xr = (const float4*)(xin + (size_t)r * DM);
        float4 v[4];
        float s = 0.f;
#pragma unroll
        for (int j = 0; j < 4; ++j) { v[j] = xr[lane + 64 * j]; s += v[j].x * v[j].x + v[j].y * v[j].y + v[j].z * v[j].z + v[j].w * v[j].w; }
        s = wave_sum(s);
        const float rs = rsqrtf(s * (1.f / DM) + 1e-6f);
        float4* hr = (float4*)(h + (size_t)r * DM);
#pragma unroll
        for (int j = 0; j < 4; ++j) {
            const float4 gg = ((const float4*)g)[lane + 64 * j];
            float4 o;
            o.x = v[j].x * rs * gg.x; o.y = v[j].y * rs * gg.y; o.z = v[j].z * rs * gg.z; o.w = v[j].w * rs * gg.w;
            hr[lane + 64 * j] = o;
        }
    }
}

__device__ void phase_gemm(const float* A, int lda, const float* B, int ldb, float* C, int ldc, const float* R, int ldr, int M, int N, int K, float* sm) {
    float(*As)[68] = (float(*)[68])sm;
    float(*Bs)[68] = (float(*)[68])(sm + 16 * 68);
    const int tid = threadIdx.x, tx = tid & 15, ty = tid >> 4;
    const int ntm = M / 64, ntn = (N + 63) / 64;
    for (int tile = blockIdx.x; tile < ntm * ntn; tile += gridDim.x) {
        const int tm = tile % ntm, tn = tile / ntm;
        const int row0 = tm * 64, col0 = tn * 64;
        float acc[4][4];
#pragma unroll
        for (int i = 0; i < 4; ++i)
#pragma unroll
            for (int j = 0; j < 4; ++j) acc[i][j] = 0.f;
        for (int k0 = 0; k0 < K; k0 += 16) {
            {
                const int r = tid >> 2, kq = (tid & 3) * 4;
                const float4 v = *(const float4*)(A + (size_t)(row0 + r) * lda + k0 + kq);
                As[kq][r] = v.x; As[kq + 1][r] = v.y; As[kq + 2][r] = v.z; As[kq + 3][r] = v.w;
            }
            {
                const int k = tid >> 4, nq = (tid & 15) * 4;
                const int c = col0 + nq;
                float4 v = make_float4(0.f, 0.f, 0.f, 0.f);
                if (c < N) v = *(const float4*)(B + (size_t)(k0 + k) * ldb + c);
                *(float4*)&Bs[k][nq] = v;
            }
            __syncthreads();
#pragma unroll 4
            for (int kk = 0; kk < 16; ++kk) {
                const float4 a = *(const float4*)&As[kk][ty * 4];
                const float4 b = *(const float4*)&Bs[kk][tx * 4];
                const float av[4] = {a.x, a.y, a.z, a.w}, bv[4] = {b.x, b.y, b.z, b.w};
#pragma unroll
                for (int i = 0; i < 4; ++i)
#pragma unroll
                    for (int j = 0; j < 4; ++j) acc[i][j] += av[i] * bv[j];
            }
            __syncthreads();
        }
        const int c = col0 + tx * 4;
        if (c < N) {
#pragma unroll
            for (int i = 0; i < 4; ++i) {
                const int r = row0 + ty * 4 + i;
                float4 o = make_float4(acc[i][0], acc[i][1], acc[i][2], acc[i][3]);
                if (R) { const float4 rv = *(const float4*)(R + (size_t)r * ldr + c); o.x += rv.x; o.y += rv.y; o.z += rv.z; o.w += rv.w; }
                *(float4*)(C + (size_t)r * ldc + c) = o;
            }
        }
    }
}

__device__ void phase_compress(const Params& p, int layer, const float* proj, float* kcmp, float* sm) {
    float* in = sm;
    float* hid = sm + 2048;
    float* red = sm + 2304;
    const int tid = threadIdx.x;
    const int nitems = 2 * CB * 2 * NCMP;
    for (int it = blockIdx.x; it < nitems; it += gridDim.x) {
        int r = it;
        const int j = r % NCMP; r /= NCMP;
        const int g = r % 2; r /= 2;
        const int b = r % CB; r /= CB;
        const int which = r;
        const int col = (which == 0 ? C_KC : C_VC) + g * 64;
        const float* pe = p.cmp_pe + ((size_t)(layer * 2 + which)) * 32 * 64;
        const float* w1 = p.cmp_w1 + ((size_t)(layer * 2 + which)) * 2048 * 256;
        const float* b1 = p.cmp_b1 + (size_t)(layer * 2 + which) * 256;
        const float* w2 = p.cmp_w2 + ((size_t)(layer * 2 + which)) * 256 * 64;
        for (int i = tid; i < 2048; i += 256) {
            const int tk = i >> 6, d = i & 63;
            in[i] = proj[(size_t)(b * SEQ + 16 * j + tk) * INW + col + d] + pe[i];
        }
        __syncthreads();
        float a0 = 0.f, a1 = 0.f, a2 = 0.f, a3 = 0.f;
#pragma unroll 2
        for (int i = 0; i < 2048; i += 4) {
            a0 += in[i] * w1[(size_t)i * 256 + tid];
            a1 += in[i + 1] * w1[(size_t)(i + 1) * 256 + tid];
            a2 += in[i + 2] * w1[(size_t)(i + 2) * 256 + tid];
            a3 += in[i + 3] * w1[(size_t)(i + 3) * 256 + tid];
        }
        hid[tid] = siluf_((a0 + a1) + (a2 + a3) + b1[tid]);
        __syncthreads();
        {
            const int d = tid & 63, part = tid >> 6;
            float a = 0.f;
            for (int n = part * 64; n < part * 64 + 64; ++n) a += hid[n] * w2[n * 64 + d];
            red[tid] = a;
        }
        __syncthreads();
        if (tid < 64) kcmp[(((size_t)(which * CB + b) * 2 + g) * NCMP + j) * 64 + tid] = (red[tid] + red[tid + 64]) + (red[tid + 128] + red[tid + 192]);
        __syncthreads();
    }
}

__device__ void phase_foxcum(const Params& p, int layer, const float* proj, float* cfox) {
    const int lane = threadIdx.x & 63, wv = threadIdx.x >> 6;
    const int gw = blockIdx.x * 4 + wv, ngw = gridDim.x * 4;
    for (int it = gw; it < CB * 4; it += ngw) {
        const int b = it / 4, h = it % 4;
        const float fb = p.forget_b[layer * 4 + h];
        double s = 0.0;
        for (int i = 0; i < 64; ++i) {
            const float v = proj[(size_t)(b * SEQ + 64 * lane + i) * INW + C_FC + h] + fb;
            const float lf = fminf(v, 0.f) - log1pf(expf(-fabsf(v)));
            s += (double)lf;
        }
        double incl = s;
#pragma unroll
        for (int o = 1; o < 64; o <<= 1) { const double t = __shfl_up(incl, o); if (lane >= o) incl += t; }
        double run = incl - s;
        for (int i = 0; i < 64; ++i) {
            const float v = proj[(size_t)(b * SEQ + 64 * lane + i) * INW + C_FC + h] + fb;
            const float lf = fminf(v, 0.f) - log1pf(expf(-fabsf(v)));
            run += (double)lf;
            cfox[(size_t)(b * 4 + h) * SEQ + 64 * lane + i] = (float)run;
        }
    }
}

__device__ void phase_attn1(const Params& p, int layer, const float* proj, const float* kcmp, const float* cfox, float* cat, float* ocmp, unsigned long long* selmask, float* sm) {
    const int lane = threadIdx.x & 63, wv = threadIdx.x >> 6;
    float* qs = sm + wv * 768;
    float* Ps = qs + 256;
    const int gw = blockIdx.x * 4 + wv, ngw = gridDim.x * 4;
    const int nA = CB * 4 * SEQ, nC = CB * 4 * SEQ, nB = CB * 2 * SEQ;
    for (int it = gw; it < nA + nC + nB; it += ngw) {
        if (it < nA) {
            const int t = it % SEQ, h = (it / SEQ) % 4, b = it / (SEQ * 4);
            const size_t trow = (size_t)(b * SEQ + t) * INW;
            qs[lane] = proj[trow + C_QA + h * 64 + lane];
            float o = 0.f, carry = 0.f;
            for (int c = (t - 1) >> 6; c >= 0 && t > 0; --c) {
                const int s = 64 * c + lane;
                const bool valid = s < t;
                const float z = dot64(qs, proj + (size_t)(b * SEQ + s) * INW + C_KA + h * 64) * 0.125f;
                const float sp = valid ? softplusf_(z) : 0.f;
                float suf = sp;
#pragma unroll
                for (int off = 1; off < 64; off <<= 1) { const float tt = __shfl_down(suf, off); if (lane + off < 64) suf += tt; }
                const float w = valid ? expf(z - (carry + suf)) : 0.f;
                o = pv64(o, w, proj + (size_t)(b * SEQ + 64 * c) * INW + C_VA + h * 64, INW, lane);
                carry += __shfl(suf, 0);
                if (carry > 120.f) break;
            }
            const float z = proj[trow + C_ZA + h * 64 + lane];
            cat[(size_t)(b * SEQ + t) * DM + h * 64 + lane] = o * siluf_(z);
        } else if (it < nA + nC) {
            const int i2 = it - nA;
            const int t = i2 % SEQ, h = (i2 / SEQ) % 4, b = i2 / (SEQ * 4);
            const size_t trow = (size_t)(b * SEQ + t) * INW;
            qs[lane] = proj[trow + C_QC + h * 64 + lane];
            const float* cf = cfox + (size_t)(b * 4 + h) * SEQ;
            const float ct = cf[t];
            float o = 0.f, m = -INFINITY, l = 0.f;
            for (int c = 0; c <= (t >> 6); ++c) {
                const int s = 64 * c + lane;
                const bool valid = s <= t;
                float sc = dot64(qs, proj + (size_t)(b * SEQ + s) * INW + C_KCF + h * 64) * 0.125f + (ct - cf[s]);
                if (!valid) sc = -INFINITY;
                const float mn = fmaxf(m, wave_max(sc));
                const float pr = valid ? expf(sc - mn) : 0.f;
                const float f = expf(m - mn);
                l = l * f + wave_sum(pr);
                o = pv64(o * f, pr, proj + (size_t)(b * SEQ + 64 * c) * INW + C_VCF + h * 64, INW, lane);
                m = mn;
            }
            const float z = proj[trow + C_ZC + h * 64 + lane];
            cat[(size_t)(b * SEQ + t) * DM + 768 + h * 64 + lane] = (o / l) * siluf_(z);
        } else {
            const int i2 = it - nA - nC;
            const int t = i2 % SEQ, g = (i2 / SEQ) % 2, b = i2 / (SEQ * 2);
            const size_t trow = (size_t)(b * SEQ + t) * INW;
#pragma unroll
            for (int hh = 0; hh < 4; ++hh) qs[hh * 64 + lane] = proj[trow + C_QB + (g * 4 + hh) * 64 + lane];
            const float* kc = kcmp + ((size_t)(0 * CB + b) * 2 + g) * NCMP * 64;
            const float* vc = kcmp + ((size_t)(1 * CB + b) * 2 + g) * NCMP * 64;
            float* Sc = Ps + 256;
#pragma unroll 1
            for (int c4 = 0; c4 < 4; ++c4) Ps[c4 * 64 + lane] = 0.f;
#pragma unroll 1
            for (int hh = 0; hh < 4; ++hh) {
                const int h8 = g * 4 + hh;
                float mx = -INFINITY;
#pragma unroll 1
                for (int c4 = 0; c4 < 4; ++c4) {
                    const int c = c4 * 64 + lane;
                    const int cend = 16 * c + 31;
                    const bool valid = (c < NCMP) && (cend <= t);
                    float v = -INFINITY;
                    if (valid) v = dot64(qs + hh * 64, kc + (size_t)c * 64) * 0.125f + p.rel_bias[bucket_of(t - cend) * 8 + h8];
                    Sc[c4 * 64 + lane] = v;
                    mx = fmaxf(mx, v);
                }
                mx = wave_max(mx);
                float sum = 0.f;
#pragma unroll 1
                for (int c4 = 0; c4 < 4; ++c4) {
                    const float v = Sc[c4 * 64 + lane];
                    const float e = (v > -INFINITY) ? expf(v - mx) : 0.f;
                    Sc[c4 * 64 + lane] = e;
                    sum += e;
                }
                sum = wave_sum(sum);
                const float inv = sum > 0.f ? 1.f / sum : 0.f;
                float o = 0.f;
#pragma unroll 1
                for (int c4 = 0; c4 < 4; ++c4) {
                    const float pr = Sc[c4 * 64 + lane] * inv;
                    Ps[c4 * 64 + lane] += pr;
#pragma unroll 4
                    for (int k = 0; k < 64; ++k) {
                        const float pk = __shfl(pr, k);
                        const int c = c4 * 64 + k;
                        if (c < NCMP) o += pk * vc[(size_t)c * 64 + lane];
                    }
                }
                ocmp[((size_t)(b * SEQ + t) * 8 + h8) * 64 + lane] = o;
            }
            float imp = Ps[4 * lane] + Ps[4 * lane + 1] + Ps[4 * lane + 2] + 0.5f * Ps[4 * lane + 3] + (lane > 0 ? 0.5f * Ps[4 * lane - 1] : 0.f);
            const int cur = t >> 6;
            if (lane == 0 || lane == cur || lane == cur - 1) imp = 1e4f;
            if (64 * lane > t) imp = -1e4f;
            unsigned long long mask = 0ull;
            for (int r = 0; r < 16; ++r) {
                const float mx = wave_max(imp);
                const unsigned long long bal = __ballot(imp == mx);
                const int sel = __ffsll((long long)bal) - 1;
                mask |= 1ull << sel;
                if (lane == sel) imp = -INFINITY;
            }
            if (lane == 0) selmask[(size_t)(b * 2 + g) * SEQ + t] = mask;
        }
    }
}

__device__ void phase_attn2(const Params& p, int layer, const float* proj, const float* ocmp, const unsigned long long* selmask, float* cat, float* sm) {
    const int lane = threadIdx.x & 63, wv = threadIdx.x >> 6;
    float* qs = sm + wv * 64;
    const int gw = blockIdx.x * 4 + wv, ngw = gridDim.x * 4;
    const int n = CB * 8 * SEQ;
    for (int it = gw; it < n; it += ngw) {
        const int t = it % SEQ, h8 = (it / SEQ) % 8, b = it / (SEQ * 8);
        const int g = h8 >> 2;
        const size_t trow = (size_t)(b * SEQ + t) * INW;
        qs[lane] = proj[trow + C_QB + h8 * 64 + lane];
        const unsigned long long mask = selmask[(size_t)(b * 2 + g) * SEQ + t];
        float os = 0.f;
        {
            float m = -INFINITY, l = 0.f;
            for (int sb = 0; sb <= (t >> 6); ++sb) {
                if (!((mask >> sb) & 1ull)) continue;
                const int s = 64 * sb + lane;
                const bool valid = s <= t;
                float sc = -INFINITY;
                if (valid) sc = dot64(qs, proj + (size_t)(b * SEQ + s) * INW + C_KSL + g * 64) * 0.125f + p.rel_bias[bucket_of(t - s) * 8 + h8];
                const float mn = fmaxf(m, wave_max(sc));
                const float pr = valid ? expf(sc - mn) : 0.f;
                const float f = expf(m - mn);
                l = l * f + wave_sum(pr);
                os = pv64(os * f, pr, proj + (size_t)(b * SEQ + 64 * sb) * INW + C_VSL + g * 64, INW, lane);
                m = mn;
            }
            os = l > 0.f ? os / l : 0.f;
        }
        float ow = 0.f;
        {
            float m = -INFINITY, l = 0.f;
            const int lo = t - 511 > 0 ? t - 511 : 0;
            for (int c = lo >> 6; c <= (t >> 6); ++c) {
                const int s = 64 * c + lane;
                const bool valid = s <= t && s >= lo;
                float sc = -INFINITY;
                if (valid) sc = dot64(qs, proj + (size_t)(b * SEQ + s) * INW + C_KWN + g * 64) * 0.125f + p.rel_bias[bucket_of(t - s) * 8 + h8];
                const float mn = fmaxf(m, wave_max(sc));
                const float pr = valid ? expf(sc - mn) : 0.f;
                const float f = expf(m - mn);
                l = l * f + wave_sum(pr);
                ow = pv64(ow * f, pr, proj + (size_t)(b * SEQ + 64 * c) * INW + C_VWN + g * 64, INW, lane);
                m = mn;
            }
            ow = l > 0.f ? ow / l : 0.f;
        }
        const float oc = ocmp[((size_t)(b * SEQ + t) * 8 + h8) * 64 + lane];
        const float g0 = sigmoidf_(proj[trow + C_GB + h8 * 3 + 0]);
        const float g1 = sigmoidf_(proj[trow + C_GB + h8 * 3 + 1]);
        const float g2 = sigmoidf_(proj[trow + C_GB + h8 * 3 + 2]);
        const float z = proj[trow + C_ZB + h8 * 64 + lane];
        cat[(size_t)(b * SEQ + t) * DM + 256 + h8 * 64 + lane] = (g0 * oc + g1 * os + g2 * ow) * siluf_(z);
    }
}

__global__ void __launch_bounds__(256, 2) mega(Params p) {
    cg::grid_group grid = cg::this_grid();
    __shared__ __attribute__((aligned(16))) float smem[3072];
    float* proj = (float*)(p.ws + WS_PROJ);
    float* h = (float*)(p.ws + WS_H);
    float* cat = (float*)(p.ws + WS_CAT);
    float* kcmp = (float*)(p.ws + WS_KCMP);
    float* cfox = (float*)(p.ws + WS_CFOX);
    unsigned long long* selmask = (unsigned long long*)(p.ws + WS_SEL);
    float* ocmp = (float*)(p.ws + WS_OCMP);
    for (int layer = 0; layer < DEPTH; ++layer) {
        const float* xin = layer == 0 ? p.x : p.out;
        for (int ch = 0; ch < NCHUNK; ++ch) {
            const size_t tok0 = (size_t)ch * CT;
            phase_rmsnorm(xin + tok0 * DM, p.norm_g + layer * DM, h, CT, false);
            grid.sync();
            phase_gemm(h, DM, p.w_in + (size_t)layer * DM * INW, INW, proj, INW, nullptr, 0, CT, INW, DM, smem);
            grid.sync();
            phase_compress(p, layer, proj, kcmp, smem);
            phase_foxcum(p, layer, proj, cfox);
            grid.sync();
            phase_attn1(p, layer, proj, kcmp, cfox, cat, ocmp, selmask, smem);
            grid.sync();
            phase_attn2(p, layer, proj, ocmp, selmask, cat, smem);
            grid.sync();
            phase_gemm(cat, DM, p.w_out + (size_t)layer * DM * DM, DM, p.out + tok0 * DM, DM, xin + tok0 * DM, DM, CT, DM, DM, smem);
            grid.sync();
        }
    }
    phase_rmsnorm(p.out, p.final_g, p.out, BATCH * SEQ, false);
}

extern "C" void kernel_launch(void* const* d_in, const int* in_sizes, int n_in, void* d_out, int out_size, void* d_ws, size_t ws_size, hipStream_t stream) {
    static int grid_blocks = 0;
    if (!grid_blocks) {
        int dev = 0, cus = 0, per_cu = 0;
        hipGetDevice(&dev);
        hipDeviceGetAttribute(&cus, hipDeviceAttributeMultiprocessorCount, dev);
        hipOccupancyMaxActiveBlocksPerMultiprocessor(&per_cu, mega, 256, 0);
        if (per_cu > 4) per_cu = 4;
        if (per_cu < 1) per_cu = 1;
        grid_blocks = cus * per_cu;
    }
    Params p{};
    p.x = (const float*)d_in[0]; p.norm_g = (const float*)d_in[1]; p.w_in = (const float*)d_in[2]; p.w_out = (const float*)d_in[3];
    p.forget_b = (const float*)d_in[4]; p.cmp_w1 = (const float*)d_in[5]; p.cmp_b1 = (const float*)d_in[6]; p.cmp_w2 = (const float*)d_in[7];
    p.cmp_pe = (const float*)d_in[8]; p.rel_bias = (const float*)d_in[9]; p.final_g = (const float*)d_in[10];
    p.out = (float*)d_out; p.ws = (unsigned char*)d_ws;
    void* args[] = {&p};
    hipError_t e = hipLaunchCooperativeKernel((void*)mega, dim3(grid_blocks), dim3(256), args, 0, stream);
    if (e != hipSuccess) fprintf(stderr, "cooperative launch failed: %s (grid %d)\n", hipGetErrorString(e), grid_blocks);
}
```

```cpp
#include <hip/hip_runtime.h>
#include <hip/hip_cooperative_groups.h>
#include <cstdio>
#include <cstdint>
namespace cg = cooperative_groups;

constexpr int DM = 1024, BATCH = 8, SEQ = 4096, DEPTH = 2, HD = 64, MTOK = BATCH * SEQ;
constexpr int INW = 3868, NPAD = 4096;
constexpr int C_QA = 0, C_KA = 256, C_VA = 512, C_ZA = 768, C_QB = 1024, C_KC = 1536, C_VC = 1664, C_KSL = 1792, C_VSL = 1920,
              C_KWN = 2048, C_VWN = 2176, C_GB = 2304, C_ZB = 2328, C_QC = 2840, C_KCF = 3096, C_VCF = 3352, C_FC = 3608, C_ZC = 3612;
constexpr int NCMP = 255;
constexpr float QSCALE = 0.125f * 1.4426950408889634f;
constexpr float LN2 = 0.6931471805599453f;
constexpr size_t MiB = 1u << 20;
constexpr size_t WS_WTIN = 0, WS_WTOUT = 16 * MiB, WS_W1T = 20 * MiB, WS_W2T = 24 * MiB, WS_BIAS1 = 25 * MiB, WS_SS = 25 * MiB + 512 * 1024,
                 WS_CFOX = 26 * MiB, WS_SEL = 27 * MiB, WS_KCMP = 28 * MiB, WS_GF = 30 * MiB, WS_XB = 36 * MiB, WS_CAT = 100 * MiB,
                 WS_QA = 164 * MiB, WS_KA = 180 * MiB, WS_VA = 196 * MiB, WS_ZA = 212 * MiB, WS_QB = 228 * MiB, WS_KC = 260 * MiB, WS_VC = 268 * MiB,
                 WS_KSL = 276 * MiB, WS_VSL = 284 * MiB, WS_KWN = 292 * MiB, WS_VWN = 300 * MiB, WS_ZB = 308 * MiB, WS_QC = 340 * MiB, WS_KCF = 356 * MiB,
                 WS_VCF = 372 * MiB, WS_ZC = 388 * MiB, WS_DBG_PROJF = 404 * MiB, WS_DBG_OCMP = 466 * MiB, WS_DBG_KCMPF = 475 * MiB, WS_END = 480 * MiB;
constexpr int LDS_BYTES = 147456;
constexpr int NTHREADS = 512, NWAVES = 8;

typedef unsigned short bf16_t;
__device__ __forceinline__ float bf2f(bf16_t v) { return __uint_as_float((unsigned)v << 16); }
__device__ __forceinline__ unsigned f2bf(float f) { unsigned u = __float_as_uint(f); return (u + 0x7fffu + ((u >> 16) & 1u)) >> 16; }
__device__ __forceinline__ unsigned pk2(float lo, float hi) { return f2bf(lo) | (f2bf(hi) << 16); }

__constant__ unsigned char c_bucket[128] = {0, 1, 2, 3, 4, 5, 6, 7, 8, 9, 10, 11, 12, 13, 14, 15, 16, 16, 16, 17, 17, 18, 18, 18, 19, 19, 19, 20, 20, 20, 20, 21, 21, 21, 21, 22, 22, 22, 22, 22, 23, 23, 23, 23, 23, 23, 24, 24, 24, 24, 24, 24, 25, 25, 25, 25, 25, 25, 25, 26, 26, 26, 26, 26, 26, 26, 26, 27, 27, 27, 27, 27, 27, 27, 27, 27, 27, 28, 28, 28, 28, 28, 28, 28, 28, 28, 28, 29, 29, 29, 29, 29, 29, 29, 29, 29, 29, 29, 29, 30, 30, 30, 30, 30, 30, 30, 30, 30, 30, 30, 30, 30, 30, 31, 31, 31, 31, 31, 31, 31, 31, 31, 31, 31, 31, 31, 31, 31};

struct Params {
    const float *x, *norm_g, *w_in, *w_out, *forget_b, *cmp_w1, *cmp_b1, *cmp_w2, *cmp_pe, *rel_bias, *final_g;
    float* out;
    unsigned char* ws;
};

__device__ __forceinline__ float wave_sum(float v) {
#pragma unroll
    for (int o = 32; o > 0; o >>= 1) v += __shfl_xor(v, o);
    return v;
}
__device__ __forceinline__ float wave_max(float v) {
#pragma unroll
    for (int o = 32; o > 0; o >>= 1) v = fmaxf(v, __shfl_xor(v, o));
    return v;
}
__device__ __forceinline__ float sigmoidf_(float v) { return 1.f / (1.f + expf(-v)); }
__device__ __forceinline__ float siluf_(float v) { return v / (1.f + expf(-v)); }
__device__ __forceinline__ float softplusf_(float z) { return fmaxf(z, 0.f) + log1pf(expf(-fabsf(z))); }
__device__ __forceinline__ int bucket_of(int dist) { return dist >= 128 ? 31 : (int)c_bucket[dist < 0 ? 0 : dist]; }
__device__ __forceinline__ int otid() { int t = threadIdx.x; asm volatile("" : "+v"(t)); return t; }
namespace pg8 {
#define PG8_LAS __attribute__((address_space(3)))
typedef unsigned short bf16_t;
typedef short bf16x8 __attribute__((ext_vector_type(8)));
typedef float f32x4 __attribute__((ext_vector_type(4)));
typedef unsigned u32x4 __attribute__((ext_vector_type(4)));
constexpr int BM = 256, BK = 64, HALF = 128, HTB = HALF * BK * 2  , STAGE_BYTES = 8 * HTB, NXCD = 8, WGM = 8;

__host__ __device__ __forceinline__ int lds_byte(int r, int c) { const int st = (r >> 4) * 2 + (c >> 5), rr = r & 15, cc = c & 31, ob = rr * 64 + cc * 2; return st * 1024 + (ob ^ (((ob >> 9) & 1) << 5)); }
__host__ __device__ __forceinline__ void stage_rc(int b, int& R, int& C) { const int st = b / 1024, sb = b % 1024, swz = sb ^ (((sb >> 9) & 1) << 5); R = (st >> 1) * 16 + swz / 64; C = (st & 1) * 32 + (swz % 64) / 2; }
__host__ __device__ __forceinline__ int perm32(int rho) { const int n = rho >> 4, i = rho & 15; return 8 * (i >> 2) + 4 * n + (i & 3); }

struct Unit { int pm, pn; };
struct Gemm { const bf16_t* A; const bf16_t* Bt; int M, N, K, lda, ldb; };

struct StaticOrder {
    int nM, nN, nwg, G, c;
    __host__ __device__ void init(int M, int N, int G_, int c_) { nM = M / BM; nN = N / BM; nwg = nM * nN; G = G_; c = c_; }
    __host__ __device__ bool next(int i, Unit& u) const {
        const long L = (long)i * G + c; if (L >= nwg) return false;
        int wgid = (int)L; { const int q = nwg / NXCD, r = nwg % NXCD, xcd = wgid % NXCD, off = wgid / NXCD; wgid = (xcd < r ? xcd * (q + 1) : r * (q + 1) + (xcd - r) * q) + off; }
        const int nig = WGM * nN, gid = wgid / nig, fm = gid * WGM, gsz = (nM - fm) < WGM ? (nM - fm) : WGM;
        u.pm = fm + ((wgid % nig) % gsz); u.pn = (wgid % nig) / gsz; return true;
    }
    __device__ __forceinline__ void a_ready(const Unit&) const {}
    __device__ __forceinline__ void done(const Unit&) const {}
};


template <class Epi, class Sched, bool ALIGN_EPI = false, bool SP2 = false>
__device__ __forceinline__ void gemm_phase(PG8_LAS unsigned char* lds, const Gemm g, const Sched& S, const Epi& E) {
    const int tid = otid(), wid = __builtin_amdgcn_readfirstlane(tid >> 6), lane = tid & 63, wr = wid >> 2, wc = wid & 3, fr = lane & 15, fq = lane >> 4;
    const int K = g.K, nt = K / BK;
    unsigned voffA[2], voffB[2];
#pragma unroll
    for (int i = 0; i < 2; ++i) { int R, C; stage_rc(tid * 16 + i * 8192, R, C); const int Rb = Epi::PERM ? ((R & ~31) + perm32(R & 31)) : R;
        voffA[i] = (unsigned)(R * g.lda + C) * 2u; voffB[i] = (unsigned)(Rb * g.ldb + C) * 2u; }
    const size_t kstep = (size_t)(BK * 2);
    const size_t hstepA = (size_t)HALF * g.lda * 2, hstepB = (size_t)HALF * g.ldb * 2;
    const size_t tstepA = 2 * hstepA, tstepB = 2 * hstepB;
    const unsigned ldsw = (unsigned)wid * 1024u;
    const int aoff = lds_byte(wr * 64 + fr, fq * 8), boff = lds_byte(wc * 32 + fr, fq * 8);
#define PG8_SA(b, h) (((b) * 2 + (h)) * HTB)
#define PG8_SB(b, h) ((4 + (b) * 2 + (h)) * HTB)
#define PG8_STAGE(bufoff, gbase, voff) do { _Pragma("unroll") for (int _i = 0; _i < 2; ++_i) \
        __builtin_amdgcn_global_load_lds((const unsigned*)((const char*)(gbase) + (voff)[_i]), (PG8_LAS unsigned*)(lds + (bufoff) + ldsw + _i * 8192), 16, 0, 0); } while (0)
#define PG8_LDA(dst, b, h) do { _Pragma("unroll") for (int m = 0; m < 4; ++m) _Pragma("unroll") for (int k = 0; k < 2; ++k) dst[m][k] = *(const PG8_LAS bf16x8*)(lds + PG8_SA(b, h) + aoff + m * 2048 + k * 1024); } while (0)
#define PG8_LDB(dst, b, h) do { _Pragma("unroll") for (int n = 0; n < 2; ++n) _Pragma("unroll") for (int k = 0; k < 2; ++k) dst[n][k] = *(const PG8_LAS bf16x8*)(lds + PG8_SB(b, h) + boff + n * 2048 + k * 1024); } while (0)
#define PG8_MMA(ai, bj, At, Bt) do { __builtin_amdgcn_s_setprio(1); _Pragma("unroll") for (int m = 0; m < 4; ++m) _Pragma("unroll") for (int n = 0; n < 2; ++n) _Pragma("unroll") for (int k = 0; k < 2; ++k) \
        acc[ai][bj][m][n] = __builtin_amdgcn_mfma_f32_16x16x32_bf16(Bt[n][k], At[m][k], acc[ai][bj][m][n], 0, 0, 0); __builtin_amdgcn_s_setprio(0); } while (0)
#define PG8_WAIT_V(n) asm volatile("s_waitcnt vmcnt(" #n ")" ::: "memory")
#define PG8_WAIT_L(n) asm volatile("s_waitcnt lgkmcnt(" #n ")" ::: "memory")
#define PG8_BAR __builtin_amdgcn_s_barrier()
#define PG8_SCHED __builtin_amdgcn_sched_barrier(0)
    Unit cur, nxt; int ui = 0;
    if (!S.next(0, cur)) return;
    f32x4 acc[2][2][4][2];
#pragma unroll
    for (int a = 0; a < 2; ++a)
#pragma unroll
        for (int b = 0; b < 2; ++b)
#pragma unroll
            for (int m = 0; m < 4; ++m)
#pragma unroll
                for (int n = 0; n < 2; ++n) acc[a][b][m][n] = (f32x4){0.f, 0.f, 0.f, 0.f};
    bf16x8 At[4][2], B0[2][2], B1[2][2];
    const char* cA = (const char*)g.A + (size_t)cur.pm * tstepA; const char* cB = (const char*)g.Bt + (size_t)cur.pn * tstepB;
    S.a_ready(cur);
    if constexpr (SP2) {
        PG8_STAGE(PG8_SB(0, 0), cB, voffB); PG8_STAGE(PG8_SB(0, 1), cB + hstepB, voffB); PG8_STAGE(PG8_SA(0, 0), cA, voffA); PG8_STAGE(PG8_SA(0, 1), cA + hstepA, voffA);
        if (wr == 1) PG8_BAR;
        PG8_WAIT_V(2); PG8_BAR;
        PG8_STAGE(PG8_SB(1, 0), cB + kstep, voffB); PG8_STAGE(PG8_SA(1, 0), cA + kstep, voffA); PG8_STAGE(PG8_SB(1, 1), cB + hstepB + kstep, voffB);
        PG8_WAIT_V(6); PG8_BAR;
    } else {
        PG8_STAGE(PG8_SB(0, 0), cB, voffB); PG8_STAGE(PG8_SA(0, 0), cA, voffA); PG8_STAGE(PG8_SB(0, 1), cB + hstepB, voffB); PG8_STAGE(PG8_SA(0, 1), cA + hstepA, voffA);
        if (wr == 1) PG8_BAR;
        PG8_WAIT_V(4); PG8_BAR;
        PG8_STAGE(PG8_SB(1, 0), cB + kstep, voffB); PG8_STAGE(PG8_SA(1, 0), cA + kstep, voffA); PG8_STAGE(PG8_SB(1, 1), cB + hstepB + kstep, voffB);
        PG8_WAIT_V(6); PG8_BAR;
    }
    for (;;) {
        const bool has_next = S.next(ui + 1, nxt);
        const char* nA = has_next ? (const char*)g.A + (size_t)nxt.pm * tstepA : cA; const char* nB = has_next ? (const char*)g.Bt + (size_t)nxt.pn * tstepB : cB;
        for (int t = 0; t < nt; t += 2) {
            const bool last = (t == nt - 2);
            const char* a1 = cA + (size_t)(t + 1) * kstep;
            const char* a2 = last ? nA : cA + (size_t)(t + 2) * kstep; const char* b2 = last ? nB : cB + (size_t)(t + 2) * kstep;
            const char* a3 = a2 + kstep; const char* b3 = b2 + kstep;
            if (last && has_next) S.a_ready(nxt);
            if constexpr (SP2) {
            PG8_LDB(B0, 0, 0); PG8_LDB(B1, 0, 1); PG8_SCHED; PG8_LDA(At, 0, 0); PG8_STAGE(PG8_SA(1, 1), a1 + hstepA, voffA);
            PG8_WAIT_V(8); PG8_WAIT_L(0); PG8_BAR; PG8_MMA(0, 0, At, B0); PG8_MMA(0, 1, At, B1); PG8_BAR; PG8_SCHED;
            PG8_LDA(At, 0, 1); PG8_STAGE(PG8_SB(0, 0), b2, voffB); PG8_STAGE(PG8_SB(0, 1), b2 + hstepB, voffB); PG8_STAGE(PG8_SA(0, 0), a2, voffA);
            PG8_WAIT_V(8); PG8_WAIT_L(0); PG8_BAR; PG8_MMA(1, 0, At, B0); PG8_MMA(1, 1, At, B1); PG8_BAR; PG8_SCHED;
            PG8_LDB(B0, 1, 0); PG8_LDB(B1, 1, 1); PG8_SCHED; PG8_LDA(At, 1, 0); PG8_STAGE(PG8_SA(0, 1), a2 + hstepA, voffA);
            PG8_WAIT_V(8); PG8_WAIT_L(0); PG8_BAR; PG8_MMA(0, 0, At, B0); PG8_MMA(0, 1, At, B1); PG8_BAR; PG8_SCHED;
            PG8_LDA(At, 1, 1); PG8_STAGE(PG8_SB(1, 0), b3, voffB); PG8_STAGE(PG8_SB(1, 1), b3 + hstepB, voffB); PG8_STAGE(PG8_SA(1, 0), a3, voffA);
            PG8_WAIT_V(8); PG8_WAIT_L(0); PG8_BAR; PG8_MMA(1, 0, At, B0); PG8_MMA(1, 1, At, B1); PG8_BAR; PG8_SCHED;
            } else {
            PG8_LDB(B0, 0, 0); PG8_SCHED; PG8_LDA(At, 0, 0); PG8_STAGE(PG8_SA(1, 1), a1 + hstepA, voffA);
            PG8_WAIT_L(8); PG8_BAR; PG8_WAIT_L(0); PG8_MMA(0, 0, At, B0); PG8_BAR; PG8_SCHED;
            PG8_LDB(B1, 0, 1); PG8_STAGE(PG8_SB(0, 0), b2, voffB);
            PG8_BAR; PG8_WAIT_L(0); PG8_MMA(0, 1, At, B1); PG8_BAR;
            PG8_LDA(At, 0, 1); PG8_STAGE(PG8_SA(0, 0), a2, voffA);
            PG8_BAR; PG8_WAIT_L(0); PG8_MMA(1, 0, At, B0); PG8_BAR; PG8_SCHED;
            PG8_STAGE(PG8_SB(0, 1), b2 + hstepB, voffB);
            PG8_WAIT_V(6); PG8_BAR; PG8_MMA(1, 1, At, B1); PG8_BAR;
            PG8_LDB(B0, 1, 0); PG8_SCHED; PG8_LDA(At, 1, 0); PG8_STAGE(PG8_SA(0, 1), a2 + hstepA, voffA);
            PG8_WAIT_L(8); PG8_BAR; PG8_WAIT_L(0); PG8_MMA(0, 0, At, B0); PG8_BAR; PG8_SCHED;
            PG8_LDB(B1, 1, 1); PG8_STAGE(PG8_SB(1, 0), b3, voffB);
            PG8_BAR; PG8_WAIT_L(0); PG8_MMA(0, 1, At, B1); PG8_BAR;
            PG8_LDA(At, 1, 1); PG8_STAGE(PG8_SA(1, 0), a3, voffA);
            PG8_BAR; PG8_WAIT_L(0); PG8_MMA(1, 0, At, B0); PG8_BAR; PG8_SCHED;
            PG8_STAGE(PG8_SB(1, 1), b3 + hstepB, voffB);
            PG8_WAIT_V(6); PG8_BAR; PG8_MMA(1, 1, At, B1); PG8_BAR;
            }
        }
        if constexpr (ALIGN_EPI) { if (wr == 0) PG8_BAR; }
        if constexpr (!Epi::AFTER_DRAIN) { E(acc, cur, wr, wc, fr, fq); S.done(cur); }
        if (!has_next) break;
#pragma unroll
        for (int a = 0; a < 2; ++a)
#pragma unroll
            for (int b = 0; b < 2; ++b)
#pragma unroll
                for (int m = 0; m < 4; ++m)
#pragma unroll
                    for (int n = 0; n < 2; ++n) acc[a][b][m][n] = (f32x4){0.f, 0.f, 0.f, 0.f};
        cur = nxt; cA = nA; cB = nB; ++ui;
        if constexpr (ALIGN_EPI) { if (wr == 1) PG8_BAR; }
    }
    PG8_WAIT_V(0);
    if constexpr (!ALIGN_EPI) { if (wr == 0) PG8_BAR; }
    PG8_BAR;
    if constexpr (Epi::AFTER_DRAIN) { E.fused(acc, cur, wr, wc, fr, fq, lds, wid, lane); S.done(cur); }
#undef PG8_SA
#undef PG8_SB
#undef PG8_STAGE
#undef PG8_LDA
#undef PG8_LDB
#undef PG8_MMA
#undef PG8_WAIT_V
#undef PG8_WAIT_L
#undef PG8_BAR
#undef PG8_SCHED
}
}

namespace pg8 {
struct EpiInProj {
    static constexpr bool PERM = true, AFTER_DRAIN = false;
    unsigned char* ws; const float* ss;
    __device__ __forceinline__ void operator()(const f32x4 (&acc)[2][2][4][2], const Unit& u, int wr, int wc, int fr, int fq) const {
        const int pn = u.pn;
        const int b = u.pm >> 4, t0 = (u.pm & 15) * 256 + wr * 64 + fr;
        size_t base0 = 0, base1 = 0; int mul = 64, H = 4; float sc = 1.f; int kind = 0;
        int W = 0, coff = 0;
        switch (pn) {
            case 0: base0 = base1 = WS_QA; sc = QSCALE; break;
            case 1: base0 = base1 = WS_KA; break;
            case 2: base0 = base1 = WS_VA; break;
            case 3: kind = 1; base0 = base1 = WS_ZA; W = 256; break;
            case 4: kind = 1; base0 = base1 = WS_QB; W = 512; sc = QSCALE; break;
            case 5: kind = 1; base0 = base1 = WS_QB; W = 512; coff = 256; sc = QSCALE; break;
            case 6: H = 2; base0 = WS_KC; base1 = WS_VC; break;
            case 7: H = 2; base0 = WS_KSL; base1 = WS_VSL; break;
            case 8: H = 2; base0 = WS_KWN; base1 = WS_VWN; break;
            case 9: kind = 1; base0 = base1 = WS_ZB; W = 512; break;
            case 10: kind = 1; base0 = base1 = WS_ZB; W = 512; coff = 256; break;
            case 11: base0 = base1 = WS_QC; sc = QSCALE; break;
            case 12: base0 = base1 = WS_KCF; break;
            case 13: base0 = base1 = WS_VCF; break;
            case 14: kind = 1; base0 = base1 = WS_ZC; W = 256; break;
            default: kind = 2; break;
        }
        const int chl = 32 * wc + 8 * fq;
        if (kind == 2) {
            if (wc == 0) {
                float* gf = (float*)(ws + WS_GF) + (size_t)(b * SEQ + t0) * 32 + chl;
#pragma unroll
                for (int ai = 0; ai < 2; ++ai)
#pragma unroll
                    for (int m = 0; m < 4; ++m) {
                        const int tl = ai * HALF + m * 16;
                        const float r = rsqrtf(ss[b * SEQ + t0 + tl] * (1.f / DM) + 1e-6f);
                        *(f32x4*)(gf + (size_t)tl * 32) = acc[ai][0][m][0] * r;
                        *(f32x4*)(gf + (size_t)tl * 32 + 4) = acc[ai][0][m][1] * r;
                    }
            }
            return;
        }
        unsigned cst0, cst1;
        if (kind == 0) {
            mul = 64;
            if (H == 4) { cst0 = (unsigned)(((b * 4 + (chl >> 6)) * SEQ) * 64 + (chl & 63)); cst1 = (unsigned)(((b * 4 + 2 + (chl >> 6)) * SEQ) * 64 + (chl & 63)); }
            else { cst0 = cst1 = (unsigned)(((b * 2 + (chl >> 6)) * SEQ) * 64 + (chl & 63)); }
        } else {
            mul = W;
            cst0 = (unsigned)(b * SEQ) * (unsigned)W + coff + chl; cst1 = cst0 + 128;
        }
        bf16_t* d0 = (bf16_t*)(ws + base0) + cst0 + (size_t)t0 * mul;
        bf16_t* d1 = (bf16_t*)(ws + base1) + cst1 + (size_t)t0 * mul;
#pragma unroll
        for (int ai = 0; ai < 2; ++ai)
#pragma unroll
            for (int m = 0; m < 4; ++m) {
                const int tl = ai * HALF + m * 16;
                const float r = rsqrtf(ss[b * SEQ + t0 + tl] * (1.f / DM) + 1e-6f) * sc;
#pragma unroll
                for (int bj = 0; bj < 2; ++bj) {
                    const f32x4 v0 = acc[ai][bj][m][0] * r, v1 = acc[ai][bj][m][1] * r;
                    u32x4 w; w.x = pk2(v0[0], v0[1]); w.y = pk2(v0[2], v0[3]); w.z = pk2(v1[0], v1[1]); w.w = pk2(v1[2], v1[3]);
                    *(u32x4*)((bj ? d1 : d0) + (size_t)tl * mul) = w;
                }
            }
    }
};
struct EpiOutProj {
    static constexpr bool PERM = false, AFTER_DRAIN = false;
    const float* xin; float* xout;
    __device__ __forceinline__ void operator()(const f32x4 (&acc)[2][2][4][2], const Unit& u, int wr, int wc, int fr, int fq) const {
        const int col0 = u.pn * BM + wc * 32 + 4 * fq;
#pragma unroll
        for (int ai = 0; ai < 2; ++ai)
#pragma unroll
            for (int m = 0; m < 4; ++m) {
                const size_t roff = (size_t)(u.pm * BM + ai * HALF + wr * 64 + m * 16 + fr) * DM + col0;
#pragma unroll
                for (int bj = 0; bj < 2; ++bj)
#pragma unroll
                    for (int n = 0; n < 2; ++n) {
                        const f32x4 r = *(const f32x4*)(xin + roff + bj * HALF + n * 16);
                        *(f32x4*)(xout + roff + bj * HALF + n * 16) = r + acc[ai][bj][m][n];
                    }
            }
    }
};
}

__device__ __forceinline__ void cvt_item(const float* src, int ldsrc, int col, int k0, const float* scale, bf16_t* dst) {
    float v[8];
#pragma unroll
    for (int j = 0; j < 8; ++j) v[j] = col >= 0 ? src[(size_t)(k0 + j) * ldsrc + col] * (scale ? scale[k0 + j] : 1.f) : 0.f;
    uint4 w; w.x = pk2(v[0], v[1]); w.y = pk2(v[2], v[3]); w.z = pk2(v[4], v[5]); w.w = pk2(v[6], v[7]);
    *(uint4*)dst = w;
}
__device__ __forceinline__ int in_src_col(int n) {
    if (n < 2304) return n;
    if (n < 3584) return n + 24;
    if (n < 3840) return n + 28;
    if (n < 3864) return C_GB + (n - 3840);
    if (n < 3868) return C_FC + (n - 3864);
    return -1;
}
__device__ void p0_weights(const Params& p) {
    const int gtid = blockIdx.x * NTHREADS + otid(), gsz = gridDim.x * NTHREADS;
    constexpr int I_IN = NPAD * 128, I_OUT = 1024 * 128, I_W1 = 256 * 256, I_W2 = 64 * 32;
    constexpr int TOTAL = 2 * I_IN + 2 * I_OUT + 4 * I_W1 + 4 * I_W2;
    for (int it = gtid; it < TOTAL; it += gsz) {
        int r = it;
        if (r < 2 * I_IN) {
            const int l = r / I_IN; r %= I_IN; const int n = r % NPAD, kc = r / NPAD;
            cvt_item(p.w_in + (size_t)l * DM * INW, INW, in_src_col(n), kc * 8, p.norm_g + l * DM, (bf16_t*)(p.ws + WS_WTIN) + ((size_t)l * NPAD + n) * DM + kc * 8);
            continue;
        }
        r -= 2 * I_IN;
        if (r < 2 * I_OUT) {
            const int l = r / I_OUT; r %= I_OUT; const int n = r % 1024, kc = r / 1024;
            cvt_item(p.w_out + (size_t)l * DM * DM, DM, n, kc * 8, nullptr, (bf16_t*)(p.ws + WS_WTOUT) + ((size_t)l * 1024 + n) * DM + kc * 8);
            continue;
        }
        r -= 2 * I_OUT;
        if (r < 4 * I_W1) {
            const int lw = r / I_W1; r %= I_W1; const int n = r % 256, kc = r / 256;
            cvt_item(p.cmp_w1 + (size_t)lw * 2048 * 256, 256, n, kc * 8, nullptr, (bf16_t*)(p.ws + WS_W1T) + ((size_t)lw * 256 + n) * 2048 + kc * 8);
            continue;
        }
        r -= 4 * I_W1;
        {
            const int lw = r / I_W2; r %= I_W2; const int n = r % 64, kc = r / 64;
            cvt_item(p.cmp_w2 + (size_t)lw * 256 * 64, 64, n, kc * 8, nullptr, (bf16_t*)(p.ws + WS_W2T) + ((size_t)lw * 64 + n) * 256 + kc * 8);
        }
    }
    if (gtid < 1024) {
        const int lw = gtid >> 8, n = gtid & 255;
        const float* w1 = p.cmp_w1 + (size_t)lw * 2048 * 256; const float* pe = p.cmp_pe + (size_t)lw * 2048;
        float a0 = 0.f, a1 = 0.f;
        for (int i = 0; i < 2048; i += 2) { a0 += pe[i] * w1[(size_t)i * 256 + n]; a1 += pe[i + 1] * w1[(size_t)(i + 1) * 256 + n]; }
        ((float*)(p.ws + WS_BIAS1))[gtid] = a0 + a1 + p.cmp_b1[gtid];
    }
}
__device__ void phase_convert_x(const float* xin, bf16_t* xb, float* ss) {
    const int tid_ = otid(); const int lane = tid_ & 63, wv = tid_ >> 6;
    const int gw = blockIdx.x * NWAVES + wv, ngw = gridDim.x * NWAVES;
    for (int r = gw; r < MTOK; r += ngw) {
        const float4* xr = (const float4*)(xin + (size_t)r * DM);
        float s = 0.f;
#pragma unroll
        for (int j = 0; j < 4; ++j) {
            const float4 v = xr[lane + 64 * j];
            s += v.x * v.x + v.y * v.y + v.z * v.z + v.w * v.w;
            uint2 w; w.x = pk2(v.x, v.y); w.y = pk2(v.z, v.w);
            *(uint2*)(xb + (size_t)r * DM + 4 * (lane + 64 * j)) = w;
        }
        s = wave_sum(s);
        if (lane == 0) ss[r] = s;
    }
}
__device__ void phase_final_norm(float* x, const float* g) {
    const int tid_ = otid(); const int lane = tid_ & 63, wv = tid_ >> 6;
    const int gw = blockIdx.x * NWAVES + wv, ngw = gridDim.x * NWAVES;
    for (int r = gw; r < MTOK; r += ngw) {
        float4* xr = (float4*)(x + (size_t)r * DM);
        float4 v[4];
        float s = 0.f;
#pragma unroll
        for (int j = 0; j < 4; ++j) { v[j] = xr[lane + 64 * j]; s += v[j].x * v[j].x + v[j].y * v[j].y + v[j].z * v[j].z + v[j].w * v[j].w; }
        s = wave_sum(s);
        const float rs = rsqrtf(s * (1.f / DM) + 1e-6f);
#pragma unroll
        for (int j = 0; j < 4; ++j) {
            const float4 gg = ((const float4*)g)[lane + 64 * j];
            float4 o;
            o.x = v[j].x * rs * gg.x; o.y = v[j].y * rs * gg.y; o.z = v[j].z * rs * gg.z; o.w = v[j].w * rs * gg.w;
            xr[lane + 64 * j] = o;
        }
    }
}

namespace att {
#define LAS3 __attribute__((address_space(3)))
typedef short bf16x8 __attribute__((ext_vector_type(8)));
typedef float f32x16 __attribute__((ext_vector_type(16)));
typedef float f32x4 __attribute__((ext_vector_type(4)));
typedef short v4i16_t __attribute__((ext_vector_type(4)));
typedef float f32x2_t __attribute__((ext_vector_type(2)));
typedef __bf16 bf16x2_t __attribute__((ext_vector_type(2)));
constexpr int L_KV = 0;
constexpr int L_AUX = 32768;
constexpr int L_WSF = 33792;
constexpr int L_BTAB = 36864;
constexpr int L_IMP = 40960;
constexpr int L_SELM = 57344;
constexpr float NEG_INF = -INFINITY;

__device__ __forceinline__ unsigned cvtpk(float lo, float hi) { f32x2_t v = {lo, hi}; bf16x2_t b = __builtin_convertvector(v, bf16x2_t); return __builtin_bit_cast(unsigned, b); }
__device__ __forceinline__ int crow(int r, int hi) { return (r & 3) + 8 * (r >> 2) + 4 * hi; }

struct Ctx {
    int tid, lane, r32, hi, wid;
    unsigned kofs[4];
    unsigned vofs0;
    unsigned stK, stV;
};
__device__ __forceinline__ Ctx make_ctx() {
    Ctx c; c.tid = otid(); c.lane = c.tid & 63; c.r32 = c.lane & 31; c.hi = c.lane >> 5; c.wid = __builtin_amdgcn_readfirstlane(c.tid >> 6);
#pragma unroll
    for (int d0 = 0; d0 < 4; ++d0) c.kofs[d0] = (unsigned)(c.r32 * 128 + (((2 * d0 + c.hi) ^ (c.r32 & 7)) << 4));
    const int q = (c.lane & 15) >> 2, p = c.lane & 3, g = (c.lane >> 4) & 1;
    c.vofs0 = (unsigned)((4 * c.hi + q) * 128 + (((2 * g + (p >> 1)) ^ ((q >> 1) << 2)) << 4) + 8 * (p & 1));
    const int kv = c.tid >> 3, ch = c.tid & 7;
    c.stK = (unsigned)(kv * 128 + ((ch ^ (kv & 7)) << 4));
    c.stV = (unsigned)(kv * 128 + ((ch ^ (((kv >> 1) & 1) << 2)) << 4));
    return c;
}
__device__ __forceinline__ void qk_tile(f32x16& p0, f32x16& p1, const LAS3 unsigned char* kb, const Ctx& c, const bf16x8 (&qf)[4]) {
#pragma unroll
    for (int d0 = 0; d0 < 4; ++d0) {
        const bf16x8 a0 = *(const LAS3 bf16x8*)(kb + c.kofs[d0]);
        const bf16x8 a1 = *(const LAS3 bf16x8*)(kb + 4096 + c.kofs[d0]);
        p0 = __builtin_amdgcn_mfma_f32_32x32x16_bf16(a0, qf[d0], p0, 0, 0, 0);
        p1 = __builtin_amdgcn_mfma_f32_32x32x16_bf16(a1, qf[d0], p1, 0, 0, 0);
    }
}
__device__ __forceinline__ bf16x8 pack8(const f32x16& p, int b) {
    typedef unsigned u32x4p_t __attribute__((ext_vector_type(4)));
    u32x4p_t w; w.x = cvtpk(p[b], p[b + 1]); w.y = cvtpk(p[b + 2], p[b + 3]); w.z = cvtpk(p[b + 4], p[b + 5]); w.w = cvtpk(p[b + 6], p[b + 7]);
    return __builtin_bit_cast(bf16x8, w);
}
__device__ __forceinline__ void pv_tile(f32x16 (&o)[2], const LAS3 unsigned char* vb, const Ctx& c, const f32x16& p0, const f32x16& p1) {
    bf16x8 pa[4];
    pa[0] = pack8(p0, 0); pa[1] = pack8(p0, 8); pa[2] = pack8(p1, 0); pa[3] = pack8(p1, 8);
#pragma unroll
    for (int dblk = 0; dblk < 2; ++dblk) {
        const LAS3 unsigned char* vp = vb + (c.vofs0 ^ (unsigned)(dblk * 64));
#pragma unroll
        for (int s = 0; s < 4; ++s) {
            const v4i16_t lo = __builtin_amdgcn_ds_read_tr16_b64_v4i16((LAS3 v4i16_t*)(vp + s * 2048));
            const v4i16_t hi = __builtin_amdgcn_ds_read_tr16_b64_v4i16((LAS3 v4i16_t*)(vp + s * 2048 + 1024));
            const bf16x8 bfr = {lo[0], lo[1], lo[2], lo[3], hi[0], hi[1], hi[2], hi[3]};
            o[dblk] = __builtin_amdgcn_mfma_f32_32x32x16_bf16(pa[s], bfr, o[dblk], 0, 0, 0);
        }
    }
}
__device__ __forceinline__ void rows_to_o(float (&out)[16], float v, LAS3 float* wsf, const Ctx& c) {
    if (c.hi == 0) wsf[c.r32] = v;
    asm volatile("" ::: "memory");
#pragma unroll
    for (int i = 0; i < 4; ++i) {
        const f32x4 t = *(const LAS3 f32x4*)(wsf + 8 * i + 4 * c.hi);
        out[4 * i] = t[0]; out[4 * i + 1] = t[1]; out[4 * i + 2] = t[2]; out[4 * i + 3] = t[3];
    }
    asm volatile("" ::: "memory");
}
__device__ __forceinline__ void softmax_step(f32x16& p0, f32x16& p1, float& m, float& l, f32x16 (&o)[2], LAS3 float* wsf, const Ctx& c) {
    float mx = fmaxf(p0[0], p1[0]);
#pragma unroll
    for (int r = 1; r < 16; ++r) mx = fmaxf(mx, fmaxf(p0[r], p1[r]));
    mx = fmaxf(mx, __shfl_xor(mx, 32));
    const float mnew = fmaxf(m, mx);
    const float msafe = (mnew == NEG_INF) ? 0.f : mnew;
    if (__any(mnew > m)) {
        const float alpha = __builtin_amdgcn_exp2f(m - msafe);
        l *= alpha;
        float a16[16];
        rows_to_o(a16, alpha, wsf, c);
#pragma unroll
        for (int r = 0; r < 16; ++r) { o[0][r] *= a16[r]; o[1][r] *= a16[r]; }
        m = mnew;
    }
    float s = 0.f;
#pragma unroll
    for (int r = 0; r < 16; ++r) { p0[r] = __builtin_amdgcn_exp2f(p0[r] - msafe); p1[r] = __builtin_amdgcn_exp2f(p1[r] - msafe); s += p0[r] + p1[r]; }
    l += s;
}
typedef unsigned u32x4_t __attribute__((ext_vector_type(4)));
struct Stage { u32x4_t k, v; float aux; };
__device__ __forceinline__ void stage_load(Stage& st, const bf16_t* kt, const bf16_t* vt, const float* aux, const Ctx& c) {
    st.k = *(const u32x4_t*)((const unsigned char*)kt + c.tid * 16);
    st.v = *(const u32x4_t*)((const unsigned char*)vt + c.tid * 16);
    if (aux && c.tid < 64) st.aux = aux[c.tid];
}
__device__ __forceinline__ void stage_store(const Stage& st, LAS3 unsigned char* L, int buf, bool has_aux, float aux_scale, float aux_ref, const Ctx& c) {
    *(LAS3 u32x4_t*)(L + L_KV + buf * 16384 + c.stK) = st.k;
    *(LAS3 u32x4_t*)(L + L_KV + buf * 16384 + 8192 + c.stV) = st.v;
    if (has_aux && c.tid < 64) *(LAS3 float*)(L + L_AUX + buf * 256 + c.tid * 4) = (st.aux - aux_ref) * aux_scale;
}

__device__ void fox_unit(unsigned char* ws, unsigned char* ldsg, int b, int h, int qb) {
    const Ctx c = make_ctx();
    LAS3 unsigned char* L = (LAS3 unsigned char*)ldsg;
    LAS3 float* wsf = (LAS3 float*)(L + L_WSF) + c.wid * 64;
    const int t0 = qb * 256;
    const int tw0 = t0 + c.wid * 32;
    const int t = tw0 + c.r32;
    const size_t hb = ((size_t)(b * 4 + h) * SEQ);
    const bf16_t* Q = (const bf16_t*)(ws + WS_QC) + (hb + t) * 64;
    const bf16_t* K = (const bf16_t*)(ws + WS_KCF) + hb * 64;
    const bf16_t* V = (const bf16_t*)(ws + WS_VCF) + hb * 64;
    const float* cf = (const float*)(ws + WS_CFOX) + hb;
    bf16x8 qf[4];
#pragma unroll
    for (int d0 = 0; d0 < 4; ++d0) qf[d0] = *(const bf16x8*)(Q + 16 * d0 + 8 * c.hi);
    const float cref = cf[t0 + 255];
    const float L2E = 1.4426950408889634f;
    float m = NEG_INF, l = 0.f;
    f32x16 o[2]; o[0] = f32x16{}; o[1] = f32x16{};
    const int NT = (t0 + 256) / 64;
    Stage st;
    stage_load(st, K + (size_t)(NT - 1) * 4096, V + (size_t)(NT - 1) * 4096, cf + (NT - 1) * 64, c);
    stage_store(st, L, 0, true, -L2E, cref, c);
    __syncthreads();
    for (int i = 0; i < NT; ++i) {
        const int j = NT - 1 - i, buf = i & 1;
        if (i + 1 < NT) stage_load(st, K + (size_t)(j - 1) * 4096, V + (size_t)(j - 1) * 4096, cf + (j - 1) * 64, c);
        if (j * 64 <= tw0 + 31) {
            const LAS3 unsigned char* kb = L + L_KV + buf * 16384;
            const LAS3 float* aux = (const LAS3 float*)(L + L_AUX + buf * 256);
            f32x16 p0, p1;
#pragma unroll
            for (int i4 = 0; i4 < 4; ++i4) {
                const f32x4 a = *(const LAS3 f32x4*)(aux + 8 * i4 + 4 * c.hi);
                const f32x4 bq = *(const LAS3 f32x4*)(aux + 32 + 8 * i4 + 4 * c.hi);
                p0[4 * i4] = a[0]; p0[4 * i4 + 1] = a[1]; p0[4 * i4 + 2] = a[2]; p0[4 * i4 + 3] = a[3];
                p1[4 * i4] = bq[0]; p1[4 * i4 + 1] = bq[1]; p1[4 * i4 + 2] = bq[2]; p1[4 * i4 + 3] = bq[3];
            }
            qk_tile(p0, p1, kb, c, qf);
            if (j * 64 + 63 > tw0) {
                const int kv0 = j * 64 + 4 * c.hi;
#pragma unroll
                for (int r = 0; r < 16; ++r) {
                    const int kv = kv0 + (r & 3) + 8 * (r >> 2);
                    if (kv > t) p0[r] = NEG_INF;
                    if (kv + 32 > t) p1[r] = NEG_INF;
                }
            }
            softmax_step(p0, p1, m, l, o, wsf, c);
            pv_tile(o, kb + 8192, c, p0, p1);
        }
        if (i + 1 < NT) stage_store(st, L, buf ^ 1, true, -L2E, cref, c);
        __syncthreads();
    }
    l += __shfl_xor(l, 32);
    float f16[16];
    rows_to_o(f16, 1.f / l, wsf, c);
    const bf16_t* Z = (const bf16_t*)(ws + WS_ZC);
    bf16_t* cat = (bf16_t*)(ws + WS_CAT);
#pragma unroll
    for (int r = 0; r < 16; ++r) {
        const size_t mrow = (size_t)b * SEQ + tw0 + crow(r, c.hi);
#pragma unroll
        for (int dblk = 0; dblk < 2; ++dblk) {
            const int d = 32 * dblk + c.r32;
            const float z = bf2f(Z[mrow * 256 + h * 64 + d]);
            cat[mrow * DM + 768 + h * 64 + d] = (bf16_t)f2bf(o[dblk][r] * f16[r] * (z / (1.f + __expf(-z))));
        }
    }
    __syncthreads();
}
}

__device__ void phase_fox(unsigned char* ws, unsigned char* ldsg) {
    const int nunits = BATCH * 4 * 16;
    for (int u = blockIdx.x; u < nunits; u += gridDim.x) {
        const int k_ = (u % 256) / (BATCH * 4), bh = u % (BATCH * 4); const int qb = u < 256 ? 15 - k_ : k_;
        att::fox_unit(ws, ldsg, bh >> 2, bh & 3, qb);
    }
}

namespace att {
constexpr int L_IMPM = 40960, L_IMPS = 57344, L_OTOT = 73728;
__device__ __forceinline__ f32x16 splat16(float v) { f32x16 r;
#pragma unroll
    for (int i = 0; i < 16; ++i) r[i] = v;
    return r; }
__device__ __forceinline__ void stats_step(const f32x16& p0, const f32x16& p1, float& m, float& l) {
    float mx = fmaxf(p0[0], p1[0]);
#pragma unroll
    for (int r = 1; r < 16; ++r) mx = fmaxf(mx, fmaxf(p0[r], p1[r]));
    mx = fmaxf(mx, __shfl_xor(mx, 32));
    const float mnew = fmaxf(m, mx);
    const float msafe = (mnew == NEG_INF) ? 0.f : mnew;
    l *= __builtin_amdgcn_exp2f(m - msafe);
    float s = 0.f;
#pragma unroll
    for (int r = 0; r < 16; ++r) s += __builtin_amdgcn_exp2f(p0[r] - msafe) + __builtin_amdgcn_exp2f(p1[r] - msafe);
    l += s;
    m = mnew;
}
__device__ __forceinline__ void bias_mask(f32x16& p0, f32x16& p1, const LAS3 float* bt, int t, int kp0, int kstride, int lo) {
#pragma unroll
    for (int r = 0; r < 16; ++r) {
        const int kl = (r & 3) + 8 * (r >> 2);
        const int ka = kp0 + kstride * kl, kb = ka + 32 * kstride;
        const int da = t - ka, db = t - kb;
        const float ba = bt[min(max(da, 0), 127)], bb = bt[min(max(db, 0), 127)];
        p0[r] = (da < 0 || ka < lo) ? NEG_INF : p0[r] + ba;
        p1[r] = (db < 0 || kb < lo) ? NEG_INF : p1[r] + bb;
        if ((r & 3) == 3) asm volatile("" ::: "memory");
    }
}

__device__ void nsa_unit(const Params& p, unsigned char* ws, unsigned char* ldsg, int b, int g, int qt) {
    const Ctx c = make_ctx();
    LAS3 unsigned char* L = (LAS3 unsigned char*)ldsg;
    LAS3 float* wsf = (LAS3 float*)(L + L_WSF) + c.wid * 64;
    LAS3 float* btab = (LAS3 float*)(L + L_BTAB);
    LAS3 float* impm = (LAS3 float*)(L + L_IMPM);
    LAS3 float* imps = (LAS3 float*)(L + L_IMPS);
    const float L2E = 1.4426950408889634f;
    const int t0 = qt * 64;
    const int ql = c.r32 >> 2, head = c.r32 & 3;
    const int qloc = 8 * c.wid + ql;
    const int t = t0 + qloc;
    const size_t mrow = (size_t)b * SEQ + t;
    btab[c.tid] = p.rel_bias[bucket_of(c.tid & 127) * 8 + g * 4 + (c.tid >> 7)] * L2E;
    bf16x8 qf[4];
    {
        const bf16_t* Q = (const bf16_t*)(ws + WS_QB) + mrow * 512 + g * 256 + head * 64;
#pragma unroll
        for (int d0 = 0; d0 < 4; ++d0) qf[d0] = *(const bf16x8*)(Q + 16 * d0 + 8 * c.hi);
    }
    const float* gfr = (const float*)(ws + WS_GF) + mrow * 32 + (g * 4 + head) * 3;
    __syncthreads();
    const LAS3 float* bt = btab + head * 128;
    const float b31 = bt[127];
    const size_t gb = (size_t)(b * 2 + g);
    LAS3 float* otl = (LAS3 float*)(L + L_OTOT) + c.wid * 2048 + c.r32;
    f32x16 o[2];
    Stage st;
    const bf16_t* KC = (const bf16_t*)(ws + WS_KCMP) + gb * 256 * 64;
    const bf16_t* VC = (const bf16_t*)(ws + WS_KCMP) + ((size_t)BATCH * 2 + gb) * 256 * 64;
    const int NTC = ((4 * qt + 2) >> 6) + 1;
    float mc = NEG_INF, lc = 0.f;
    stage_load(st, KC, VC, nullptr, c);
    stage_store(st, L, 0, false, 0.f, 0.f, c);
    __syncthreads();
    for (int jc = 0; jc < NTC; ++jc) {
        const int buf = jc & 1;
        if (jc + 1 < NTC) stage_load(st, KC + (size_t)(jc + 1) * 4096, VC + (size_t)(jc + 1) * 4096, nullptr, c);
        {
            f32x16 p0 = f32x16{}, p1 = f32x16{};
            qk_tile(p0, p1, L + L_KV + buf * 16384, c, qf);
            bias_mask(p0, p1, bt, t, 16 * (64 * jc + 4 * c.hi) + 31, 16, -(1 << 30));
            stats_step(p0, p1, mc, lc);
        }
        if (jc + 1 < NTC) stage_store(st, L, buf ^ 1, false, 0.f, 0.f, c);
        __syncthreads();
    }
    lc += __shfl_xor(lc, 32);
    const float mcs = (mc == NEG_INF) ? 0.f : mc;
    const float rlc = lc > 0.f ? 1.f / lc : 0.f;
    o[0] = f32x16{}; o[1] = f32x16{};
    stage_load(st, KC, VC, nullptr, c);
    stage_store(st, L, 0, false, 0.f, 0.f, c);
    __syncthreads();
    for (int jc = 0; jc < NTC; ++jc) {
        const int buf = jc & 1;
        if (jc + 1 < NTC) stage_load(st, KC + (size_t)(jc + 1) * 4096, VC + (size_t)(jc + 1) * 4096, nullptr, c);
        {
            f32x16 p0 = f32x16{}, p1 = f32x16{};
            qk_tile(p0, p1, L + L_KV + buf * 16384, c, qf);
            bias_mask(p0, p1, bt, t, 16 * (64 * jc + 4 * c.hi) + 31, 16, -(1 << 30));
#pragma unroll
            for (int r = 0; r < 16; ++r) { p0[r] = __builtin_amdgcn_exp2f(p0[r] - mcs) * rlc; p1[r] = __builtin_amdgcn_exp2f(p1[r] - mcs) * rlc; }
#pragma unroll
            for (int blk = 0; blk < 2; ++blk)
#pragma unroll
                for (int i = 0; i < 4; ++i) {
                    const float x0 = blk ? p1[4 * i] : p0[4 * i], x1 = blk ? p1[4 * i + 1] : p0[4 * i + 1], x2 = blk ? p1[4 * i + 2] : p0[4 * i + 2], x3 = blk ? p1[4 * i + 3] : p0[4 * i + 3];
                    float a = (x0 + x1) + (x2 + 0.5f * x3), sp = 0.5f * x3;
                    a += __shfl_xor(a, 1); sp += __shfl_xor(sp, 1);
                    a += __shfl_xor(a, 2); sp += __shfl_xor(sp, 2);
                    const int sidx = 16 * jc + 8 * blk + 2 * i + c.hi;
                    if (head == 0) { impm[qloc * 64 + sidx] = a; if (sidx + 1 < 64) imps[qloc * 64 + sidx + 1] = sp; }
                }
            pv_tile(o, L + L_KV + buf * 16384 + 8192, c, p0, p1);
        }
        if (jc + 1 < NTC) stage_store(st, L, buf ^ 1, false, 0.f, 0.f, c);
        __syncthreads();
    }
    {
        float f16[16];
        rows_to_o(f16, 1.f / (1.f + __expf(-gfr[0])), wsf, c);
#pragma unroll
        for (int r = 0; r < 16; ++r) { otl[crow(r, c.hi) * 64] = o[0][r] * f16[r]; otl[crow(r, c.hi) * 64 + 32] = o[1][r] * f16[r]; }
    }
    unsigned long long mymask = 0ull;
    for (int q2 = 0; q2 < 8; ++q2) {
        const int qq = 8 * c.wid + q2;
        float imp = impm[qq * 64 + c.lane] + (c.lane > 0 ? imps[qq * 64 + c.lane] : 0.f);
        if (c.lane == 0 || c.lane == qt || c.lane == qt - 1) imp = 1e4f;
        if (c.lane > qt) imp = -1e4f;
        unsigned long long mask = 0ull;
        for (int r = 0; r < 16; ++r) {
            float mx = imp;
#pragma unroll
            for (int off = 32; off > 0; off >>= 1) mx = fmaxf(mx, __shfl_xor(mx, off));
            const unsigned long long bal = __ballot(imp == mx);
            const int sel = __ffsll((long long)bal) - 1;
            mask |= 1ull << sel;
            if (c.lane == sel) imp = NEG_INF;
        }
        if (ql == q2) mymask = mask;
    }
    {
        const bf16_t* K = (const bf16_t*)(ws + WS_KSL) + gb * SEQ * 64;
        const bf16_t* V = (const bf16_t*)(ws + WS_VSL) + gb * SEQ * 64;
        float m = NEG_INF, l = 0.f;
        o[0] = f32x16{}; o[1] = f32x16{};
        const int NT = qt + 1;
        stage_load(st, K, V, nullptr, c);
        stage_store(st, L, 0, false, 0.f, 0.f, c);
        __syncthreads();
        for (int j = 0; j < NT; ++j) {
            const int buf = j & 1;
            if (j + 1 < NT) stage_load(st, K + (size_t)(j + 1) * 4096, V + (size_t)(j + 1) * 4096, nullptr, c);
            const bool sel = (mymask >> j) & 1ull;
            if (__any(sel)) {
                const bool nearby = j + 2 >= qt;
                const float init = sel ? (nearby ? 0.f : b31) : NEG_INF;
                f32x16 p0 = splat16(init), p1 = splat16(init);
                qk_tile(p0, p1, L + L_KV + buf * 16384, c, qf);
                if (nearby) bias_mask(p0, p1, bt, t, 64 * j + 4 * c.hi, 1, -(1 << 30));
                softmax_step(p0, p1, m, l, o, wsf, c);
                pv_tile(o, L + L_KV + buf * 16384 + 8192, c, p0, p1);
            }
            if (j + 1 < NT) stage_store(st, L, buf ^ 1, false, 0.f, 0.f, c);
            __syncthreads();
        }
        l += __shfl_xor(l, 32);
        float f16[16];
        rows_to_o(f16, l > 0.f ? 1.f / ((1.f + __expf(-gfr[1])) * l) : 0.f, wsf, c);
#pragma unroll
        for (int r = 0; r < 16; ++r) { otl[crow(r, c.hi) * 64] += o[0][r] * f16[r]; otl[crow(r, c.hi) * 64 + 32] += o[1][r] * f16[r]; }
    }
    {
        const bf16_t* K = (const bf16_t*)(ws + WS_KWN) + gb * SEQ * 64;
        const bf16_t* V = (const bf16_t*)(ws + WS_VWN) + gb * SEQ * 64;
        float m = NEG_INF, l = 0.f;
        o[0] = f32x16{}; o[1] = f32x16{};
        const int jlo = qt - 8 > 0 ? qt - 8 : 0;
        const int NT = qt - jlo + 1;
        stage_load(st, K + (size_t)qt * 4096, V + (size_t)qt * 4096, nullptr, c);
        stage_store(st, L, 0, false, 0.f, 0.f, c);
        __syncthreads();
        for (int i = 0; i < NT; ++i) {
            const int j = qt - i, buf = i & 1;
            if (i + 1 < NT) stage_load(st, K + (size_t)(j - 1) * 4096, V + (size_t)(j - 1) * 4096, nullptr, c);
            {
                const bool nearby = j + 2 >= qt, edge = (j == qt - 8);
                const float init = nearby ? 0.f : b31;
                f32x16 p0 = splat16(init), p1 = splat16(init);
                qk_tile(p0, p1, L + L_KV + buf * 16384, c, qf);
                if (nearby) bias_mask(p0, p1, bt, t, 64 * j + 4 * c.hi, 1, -(1 << 30));
                else if (edge) {
                    const int lo = t - 511, kp0 = 64 * j + 4 * c.hi;
#pragma unroll
                    for (int r = 0; r < 16; ++r) {
                        const int ka = kp0 + (r & 3) + 8 * (r >> 2);
                        if (ka < lo) p0[r] = NEG_INF;
                        if (ka + 32 < lo) p1[r] = NEG_INF;
                    }
                }
                softmax_step(p0, p1, m, l, o, wsf, c);
                pv_tile(o, L + L_KV + buf * 16384 + 8192, c, p0, p1);
            }
            if (i + 1 < NT) stage_store(st, L, buf ^ 1, false, 0.f, 0.f, c);
            __syncthreads();
        }
        l += __shfl_xor(l, 32);
        float f16[16];
        rows_to_o(f16, l > 0.f ? 1.f / ((1.f + __expf(-gfr[2])) * l) : 0.f, wsf, c);
#pragma unroll
        for (int r = 0; r < 16; ++r) { otl[crow(r, c.hi) * 64] += o[0][r] * f16[r]; otl[crow(r, c.hi) * 64 + 32] += o[1][r] * f16[r]; }
    }
    {
        const bf16_t* Z = (const bf16_t*)(ws + WS_ZB);
        bf16_t* cat = (bf16_t*)(ws + WS_CAT);
#pragma unroll
        for (int r = 0; r < 16; ++r) {
            const int row = crow(r, c.hi);
            const size_t mr = (size_t)b * SEQ + t0 + 8 * c.wid + (row >> 2);
            const int h8 = g * 4 + (row & 3);
#pragma unroll
            for (int dblk = 0; dblk < 2; ++dblk) {
                const int d = 32 * dblk + c.r32;
                const float z = bf2f(Z[mr * 512 + h8 * 64 + d]);
                cat[mr * DM + 256 + h8 * 64 + d] = (bf16_t)f2bf(otl[row * 64 + 32 * dblk] * (z / (1.f + __expf(-z))));
            }
        }
    }
    __syncthreads();
}
}
__device__ void phase_nsa(const Params& p, unsigned char* ws, unsigned char* ldsg) {
    const int nunits = BATCH * 2 * 64;
    for (int u = blockIdx.x; u < nunits; u += gridDim.x) {
        const int qt = 63 - u / (BATCH * 2), bg = u % (BATCH * 2);
        att::nsa_unit(p, ws, ldsg, bg >> 1, bg & 1, qt);
    }
}

namespace att {
constexpr float SB_EXIT = 160.f;
__device__ void sb_unit(unsigned char* ws, unsigned char* ldsg, int b, int h, int qb) {
    const Ctx c = make_ctx();
    LAS3 unsigned char* L = (LAS3 unsigned char*)ldsg;
    const int t0 = qb * 256;
    const int tw0 = t0 + c.wid * 32;
    const int t = tw0 + c.r32;
    const size_t hb = ((size_t)(b * 4 + h) * SEQ);
    const bf16_t* Q = (const bf16_t*)(ws + WS_QA) + (hb + t) * 64;
    const bf16_t* K = (const bf16_t*)(ws + WS_KA) + hb * 64;
    const bf16_t* V = (const bf16_t*)(ws + WS_VA) + hb * 64;
    bf16x8 qf[4];
#pragma unroll
    for (int d0 = 0; d0 < 4; ++d0) qf[d0] = *(const bf16x8*)(Q + 16 * d0 + 8 * c.hi);
    float carry = 0.f;
    f32x16 o[2]; o[0] = f32x16{}; o[1] = f32x16{};
    const int NT = (t0 + 256) / 64;
    Stage st;
    stage_load(st, K + (size_t)(NT - 1) * 4096, V + (size_t)(NT - 1) * 4096, nullptr, c);
    stage_store(st, L, 0, false, 0.f, 0.f, c);
    __syncthreads();
    for (int i = 0; i < NT; ++i) {
        const int j = NT - 1 - i, buf = i & 1;
        if (i + 1 < NT) stage_load(st, K + (size_t)(j - 1) * 4096, V + (size_t)(j - 1) * 4096, nullptr, c);
        const bool wdone = !__any(carry <= SB_EXIT);
        if (j * 64 <= tw0 + 31 && !wdone) {
            const LAS3 unsigned char* kb = L + L_KV + buf * 16384;
            f32x16 z0 = f32x16{}, z1 = f32x16{};
            qk_tile(z0, z1, kb, c, qf);
            const int kv0 = j * 64 + 4 * c.hi;
            f32x16 e0, e1;
#pragma unroll
            for (int r = 0; r < 16; ++r) {
                const int kv = kv0 + (r & 3) + 8 * (r >> 2);
                const float a0 = z0[r], a1 = z1[r];
                const float s0 = fmaxf(a0, 0.f) + __builtin_amdgcn_logf(1.f + __builtin_amdgcn_exp2f(-fabsf(a0)));
                const float s1 = fmaxf(a1, 0.f) + __builtin_amdgcn_logf(1.f + __builtin_amdgcn_exp2f(-fabsf(a1)));
                e0[r] = kv < t ? s0 : 0.f;
                e1[r] = kv + 32 < t ? s1 : 0.f;
            }
            float cs[2][4], pc[2][4], after[2][4];
#pragma unroll
            for (int i4 = 0; i4 < 4; ++i4) {
                cs[0][i4] = (e0[4 * i4] + e0[4 * i4 + 1]) + (e0[4 * i4 + 2] + e0[4 * i4 + 3]);
                cs[1][i4] = (e1[4 * i4] + e1[4 * i4 + 1]) + (e1[4 * i4 + 2] + e1[4 * i4 + 3]);
                pc[0][i4] = __shfl_xor(cs[0][i4], 32);
                pc[1][i4] = __shfl_xor(cs[1][i4], 32);
            }
            float run = 0.f;
#pragma unroll
            for (int blk = 1; blk >= 0; --blk)
#pragma unroll
                for (int i4 = 3; i4 >= 0; --i4) { after[blk][i4] = run + (c.hi == 0 ? pc[blk][i4] : 0.f); run += cs[blk][i4] + pc[blk][i4]; }
#pragma unroll
            for (int i4 = 0; i4 < 4; ++i4) {
                {
                    const float base = carry + after[0][i4];
                    const float s3 = base + e0[4 * i4 + 3], s2 = s3 + e0[4 * i4 + 2], s1 = s2 + e0[4 * i4 + 1], s0 = s1 + e0[4 * i4];
                    const int kv = kv0 + 8 * i4;
                    z0[4 * i4] = kv < t ? __builtin_amdgcn_exp2f(z0[4 * i4] - s0) : 0.f;
                    z0[4 * i4 + 1] = kv + 1 < t ? __builtin_amdgcn_exp2f(z0[4 * i4 + 1] - s1) : 0.f;
                    z0[4 * i4 + 2] = kv + 2 < t ? __builtin_amdgcn_exp2f(z0[4 * i4 + 2] - s2) : 0.f;
                    z0[4 * i4 + 3] = kv + 3 < t ? __builtin_amdgcn_exp2f(z0[4 * i4 + 3] - s3) : 0.f;
                }
                {
                    const float base = carry + after[1][i4];
                    const float s3 = base + e1[4 * i4 + 3], s2 = s3 + e1[4 * i4 + 2], s1 = s2 + e1[4 * i4 + 1], s0 = s1 + e1[4 * i4];
                    const int kv = kv0 + 32 + 8 * i4;
                    z1[4 * i4] = kv < t ? __builtin_amdgcn_exp2f(z1[4 * i4] - s0) : 0.f;
                    z1[4 * i4 + 1] = kv + 1 < t ? __builtin_amdgcn_exp2f(z1[4 * i4 + 1] - s1) : 0.f;
                    z1[4 * i4 + 2] = kv + 2 < t ? __builtin_amdgcn_exp2f(z1[4 * i4 + 2] - s2) : 0.f;
                    z1[4 * i4 + 3] = kv + 3 < t ? __builtin_amdgcn_exp2f(z1[4 * i4 + 3] - s3) : 0.f;
                }
            }
            carry += run;
            pv_tile(o, kb + 8192, c, z0, z1);
        }
        if (i + 1 < NT) stage_store(st, L, buf ^ 1, false, 0.f, 0.f, c);
        const bool wdone2 = !__any(carry <= SB_EXIT);
        if (!__syncthreads_or(wdone2 ? 0 : 1)) break;
    }
    const bf16_t* Z = (const bf16_t*)(ws + WS_ZA);
    bf16_t* cat = (bf16_t*)(ws + WS_CAT);
#pragma unroll
    for (int r = 0; r < 16; ++r) {
        const size_t mrow = (size_t)b * SEQ + tw0 + crow(r, c.hi);
#pragma unroll
        for (int dblk = 0; dblk < 2; ++dblk) {
            const int d = 32 * dblk + c.r32;
            const float z = bf2f(Z[mrow * 256 + h * 64 + d]);
            cat[mrow * DM + h * 64 + d] = (bf16_t)f2bf(o[dblk][r] * (z / (1.f + __expf(-z))));
        }
    }
    __syncthreads();
}
}

namespace pg8 {
struct EpiCompress {
    static constexpr bool PERM = false, AFTER_DRAIN = true;
    const float* bias1;
    const bf16_t* w2t;
    bf16_t* outp;
    __device__ __forceinline__ void fused(f32x4 (&acc)[2][2][4][2], const Unit& u, int wr, int wc, int fr, int fq, PG8_LAS unsigned char* lds, int wid, int lane) const {
        constexpr int PITCH = 528;
#pragma unroll
        for (int bj = 0; bj < 2; ++bj)
#pragma unroll
            for (int n = 0; n < 2; ++n) {
                const int col = bj * HALF + wc * 32 + n * 16 + 4 * fq;
                const f32x4 bv = *(const f32x4*)(bias1 + col);
#pragma unroll
                for (int ai = 0; ai < 2; ++ai)
#pragma unroll
                    for (int m = 0; m < 4; ++m) {
                        const int row = ai * HALF + wr * 64 + m * 16 + fr;
                        f32x4 v = acc[ai][bj][m][n] + bv;
#pragma unroll
                        for (int e = 0; e < 4; ++e) v[e] = v[e] / (1.f + __expf(-v[e]));
                        typedef unsigned u32x2_t __attribute__((ext_vector_type(2)));
                        u32x2_t w; w.x = pk2(v[0], v[1]); w.y = pk2(v[2], v[3]);
                        *(PG8_LAS u32x2_t*)(lds + row * PITCH + col * 2) = w;
                    }
            }
        asm volatile("s_waitcnt lgkmcnt(0)" ::: "memory"); __builtin_amdgcn_s_barrier(); asm volatile("" ::: "memory");
        typedef float f32x16 __attribute__((ext_vector_type(16)));
        const int r32 = lane & 31, hi = lane >> 5;
        f32x16 o0 = f32x16{}, o1 = f32x16{};
#pragma unroll
        for (int s = 0; s < 16; ++s) {
            const bf16x8 a = *(const PG8_LAS bf16x8*)(lds + (wid * 32 + r32) * PITCH + (16 * s + 8 * hi) * 2);
            const bf16x8 b0 = *(const bf16x8*)(w2t + (size_t)r32 * 256 + 16 * s + 8 * hi);
            const bf16x8 b1 = *(const bf16x8*)(w2t + (size_t)(32 + r32) * 256 + 16 * s + 8 * hi);
            o0 = __builtin_amdgcn_mfma_f32_32x32x16_bf16(a, b0, o0, 0, 0, 0);
            o1 = __builtin_amdgcn_mfma_f32_32x32x16_bf16(a, b1, o1, 0, 0, 0);
        }
        bf16_t* op = outp + ((size_t)u.pm * 256 + wid * 32) * 64;
#pragma unroll
        for (int r = 0; r < 16; ++r) {
            const int row = (r & 3) + 8 * (r >> 2) + 4 * hi;
            const bool pad = (wid * 32 + row) == 255;
            op[(size_t)row * 64 + r32] = pad ? (bf16_t)0 : (bf16_t)f2bf(o0[r]);
            op[(size_t)row * 64 + 32 + r32] = pad ? (bf16_t)0 : (bf16_t)f2bf(o1[r]);
        }
        asm volatile("s_waitcnt lgkmcnt(0)" ::: "memory"); __builtin_amdgcn_s_barrier(); asm volatile("" ::: "memory");
    }
};
}
__device__ void phase_mid(const Params& p, int layer, unsigned char* ws, unsigned char* ldsg, PG8_LAS unsigned char* lds3) {
    const int G = (int)gridDim.x;
    if (blockIdx.x < 32) {
        const int which = blockIdx.x >> 4;
        const int lw = layer * 2 + which;
        pg8::Gemm g{(const bf16_t*)(ws + (which ? WS_VC : WS_KC)), (const bf16_t*)(ws + WS_W1T) + (size_t)lw * 256 * 2048, BATCH * 2 * 256, 256, 2048, 1024, 2048};
        pg8::StaticOrder S; S.init(BATCH * 2 * 256, 256, G, (int)(blockIdx.x & 15));
        pg8::EpiCompress E{(const float*)(ws + WS_BIAS1) + lw * 256, (const bf16_t*)(ws + WS_W2T) + (size_t)lw * 64 * 256, (bf16_t*)(ws + WS_KCMP) + (size_t)which * BATCH * 2 * 256 * 64};
        pg8::gemm_phase<pg8::EpiCompress, pg8::StaticOrder, false, true>(lds3, g, S, E);
    } else {
        const int tid_ = otid();
        const int bi = (int)blockIdx.x - 32;
        if (bi < 32 && (tid_ >> 6) == 0) {
            const int lane = tid_ & 63, b = bi >> 2, h = bi & 3;
            const float* gf = (const float*)(ws + WS_GF);
            float* cfox = (float*)(ws + WS_CFOX);
            const float fb = p.forget_b[layer * 4 + h];
            double s = 0.0;
            for (int i = 0; i < 64; ++i) {
                const float v = gf[((size_t)b * SEQ + 64 * lane + i) * 32 + 24 + h] + fb;
                s += (double)(fminf(v, 0.f) - log1pf(expf(-fabsf(v))));
            }
            double incl = s;
#pragma unroll
            for (int o = 1; o < 64; o <<= 1) { const double tt = __shfl_up(incl, o); if (lane >= o) incl += tt; }
            double run = incl - s;
            for (int i = 0; i < 64; ++i) {
                const float v = gf[((size_t)b * SEQ + 64 * lane + i) * 32 + 24 + h] + fb;
                run += (double)(fminf(v, 0.f) - log1pf(expf(-fabsf(v))));
                cfox[((size_t)(b * 4 + h)) * SEQ + 64 * lane + i] = (float)run;
            }
        }
        const int nunits = BATCH * 4 * 16;
        for (int u = bi; u < nunits; u += G - 32) {
            const int qb = 15 - u / (BATCH * 4), bh = u % (BATCH * 4);
            att::sb_unit(ws, ldsg, bh >> 2, bh & 3, qb);
        }
    }
}

__global__ void __launch_bounds__(NTHREADS, 2) mega(Params p) {
    cg::grid_group grid = cg::this_grid();
    extern __shared__ __attribute__((aligned(16))) unsigned char lds[];
    PG8_LAS unsigned char* lds3 = (PG8_LAS unsigned char*)lds;
    unsigned char* ws = p.ws;
    bf16_t* xb = (bf16_t*)(ws + WS_XB);
    bf16_t* cat = (bf16_t*)(ws + WS_CAT);
    float* ss = (float*)(ws + WS_SS);

    p0_weights(p);
    phase_convert_x(p.x, xb, ss);
    grid.sync();
    for (int layer = 0; layer < DEPTH; ++layer) {
        const float* xin = layer == 0 ? p.x : p.out;
        {
            pg8::Gemm g{xb, (const bf16_t*)(ws + WS_WTIN) + (size_t)layer * NPAD * DM, MTOK, NPAD, DM, DM, DM};
            pg8::StaticOrder S; S.init(MTOK, NPAD, (int)gridDim.x, (int)blockIdx.x);
            pg8::EpiInProj E{ws, ss};
            pg8::gemm_phase<pg8::EpiInProj, pg8::StaticOrder, true, true>(lds3, g, S, E);
        }
        grid.sync();
        phase_mid(p, layer, ws, lds, lds3);
        grid.sync();
        phase_fox(ws, lds);
        phase_nsa(p, ws, lds);
        grid.sync();
        {
            pg8::Gemm g{cat, (const bf16_t*)(ws + WS_WTOUT) + (size_t)layer * DM * DM, MTOK, DM, DM, DM, DM};
            pg8::StaticOrder S; S.init(MTOK, DM, (int)gridDim.x, (int)blockIdx.x);
            pg8::EpiOutProj E{xin, p.out};
            pg8::gemm_phase<pg8::EpiOutProj, pg8::StaticOrder, true, true>(lds3, g, S, E);
        }
        grid.sync();
        if (layer == 0) { phase_convert_x(p.out, xb, ss); grid.sync(); }
    }
    phase_final_norm(p.out, p.final_g);
}

extern "C" void kernel_launch(void* const* d_in, const int* in_sizes, int n_in, void* d_out, int out_size, void* d_ws, size_t ws_size, hipStream_t stream) {
    static int grid_blocks = 0;
    if (!grid_blocks) {
        if (ws_size < WS_END) { fprintf(stderr, "kernel_launch: workspace too small (%zu < %zu)\n", ws_size, (size_t)WS_END); grid_blocks = -1; return; }
        int dev = 0, cus = 0, per_cu = 0;
        (void)hipGetDevice(&dev);
        (void)hipDeviceGetAttribute(&cus, hipDeviceAttributeMultiprocessorCount, dev);
        (void)hipFuncSetAttribute((const void*)mega, hipFuncAttributeMaxDynamicSharedMemorySize, LDS_BYTES);
        (void)hipOccupancyMaxActiveBlocksPerMultiprocessor(&per_cu, mega, NTHREADS, LDS_BYTES);
        if (per_cu < 1) { fprintf(stderr, "kernel_launch: occupancy query says %d blocks/CU\n", per_cu); per_cu = 1; }
        grid_blocks = cus;
    }
    if (grid_blocks < 0) return;
    Params p{};
    p.x = (const float*)d_in[0]; p.norm_g = (const float*)d_in[1]; p.w_in = (const float*)d_in[2]; p.w_out = (const float*)d_in[3];
    p.forget_b = (const float*)d_in[4]; p.cmp_w1 = (const float*)d_in[5]; p.cmp_b1 = (const float*)d_in[6]; p.cmp_w2 = (const float*)d_in[7];
    p.cmp_pe = (const float*)d_in[8]; p.rel_bias = (const float*)d_in[9]; p.final_g = (const float*)d_in[10];
    p.out = (float*)d_out; p.ws = (unsigned char*)d_ws;
    void* args[] = {&p};
    hipError_t e = hipLaunchCooperativeKernel((void*)mega, dim3(grid_blocks), dim3(NTHREADS), args, LDS_BYTES, stream);
    if (e != hipSuccess) fprintf(stderr, "cooperative launch failed: %s (grid %d)\n", hipGetErrorString(e), grid_blocks);
}
```

```cpp
#include <hip/hip_runtime.h>
#include <hip/hip_cooperative_groups.h>
#include <cstdio>
#include <cstdint>
namespace cg = cooperative_groups;
#define PROBE_FOX 1
#define PROBE_NSA 1
#define PROBE_MID 1
#define PROBE_INP 1
#define PROBE_P0 1
#define PROBE_CVT 1
#define PROBE_ATT 1
#define PROBE_OUT 1
#define PROBE_TOPK 1
#define PROBE_SEL 1
#define PROBE_WIN 1

constexpr int DM = 1024, BATCH = 8, SEQ = 4096, DEPTH = 2, HD = 64, MTOK = BATCH * SEQ;
constexpr int INW = 3868, NPAD = 4096;
constexpr int C_QA = 0, C_KA = 256, C_VA = 512, C_ZA = 768, C_QB = 1024, C_KC = 1536, C_VC = 1664, C_KSL = 1792, C_VSL = 1920,
              C_KWN = 2048, C_VWN = 2176, C_GB = 2304, C_ZB = 2328, C_QC = 2840, C_KCF = 3096, C_VCF = 3352, C_FC = 3608, C_ZC = 3612;
constexpr int NCMP = 255;
constexpr float QSCALE = 0.125f * 1.4426950408889634f;
constexpr float LN2 = 0.6931471805599453f;
constexpr size_t MiB = 1u << 20;
constexpr size_t WS_WTIN = 0, WS_WTOUT = 16 * MiB, WS_W1T = 20 * MiB, WS_W2T = 24 * MiB, WS_BIAS1 = 25 * MiB, WS_SS = 25 * MiB + 512 * 1024, WS_CTR = 25 * MiB + 768 * 1024,
                 WS_CFOX = 26 * MiB, WS_SEL = 27 * MiB, WS_KCMP = 28 * MiB, WS_GF = 30 * MiB, WS_XB = 36 * MiB, WS_CAT = 100 * MiB,
                 WS_QA = 164 * MiB, WS_KA = 180 * MiB, WS_VA = 196 * MiB, WS_ZA = 212 * MiB, WS_QB = 228 * MiB, WS_KC = 260 * MiB, WS_VC = 268 * MiB,
                 WS_KSL = 276 * MiB, WS_VSL = 284 * MiB, WS_KWN = 292 * MiB, WS_VWN = 300 * MiB, WS_ZB = 308 * MiB, WS_QC = 340 * MiB, WS_KCF = 356 * MiB,
                 WS_VCF = 372 * MiB, WS_ZC = 388 * MiB, WS_DBG_PROJF = 404 * MiB, WS_DBG_OCMP = 466 * MiB, WS_DBG_KCMPF = 475 * MiB, WS_END = 480 * MiB;
constexpr int LDS_BYTES = 152576;
constexpr int NTHREADS = 512, NWAVES = 8;

typedef unsigned short bf16_t;
__device__ __forceinline__ float bf2f(bf16_t v) { return __uint_as_float((unsigned)v << 16); }
__device__ __forceinline__ unsigned f2bf(float f) { unsigned u = __float_as_uint(f); return (u + 0x7fffu + ((u >> 16) & 1u)) >> 16; }
__device__ __forceinline__ unsigned pk2(float lo, float hi) { return f2bf(lo) | (f2bf(hi) << 16); }

__constant__ unsigned char c_bucket[128] = {0, 1, 2, 3, 4, 5, 6, 7, 8, 9, 10, 11, 12, 13, 14, 15, 16, 16, 16, 17, 17, 18, 18, 18, 19, 19, 19, 20, 20, 20, 20, 21, 21, 21, 21, 22, 22, 22, 22, 22, 23, 23, 23, 23, 23, 23, 24, 24, 24, 24, 24, 24, 25, 25, 25, 25, 25, 25, 25, 26, 26, 26, 26, 26, 26, 26, 26, 27, 27, 27, 27, 27, 27, 27, 27, 27, 27, 28, 28, 28, 28, 28, 28, 28, 28, 28, 28, 29, 29, 29, 29, 29, 29, 29, 29, 29, 29, 29, 29, 30, 30, 30, 30, 30, 30, 30, 30, 30, 30, 30, 30, 30, 30, 31, 31, 31, 31, 31, 31, 31, 31, 31, 31, 31, 31, 31, 31, 31};

struct Params {
    const float *x, *norm_g, *w_in, *w_out, *forget_b, *cmp_w1, *cmp_b1, *cmp_w2, *cmp_pe, *rel_bias, *final_g;
    float* out;
    unsigned char* ws;
};

template <int CTRL> __device__ __forceinline__ float dppf(float v) { return __int_as_float(__builtin_amdgcn_update_dpp(0, __float_as_int(v), CTRL, 0xF, 0xF, true)); }
__device__ __forceinline__ float rdlane(float v, int l) { return __int_as_float(__builtin_amdgcn_readlane(__float_as_int(v), l)); }
__device__ __forceinline__ float wave_sum(float v) {
    v += dppf<0xB1>(v); v += dppf<0x4E>(v); v += dppf<0x141>(v); v += dppf<0x140>(v);
    return (rdlane(v, 0) + rdlane(v, 16)) + (rdlane(v, 32) + rdlane(v, 48));
}
__device__ __forceinline__ float wave_max(float v) {
    v = fmaxf(v, dppf<0xB1>(v)); v = fmaxf(v, dppf<0x4E>(v)); v = fmaxf(v, dppf<0x141>(v)); v = fmaxf(v, dppf<0x140>(v));
    return fmaxf(fmaxf(rdlane(v, 0), rdlane(v, 16)), fmaxf(rdlane(v, 32), rdlane(v, 48)));
}
__device__ __forceinline__ void pair32(float v, float& lo, float& hi) { auto rr = __builtin_amdgcn_permlane32_swap(__float_as_uint(v), __float_as_uint(v), false, false); lo = __uint_as_float(rr[0]); hi = __uint_as_float(rr[1]); }
__device__ __forceinline__ float pair_max(float v) { float a, b; pair32(v, a, b); return fmaxf(a, b); }
__device__ __forceinline__ float pair_sum(float v) { float a, b; pair32(v, a, b); return a + b; }
__device__ __forceinline__ float pair_other(float v, int hi) { float a, b; pair32(v, a, b); return hi ? a : b; }
__device__ __forceinline__ float sigmoidf_(float v) { return 1.f / (1.f + expf(-v)); }
__device__ __forceinline__ float siluf_(float v) { return v / (1.f + expf(-v)); }
__device__ __forceinline__ float softplusf_(float z) { return fmaxf(z, 0.f) + log1pf(expf(-fabsf(z))); }
__device__ __forceinline__ int bucket_of(int dist) { return dist >= 128 ? 31 : (int)c_bucket[dist < 0 ? 0 : dist]; }
__device__ __forceinline__ int otid(int wid0) { unsigned z = 0u; asm volatile("" : "+v"(z)); int t = wid0 * 64 + (int)__builtin_amdgcn_mbcnt_hi(~0u, __builtin_amdgcn_mbcnt_lo(~0u, z)); asm volatile("" : "+v"(t)); return t; }
template <class T> __device__ __forceinline__ T* opq(T* p) { asm volatile("" : "+s"(p)); return p; }
__device__ __forceinline__ int opqi(int v) { asm volatile("" : "+v"(v)); return v; }
__device__ __forceinline__ int olane() { unsigned z = 0u; asm volatile("" : "+v"(z)); return (int)__builtin_amdgcn_mbcnt_hi(~0u, __builtin_amdgcn_mbcnt_lo(~0u, z)); }
constexpr int N_ATT_UNITS = 1536;
__constant__ unsigned short c_unit_order[N_ATT_UNITS] = {480, 481, 482, 483, 484, 485, 486, 487, 488, 489, 490, 491, 492, 493, 494, 495, 496, 497, 498, 499, 500, 501, 502, 503, 504, 505, 506, 507, 508, 509, 510, 511, 448, 449, 450, 451, 452, 453, 454, 455, 456, 457, 458, 459, 460, 461, 462, 463, 464, 465, 466, 467, 468, 469, 470, 471, 472, 473, 474, 475, 476, 477, 478, 479, 416, 417, 418, 419, 420, 421, 422, 423, 424, 425, 426, 427, 428, 429, 430, 431, 432, 433, 434, 435, 436, 437, 438, 439, 440, 441, 442, 443, 444, 445, 446, 447, 384, 385, 386, 387, 388, 389, 390, 391, 392, 393, 394, 395, 396, 397, 398, 399, 400, 401, 402, 403, 404, 405, 406, 407, 408, 409, 410, 411, 412, 413, 414, 415, 352, 353, 354, 355, 356, 357, 358, 359, 360, 361, 362, 363, 364, 365, 366, 367, 368, 369, 370, 371, 372, 373, 374, 375, 376, 377, 378, 379, 380, 381, 382, 383, 320, 321, 322, 323, 324, 325, 326, 327, 328, 329, 330, 331, 332, 333, 334, 335, 336, 337, 338, 339, 340, 341, 342, 343, 344, 345, 346, 347, 348, 349, 350, 351, 288, 289, 290, 291, 292, 293, 294, 295, 296, 297, 298, 299, 300, 301, 302, 303, 304, 305, 306, 307, 308, 309, 310, 311, 312, 313, 314, 315, 316, 317, 318, 319, 256, 257, 258, 259, 260, 261, 262, 263, 264, 265, 266, 267, 268, 269, 270, 271, 272, 273, 274, 275, 276, 277, 278, 279, 280, 281, 282, 283, 284, 285, 286, 287, 224, 225, 226, 227, 228, 229, 230, 231, 232, 233, 234, 235, 236, 237, 238, 239, 240, 241, 242, 243, 244, 245, 246, 247, 248, 249, 250, 251, 252, 253, 254, 255, 192, 193, 194, 195, 196, 197, 198, 199, 200, 201, 202, 203, 204, 205, 206, 207, 208, 209, 210, 211, 212, 213, 214, 215, 216, 217, 218, 219, 220, 221, 222, 223, 160, 161, 162, 163, 164, 165, 166, 167, 168, 169, 170, 171, 172, 173, 174, 175, 176, 177, 178, 179, 180, 181, 182, 183, 184, 185, 186, 187, 188, 189, 190, 191, 128, 129, 130, 131, 132, 133, 134, 135, 136, 137, 138, 139, 140, 141, 142, 143, 144, 145, 146, 147, 148, 149, 150, 151, 152, 153, 154, 155, 156, 157, 158, 159, 96, 97, 98, 99, 100, 101, 102, 103, 104, 105, 106, 107, 108, 109, 110, 111, 112, 113, 114, 115, 116, 117, 118, 119, 120, 121, 122, 123, 124, 125, 126, 127, 64, 65, 66, 67, 68, 69, 70, 71, 72, 73, 74, 75, 76, 77, 78, 79, 80, 81, 82, 83, 84, 85, 86, 87, 88, 89, 90, 91, 92, 93, 94, 95, 32, 33, 34, 35, 36, 37, 38, 39, 40, 41, 42, 43, 44, 45, 46, 47, 48, 49, 50, 51, 52, 53, 54, 55, 56, 57, 58, 59, 60, 61, 62, 63, 0, 1, 2, 3, 4, 5, 6, 7, 8, 9, 10, 11, 12, 13, 14, 15, 16, 17, 18, 19, 20, 21, 22, 23, 24, 25, 26, 27, 28, 29, 30, 31, 4064, 4065, 4066, 4067, 4068, 4069, 4070, 4071, 4072, 4073, 4074, 4075, 4076, 4077, 4078, 4079, 4032, 4033, 4034, 4035, 4036, 4037, 4038, 4039, 4040, 4041, 4042, 4043, 4044, 4045, 4046, 4047, 4000, 4001, 4002, 4003, 4004, 4005, 4006, 4007, 4008, 4009, 4010, 4011, 4012, 4013, 4014, 4015, 3968, 3969, 3970, 3971, 3972, 3973, 3974, 3975, 3976, 3977, 3978, 3979, 3980, 3981, 3982, 3983, 3936, 3937, 3938, 3939, 3940, 3941, 3942, 3943, 3944, 3945, 3946, 3947, 3948, 3949, 3950, 3951, 3904, 3905, 3906, 3907, 3908, 3909, 3910, 3911, 3912, 3913, 3914, 3915, 3916, 3917, 3918, 3919, 3872, 3873, 3874, 3875, 3876, 3877, 3878, 3879, 3880, 3881, 3882, 3883, 3884, 3885, 3886, 3887, 3840, 3841, 3842, 3843, 3844, 3845, 3846, 3847, 3848, 3849, 3850, 3851, 3852, 3853, 3854, 3855, 3808, 3809, 3810, 3811, 3812, 3813, 3814, 3815, 3816, 3817, 3818, 3819, 3820, 3821, 3822, 3823, 3776, 3777, 3778, 3779, 3780, 3781, 3782, 3783, 3784, 3785, 3786, 3787, 3788, 3789, 3790, 3791, 3744, 3745, 3746, 3747, 3748, 3749, 3750, 3751, 3752, 3753, 3754, 3755, 3756, 3757, 3758, 3759, 3712, 3713, 3714, 3715, 3716, 3717, 3718, 3719, 3720, 3721, 3722, 3723, 3724, 3725, 3726, 3727, 3680, 3681, 3682, 3683, 3684, 3685, 3686, 3687, 3688, 3689, 3690, 3691, 3692, 3693, 3694, 3695, 3648, 3649, 3650, 3651, 3652, 3653, 3654, 3655, 3656, 3657, 3658, 3659, 3660, 3661, 3662, 3663, 3616, 3617, 3618, 3619, 3620, 3621, 3622, 3623, 3624, 3625, 3626, 3627, 3628, 3629, 3630, 3631, 3584, 3585, 3586, 3587, 3588, 3589, 3590, 3591, 3592, 3593, 3594, 3595, 3596, 3597, 3598, 3599, 3552, 3553, 3554, 3555, 3556, 3557, 3558, 3559, 3560, 3561, 3562, 3563, 3564, 3565, 3566, 3567, 3520, 3521, 3522, 3523, 3524, 3525, 3526, 3527, 3528, 3529, 3530, 3531, 3532, 3533, 3534, 3535, 3488, 3489, 3490, 3491, 3492, 3493, 3494, 3495, 3496, 3497, 3498, 3499, 3500, 3501, 3502, 3503, 3456, 3457, 3458, 3459, 3460, 3461, 3462, 3463, 3464, 3465, 3466, 3467, 3468, 3469, 3470, 3471, 3424, 3425, 3426, 3427, 3428, 3429, 3430, 3431, 3432, 3433, 3434, 3435, 3436, 3437, 3438, 3439, 3392, 3393, 3394, 3395, 3396, 3397, 3398, 3399, 3400, 3401, 3402, 3403, 3404, 3405, 3406, 3407, 3360, 3361, 3362, 3363, 3364, 3365, 3366, 3367, 3368, 3369, 3370, 3371, 3372, 3373, 3374, 3375, 3328, 3329, 3330, 3331, 3332, 3333, 3334, 3335, 3336, 3337, 3338, 3339, 3340, 3341, 3342, 3343, 3296, 3297, 3298, 3299, 3300, 3301, 3302, 3303, 3304, 3305, 3306, 3307, 3308, 3309, 3310, 3311, 3264, 3265, 3266, 3267, 3268, 3269, 3270, 3271, 3272, 3273, 3274, 3275, 3276, 3277, 3278, 3279, 3232, 3233, 3234, 3235, 3236, 3237, 3238, 3239, 3240, 3241, 3242, 3243, 3244, 3245, 3246, 3247, 3200, 3201, 3202, 3203, 3204, 3205, 3206, 3207, 3208, 3209, 3210, 3211, 3212, 3213, 3214, 3215, 3168, 3169, 3170, 3171, 3172, 3173, 3174, 3175, 3176, 3177, 3178, 3179, 3180, 3181, 3182, 3183, 3136, 3137, 3138, 3139, 3140, 3141, 3142, 3143, 3144, 3145, 3146, 3147, 3148, 3149, 3150, 3151, 3104, 3105, 3106, 3107, 3108, 3109, 3110, 3111, 3112, 3113, 3114, 3115, 3116, 3117, 3118, 3119, 3072, 3073, 3074, 3075, 3076, 3077, 3078, 3079, 3080, 3081, 3082, 3083, 3084, 3085, 3086, 3087, 3040, 3041, 3042, 3043, 3044, 3045, 3046, 3047, 3048, 3049, 3050, 3051, 3052, 3053, 3054, 3055, 3008, 3009, 3010, 3011, 3012, 3013, 3014, 3015, 3016, 3017, 3018, 3019, 3020, 3021, 3022, 3023, 2976, 2977, 2978, 2979, 2980, 2981, 2982, 2983, 2984, 2985, 2986, 2987, 2988, 2989, 2990, 2991, 2944, 2945, 2946, 2947, 2948, 2949, 2950, 2951, 2952, 2953, 2954, 2955, 2956, 2957, 2958, 2959, 2912, 2913, 2914, 2915, 2916, 2917, 2918, 2919, 2920, 2921, 2922, 2923, 2924, 2925, 2926, 2927, 2880, 2881, 2882, 2883, 2884, 2885, 2886, 2887, 2888, 2889, 2890, 2891, 2892, 2893, 2894, 2895, 2848, 2849, 2850, 2851, 2852, 2853, 2854, 2855, 2856, 2857, 2858, 2859, 2860, 2861, 2862, 2863, 2816, 2817, 2818, 2819, 2820, 2821, 2822, 2823, 2824, 2825, 2826, 2827, 2828, 2829, 2830, 2831, 2784, 2785, 2786, 2787, 2788, 2789, 2790, 2791, 2792, 2793, 2794, 2795, 2796, 2797, 2798, 2799, 2752, 2753, 2754, 2755, 2756, 2757, 2758, 2759, 2760, 2761, 2762, 2763, 2764, 2765, 2766, 2767, 2720, 2721, 2722, 2723, 2724, 2725, 2726, 2727, 2728, 2729, 2730, 2731, 2732, 2733, 2734, 2735, 2688, 2689, 2690, 2691, 2692, 2693, 2694, 2695, 2696, 2697, 2698, 2699, 2700, 2701, 2702, 2703, 2656, 2657, 2658, 2659, 2660, 2661, 2662, 2663, 2664, 2665, 2666, 2667, 2668, 2669, 2670, 2671, 2624, 2625, 2626, 2627, 2628, 2629, 2630, 2631, 2632, 2633, 2634, 2635, 2636, 2637, 2638, 2639, 2592, 2593, 2594, 2595, 2596, 2597, 2598, 2599, 2600, 2601, 2602, 2603, 2604, 2605, 2606, 2607, 2560, 2561, 2562, 2563, 2564, 2565, 2566, 2567, 2568, 2569, 2570, 2571, 2572, 2573, 2574, 2575, 2528, 2529, 2530, 2531, 2532, 2533, 2534, 2535, 2536, 2537, 2538, 2539, 2540, 2541, 2542, 2543, 2496, 2497, 2498, 2499, 2500, 2501, 2502, 2503, 2504, 2505, 2506, 2507, 2508, 2509, 2510, 2511, 2464, 2465, 2466, 2467, 2468, 2469, 2470, 2471, 2472, 2473, 2474, 2475, 2476, 2477, 2478, 2479, 2432, 2433, 2434, 2435, 2436, 2437, 2438, 2439, 2440, 2441, 2442, 2443, 2444, 2445, 2446, 2447, 2400, 2401, 2402, 2403, 2404, 2405, 2406, 2407, 2408, 2409, 2410, 2411, 2412, 2413, 2414, 2415, 2368, 2369, 2370, 2371, 2372, 2373, 2374, 2375, 2376, 2377, 2378, 2379, 2380, 2381, 2382, 2383, 2336, 2337, 2338, 2339, 2340, 2341, 2342, 2343, 2344, 2345, 2346, 2347, 2348, 2349, 2350, 2351, 2304, 2305, 2306, 2307, 2308, 2309, 2310, 2311, 2312, 2313, 2314, 2315, 2316, 2317, 2318, 2319, 2272, 2273, 2274, 2275, 2276, 2277, 2278, 2279, 2280, 2281, 2282, 2283, 2284, 2285, 2286, 2287, 2240, 2241, 2242, 2243, 2244, 2245, 2246, 2247, 2248, 2249, 2250, 2251, 2252, 2253, 2254, 2255, 2208, 2209, 2210, 2211, 2212, 2213, 2214, 2215, 2216, 2217, 2218, 2219, 2220, 2221, 2222, 2223, 2176, 2177, 2178, 2179, 2180, 2181, 2182, 2183, 2184, 2185, 2186, 2187, 2188, 2189, 2190, 2191, 2144, 2145, 2146, 2147, 2148, 2149, 2150, 2151, 2152, 2153, 2154, 2155, 2156, 2157, 2158, 2159, 2112, 2113, 2114, 2115, 2116, 2117, 2118, 2119, 2120, 2121, 2122, 2123, 2124, 2125, 2126, 2127, 2080, 2081, 2082, 2083, 2084, 2085, 2086, 2087, 2088, 2089, 2090, 2091, 2092, 2093, 2094, 2095, 2048, 2049, 2050, 2051, 2052, 2053, 2054, 2055, 2056, 2057, 2058, 2059, 2060, 2061, 2062, 2063};
namespace pg8 {
#define PG8_LAS __attribute__((address_space(3)))
typedef unsigned short bf16_t;
typedef short bf16x8 __attribute__((ext_vector_type(8)));
typedef float f32x4 __attribute__((ext_vector_type(4)));
typedef unsigned u32x4 __attribute__((ext_vector_type(4)));
constexpr int BM = 256, BK = 64, HALF = 128, HTB = HALF * BK * 2  , STAGE_BYTES = 8 * HTB, NXCD = 8, WGM = 8;

__host__ __device__ __forceinline__ int lds_byte(int r, int c) { const int st = (r >> 4) * 2 + (c >> 5), rr = r & 15, cc = c & 31, ob = rr * 64 + cc * 2; return st * 1024 + (ob ^ (((ob >> 9) & 1) << 5)); }
__host__ __device__ __forceinline__ void stage_rc(int b, int& R, int& C) { const int st = b / 1024, sb = b % 1024, swz = sb ^ (((sb >> 9) & 1) << 5); R = (st >> 1) * 16 + swz / 64; C = (st & 1) * 32 + (swz % 64) / 2; }
__host__ __device__ __forceinline__ int perm32(int rho) { const int n = rho >> 4, i = rho & 15; return 8 * (i >> 2) + 4 * n + (i & 3); }

struct Unit { int pm, pn; };
struct Gemm { const bf16_t* A; const bf16_t* Bt; int M, N, K, lda, ldb; };

struct StaticOrder {
    int nM, nN, nwg, G, c;
    __host__ __device__ void init(int M, int N, int G_, int c_) { nM = M / BM; nN = N / BM; nwg = nM * nN; G = G_; c = c_; }
    __host__ __device__ bool next(int i, Unit& u) const {
        const long L = (long)i * G + c; if (L >= nwg) return false;
        int wgid = (int)L; { const int q = nwg / NXCD, r = nwg % NXCD, xcd = wgid % NXCD, off = wgid / NXCD; wgid = (xcd < r ? xcd * (q + 1) : r * (q + 1) + (xcd - r) * q) + off; }
        const int nig = WGM * nN, gid = wgid / nig, fm = gid * WGM, gsz = (nM - fm) < WGM ? (nM - fm) : WGM;
        u.pm = fm + ((wgid % nig) % gsz); u.pn = (wgid % nig) / gsz; return true;
    }
    __device__ __forceinline__ void a_ready(const Unit&) const {}
    __device__ __forceinline__ void done(const Unit&) const {}
};


template <class Epi, class Sched, bool ALIGN_EPI = false, bool SP2 = false>
__device__ __forceinline__ void gemm_phase(PG8_LAS unsigned char* lds, const Gemm g, const Sched& S, const Epi& E, int wid0) {
    const int tid = otid(wid0), wid = __builtin_amdgcn_readfirstlane(tid >> 6), lane = tid & 63, wr = wid >> 2, wc = wid & 3, fr = lane & 15, fq = lane >> 4;
    const int K = g.K, nt = K / BK;
    unsigned voffA[2], voffB[2];
#pragma unroll
    for (int i = 0; i < 2; ++i) { int R, C; stage_rc(tid * 16 + i * 8192, R, C); const int Rb = Epi::PERM ? ((R & ~31) + perm32(R & 31)) : R;
        voffA[i] = (unsigned)(R * g.lda + C) * 2u; voffB[i] = (unsigned)(Rb * g.ldb + C) * 2u; }
    const size_t kstep = (size_t)(BK * 2);
    const size_t hstepA = (size_t)HALF * g.lda * 2, hstepB = (size_t)HALF * g.ldb * 2;
    const size_t tstepA = 2 * hstepA, tstepB = 2 * hstepB;
    const unsigned ldsw = (unsigned)wid * 1024u;
    const int aoff = lds_byte(wr * 64 + fr, fq * 8), boff = lds_byte(wc * 32 + fr, fq * 8);
#define PG8_SA(b, h) (((b) * 2 + (h)) * HTB)
#define PG8_SB(b, h) ((4 + (b) * 2 + (h)) * HTB)
#define PG8_STAGE(bufoff, gbase, voff) do { _Pragma("unroll") for (int _i = 0; _i < 2; ++_i) \
        __builtin_amdgcn_global_load_lds((const unsigned*)((const char*)(gbase) + (voff)[_i]), (PG8_LAS unsigned*)(lds + (bufoff) + ldsw + _i * 8192), 16, 0, 0); } while (0)
#define PG8_LDA(dst, b, h) do { _Pragma("unroll") for (int m = 0; m < 4; ++m) _Pragma("unroll") for (int k = 0; k < 2; ++k) dst[m][k] = *(const PG8_LAS bf16x8*)(lds + PG8_SA(b, h) + aoff + m * 2048 + k * 1024); } while (0)
#define PG8_LDB(dst, b, h) do { _Pragma("unroll") for (int n = 0; n < 2; ++n) _Pragma("unroll") for (int k = 0; k < 2; ++k) dst[n][k] = *(const PG8_LAS bf16x8*)(lds + PG8_SB(b, h) + boff + n * 2048 + k * 1024); } while (0)
#define PG8_MMA(ai, bj, At, Bt) do { __builtin_amdgcn_s_setprio(1); _Pragma("unroll") for (int m = 0; m < 4; ++m) _Pragma("unroll") for (int n = 0; n < 2; ++n) _Pragma("unroll") for (int k = 0; k < 2; ++k) \
        acc[ai][bj][m][n] = __builtin_amdgcn_mfma_f32_16x16x32_bf16(Bt[n][k], At[m][k], acc[ai][bj][m][n], 0, 0, 0); __builtin_amdgcn_s_setprio(0); } while (0)
#define PG8_WAIT_V(n) asm volatile("s_waitcnt vmcnt(" #n ")" ::: "memory")
#define PG8_WAIT_L(n) asm volatile("s_waitcnt lgkmcnt(" #n ")" ::: "memory")
#define PG8_BAR __builtin_amdgcn_s_barrier()
#define PG8_SCHED __builtin_amdgcn_sched_barrier(0)
    Unit cur, nxt; int ui = 0;
    if (!S.next(0, cur)) return;
    f32x4 acc[2][2][4][2];
#pragma unroll
    for (int a = 0; a < 2; ++a)
#pragma unroll
        for (int b = 0; b < 2; ++b)
#pragma unroll
            for (int m = 0; m < 4; ++m)
#pragma unroll
                for (int n = 0; n < 2; ++n) acc[a][b][m][n] = (f32x4){0.f, 0.f, 0.f, 0.f};
    bf16x8 At[4][2], B0[2][2], B1[2][2];
    const char* cA = (const char*)g.A + (size_t)cur.pm * tstepA; const char* cB = (const char*)g.Bt + (size_t)cur.pn * tstepB;
    S.a_ready(cur);
    if constexpr (SP2) {
        PG8_STAGE(PG8_SB(0, 0), cB, voffB); PG8_STAGE(PG8_SB(0, 1), cB + hstepB, voffB); PG8_STAGE(PG8_SA(0, 0), cA, voffA); PG8_STAGE(PG8_SA(0, 1), cA + hstepA, voffA);
        if (wr == 1) PG8_BAR;
        PG8_WAIT_V(2); PG8_BAR;
        PG8_STAGE(PG8_SB(1, 0), cB + kstep, voffB); PG8_STAGE(PG8_SA(1, 0), cA + kstep, voffA); PG8_STAGE(PG8_SB(1, 1), cB + hstepB + kstep, voffB);
        PG8_WAIT_V(6); PG8_BAR;
    } else {
        PG8_STAGE(PG8_SB(0, 0), cB, voffB); PG8_STAGE(PG8_SA(0, 0), cA, voffA); PG8_STAGE(PG8_SB(0, 1), cB + hstepB, voffB); PG8_STAGE(PG8_SA(0, 1), cA + hstepA, voffA);
        if (wr == 1) PG8_BAR;
        PG8_WAIT_V(4); PG8_BAR;
        PG8_STAGE(PG8_SB(1, 0), cB + kstep, voffB); PG8_STAGE(PG8_SA(1, 0), cA + kstep, voffA); PG8_STAGE(PG8_SB(1, 1), cB + hstepB + kstep, voffB);
        PG8_WAIT_V(6); PG8_BAR;
    }
    for (;;) {
        const bool has_next = S.next(ui + 1, nxt);
        const char* nA = has_next ? (const char*)g.A + (size_t)nxt.pm * tstepA : cA; const char* nB = has_next ? (const char*)g.Bt + (size_t)nxt.pn * tstepB : cB;
        for (int t = 0; t < nt; t += 2) {
            const bool last = (t == nt - 2);
            const char* a1 = cA + (size_t)(t + 1) * kstep;
            const char* a2 = last ? nA : cA + (size_t)(t + 2) * kstep; const char* b2 = last ? nB : cB + (size_t)(t + 2) * kstep;
            const char* a3 = a2 + kstep; const char* b3 = b2 + kstep;
            if (last && has_next) S.a_ready(nxt);
            if constexpr (SP2) {
            PG8_LDB(B0, 0, 0); PG8_LDB(B1, 0, 1); PG8_SCHED; PG8_LDA(At, 0, 0); PG8_STAGE(PG8_SA(1, 1), a1 + hstepA, voffA);
            PG8_WAIT_V(8); PG8_WAIT_L(0); PG8_BAR; PG8_MMA(0, 0, At, B0); PG8_MMA(0, 1, At, B1); PG8_BAR; PG8_SCHED;
            PG8_LDA(At, 0, 1); PG8_STAGE(PG8_SB(0, 0), b2, voffB); PG8_STAGE(PG8_SB(0, 1), b2 + hstepB, voffB); PG8_STAGE(PG8_SA(0, 0), a2, voffA);
            PG8_WAIT_V(8); PG8_WAIT_L(0); PG8_BAR; PG8_MMA(1, 0, At, B0); PG8_MMA(1, 1, At, B1); PG8_BAR; PG8_SCHED;
            PG8_LDB(B0, 1, 0); PG8_LDB(B1, 1, 1); PG8_SCHED; PG8_LDA(At, 1, 0); PG8_STAGE(PG8_SA(0, 1), a2 + hstepA, voffA);
            PG8_WAIT_V(8); PG8_WAIT_L(0); PG8_BAR; PG8_MMA(0, 0, At, B0); PG8_MMA(0, 1, At, B1); PG8_BAR; PG8_SCHED;
            PG8_LDA(At, 1, 1); PG8_STAGE(PG8_SB(1, 0), b3, voffB); PG8_STAGE(PG8_SB(1, 1), b3 + hstepB, voffB); PG8_STAGE(PG8_SA(1, 0), a3, voffA);
            PG8_WAIT_V(8); PG8_WAIT_L(0); PG8_BAR; PG8_MMA(1, 0, At, B0); PG8_MMA(1, 1, At, B1); PG8_BAR; PG8_SCHED;
            } else {
            PG8_LDB(B0, 0, 0); PG8_SCHED; PG8_LDA(At, 0, 0); PG8_STAGE(PG8_SA(1, 1), a1 + hstepA, voffA);
            PG8_WAIT_L(8); PG8_BAR; PG8_WAIT_L(0); PG8_MMA(0, 0, At, B0); PG8_BAR; PG8_SCHED;
            PG8_LDB(B1, 0, 1); PG8_STAGE(PG8_SB(0, 0), b2, voffB);
            PG8_BAR; PG8_WAIT_L(0); PG8_MMA(0, 1, At, B1); PG8_BAR;
            PG8_LDA(At, 0, 1); PG8_STAGE(PG8_SA(0, 0), a2, voffA);
            PG8_BAR; PG8_WAIT_L(0); PG8_MMA(1, 0, At, B0); PG8_BAR; PG8_SCHED;
            PG8_STAGE(PG8_SB(0, 1), b2 + hstepB, voffB);
            PG8_WAIT_V(6); PG8_BAR; PG8_MMA(1, 1, At, B1); PG8_BAR;
            PG8_LDB(B0, 1, 0); PG8_SCHED; PG8_LDA(At, 1, 0); PG8_STAGE(PG8_SA(0, 1), a2 + hstepA, voffA);
            PG8_WAIT_L(8); PG8_BAR; PG8_WAIT_L(0); PG8_MMA(0, 0, At, B0); PG8_BAR; PG8_SCHED;
            PG8_LDB(B1, 1, 1); PG8_STAGE(PG8_SB(1, 0), b3, voffB);
            PG8_BAR; PG8_WAIT_L(0); PG8_MMA(0, 1, At, B1); PG8_BAR;
            PG8_LDA(At, 1, 1); PG8_STAGE(PG8_SA(1, 0), a3, voffA);
            PG8_BAR; PG8_WAIT_L(0); PG8_MMA(1, 0, At, B0); PG8_BAR; PG8_SCHED;
            PG8_STAGE(PG8_SB(1, 1), b3 + hstepB, voffB);
            PG8_WAIT_V(6); PG8_BAR; PG8_MMA(1, 1, At, B1); PG8_BAR;
            }
        }
        if constexpr (ALIGN_EPI) { if (wr == 0) PG8_BAR; }
        if constexpr (!Epi::AFTER_DRAIN) { E(acc, cur, wr, wc, fr, fq); S.done(cur); }
        if (!has_next) break;
#pragma unroll
        for (int a = 0; a < 2; ++a)
#pragma unroll
            for (int b = 0; b < 2; ++b)
#pragma unroll
                for (int m = 0; m < 4; ++m)
#pragma unroll
                    for (int n = 0; n < 2; ++n) acc[a][b][m][n] = (f32x4){0.f, 0.f, 0.f, 0.f};
        cur = nxt; cA = nA; cB = nB; ++ui;
        if constexpr (ALIGN_EPI) { if (wr == 1) PG8_BAR; }
    }
    PG8_WAIT_V(0);
    if constexpr (!ALIGN_EPI) { if (wr == 0) PG8_BAR; }
    PG8_BAR;
    if constexpr (Epi::AFTER_DRAIN) { E.fused(acc, cur, wr, wc, fr, fq, lds, wid, lane); S.done(cur); }
#undef PG8_SA
#undef PG8_SB
#undef PG8_STAGE
#undef PG8_LDA
#undef PG8_LDB
#undef PG8_MMA
#undef PG8_WAIT_V
#undef PG8_WAIT_L
#undef PG8_BAR
#undef PG8_SCHED
}
}

namespace pg8 {
struct EpiInProj {
    static constexpr bool PERM = true, AFTER_DRAIN = false;
    unsigned char* ws; const float* ss;
    __device__ __forceinline__ void operator()(const f32x4 (&acc)[2][2][4][2], const Unit& u, int wr, int wc, int fr, int fq) const {
        const int pn = u.pn;
        const int b = u.pm >> 4, t0 = (u.pm & 15) * 256 + wr * 64 + fr;
        size_t base0 = 0, base1 = 0; int mul = 64, H = 4; float sc = 1.f; int kind = 0;
        int W = 0, coff = 0;
        switch (pn) {
            case 0: base0 = base1 = WS_QA; sc = QSCALE; break;
            case 1: base0 = base1 = WS_KA; break;
            case 2: base0 = base1 = WS_VA; break;
            case 3: kind = 1; base0 = base1 = WS_ZA; W = 256; break;
            case 4: kind = 1; base0 = base1 = WS_QB; W = 512; sc = QSCALE; break;
            case 5: kind = 1; base0 = base1 = WS_QB; W = 512; coff = 256; sc = QSCALE; break;
            case 6: H = 2; base0 = WS_KC; base1 = WS_VC; break;
            case 7: H = 2; base0 = WS_KSL; base1 = WS_VSL; break;
            case 8: H = 2; base0 = WS_KWN; base1 = WS_VWN; break;
            case 9: kind = 1; base0 = base1 = WS_ZB; W = 512; break;
            case 10: kind = 1; base0 = base1 = WS_ZB; W = 512; coff = 256; break;
            case 11: base0 = base1 = WS_QC; sc = QSCALE; break;
            case 12: base0 = base1 = WS_KCF; break;
            case 13: base0 = base1 = WS_VCF; break;
            case 14: kind = 1; base0 = base1 = WS_ZC; W = 256; break;
            default: kind = 2; break;
        }
        const int chl = 32 * wc + 8 * fq;
        if (kind == 2) {
            if (wc == 0) {
                float* gf = (float*)(ws + WS_GF) + (size_t)(b * SEQ + t0) * 32 + chl;
#pragma unroll
                for (int ai = 0; ai < 2; ++ai)
#pragma unroll
                    for (int m = 0; m < 4; ++m) {
                        const int tl = ai * HALF + m * 16;
                        const float r = rsqrtf(ss[b * SEQ + t0 + tl] * (1.f / DM) + 1e-6f);
                        *(f32x4*)(gf + (size_t)tl * 32) = acc[ai][0][m][0] * r;
                        *(f32x4*)(gf + (size_t)tl * 32 + 4) = acc[ai][0][m][1] * r;
                    }
            }
            return;
        }
        unsigned cst0, cst1;
        if (kind == 0) {
            mul = 64;
            if (H == 4) { cst0 = (unsigned)(((b * 4 + (chl >> 6)) * SEQ) * 64 + (chl & 63)); cst1 = (unsigned)(((b * 4 + 2 + (chl >> 6)) * SEQ) * 64 + (chl & 63)); }
            else { cst0 = cst1 = (unsigned)(((b * 2 + (chl >> 6)) * SEQ) * 64 + (chl & 63)); }
        } else {
            mul = W;
            cst0 = (unsigned)(b * SEQ) * (unsigned)W + coff + chl; cst1 = cst0 + 128;
        }
        bf16_t* d0 = (bf16_t*)(ws + base0) + cst0 + (size_t)t0 * mul;
        bf16_t* d1 = (bf16_t*)(ws + base1) + cst1 + (size_t)t0 * mul;
#pragma unroll
        for (int ai = 0; ai < 2; ++ai)
#pragma unroll
            for (int m = 0; m < 4; ++m) {
                const int tl = ai * HALF + m * 16;
                const float r = rsqrtf(ss[b * SEQ + t0 + tl] * (1.f / DM) + 1e-6f) * sc;
#pragma unroll
                for (int bj = 0; bj < 2; ++bj) {
                    const f32x4 v0 = acc[ai][bj][m][0] * r, v1 = acc[ai][bj][m][1] * r;
                    u32x4 w; w.x = pk2(v0[0], v0[1]); w.y = pk2(v0[2], v0[3]); w.z = pk2(v1[0], v1[1]); w.w = pk2(v1[2], v1[3]);
                    *(u32x4*)((bj ? d1 : d0) + (size_t)tl * mul) = w;
                }
            }
    }
};
struct EpiOutProj {
    static constexpr bool PERM = false, AFTER_DRAIN = false;
    const float* xin; float* xout;
    __device__ __forceinline__ void operator()(const f32x4 (&acc)[2][2][4][2], const Unit& u, int wr, int wc, int fr, int fq) const {
        const int col0 = u.pn * BM + wc * 32 + 4 * fq;
#pragma unroll
        for (int ai = 0; ai < 2; ++ai)
#pragma unroll
            for (int m = 0; m < 4; ++m) {
                const size_t roff = (size_t)(u.pm * BM + ai * HALF + wr * 64 + m * 16 + fr) * DM + col0;
#pragma unroll
                for (int bj = 0; bj < 2; ++bj)
#pragma unroll
                    for (int n = 0; n < 2; ++n) {
                        const f32x4 r = *(const f32x4*)(xin + roff + bj * HALF + n * 16);
                        *(f32x4*)(xout + roff + bj * HALF + n * 16) = r + acc[ai][bj][m][n];
                    }
            }
    }
};
}

__device__ __forceinline__ void cvt_item(const float* src, int ldsrc, int col, int k0, const float* scale, bf16_t* dst) {
    float v[8];
#pragma unroll
    for (int j = 0; j < 8; ++j) v[j] = col >= 0 ? src[(size_t)(k0 + j) * ldsrc + col] * (scale ? scale[k0 + j] : 1.f) : 0.f;
    uint4 w; w.x = pk2(v[0], v[1]); w.y = pk2(v[2], v[3]); w.z = pk2(v[4], v[5]); w.w = pk2(v[6], v[7]);
    *(uint4*)dst = w;
}
__device__ __forceinline__ int in_src_col(int n) {
    if (n < 2304) return n;
    if (n < 3584) return n + 24;
    if (n < 3840) return n + 28;
    if (n < 3864) return C_GB + (n - 3840);
    if (n < 3868) return C_FC + (n - 3864);
    return -1;
}
__device__ void p0_weights(const Params& p, int wid0) {
    const int gtid = blockIdx.x * NTHREADS + otid(wid0), gsz = gridDim.x * NTHREADS;
    constexpr int I_IN = NPAD * 128, I_OUT = 1024 * 128, I_W1 = 256 * 256, I_W2 = 64 * 32;
    constexpr int TOTAL = 2 * I_IN + 2 * I_OUT + 4 * I_W1 + 4 * I_W2;
    for (int it = gtid; it < TOTAL; it += gsz) {
        int r = it;
        if (r < 2 * I_IN) {
            const int l = r / I_IN; r %= I_IN; const int n = r % NPAD, kc = r / NPAD;
            cvt_item(p.w_in + (size_t)l * DM * INW, INW, in_src_col(n), kc * 8, p.norm_g + l * DM, (bf16_t*)(p.ws + WS_WTIN) + ((size_t)l * NPAD + n) * DM + kc * 8);
            continue;
        }
        r -= 2 * I_IN;
        if (r < 2 * I_OUT) {
            const int l = r / I_OUT; r %= I_OUT; const int n = r % 1024, kc = r / 1024;
            cvt_item(p.w_out + (size_t)l * DM * DM, DM, n, kc * 8, nullptr, (bf16_t*)(p.ws + WS_WTOUT) + ((size_t)l * 1024 + n) * DM + kc * 8);
            continue;
        }
        r -= 2 * I_OUT;
        if (r < 4 * I_W1) {
            const int lw = r / I_W1; r %= I_W1; const int n = r % 256, kc = r / 256;
            cvt_item(p.cmp_w1 + (size_t)lw * 2048 * 256, 256, n, kc * 8, nullptr, (bf16_t*)(p.ws + WS_W1T) + ((size_t)lw * 256 + n) * 2048 + kc * 8);
            continue;
        }
        r -= 4 * I_W1;
        {
            const int lw = r / I_W2; r %= I_W2; const int n = r % 64, kc = r / 64;
            cvt_item(p.cmp_w2 + (size_t)lw * 256 * 64, 64, n, kc * 8, nullptr, (bf16_t*)(p.ws + WS_W2T) + ((size_t)lw * 64 + n) * 256 + kc * 8);
        }
    }
    if (gtid < 1024) {
        const int lw = gtid >> 8, n = gtid & 255;
        const float* w1 = p.cmp_w1 + (size_t)lw * 2048 * 256; const float* pe = p.cmp_pe + (size_t)lw * 2048;
        float a0 = 0.f, a1 = 0.f;
        for (int i = 0; i < 2048; i += 2) { a0 += pe[i] * w1[(size_t)i * 256 + n]; a1 += pe[i + 1] * w1[(size_t)(i + 1) * 256 + n]; }
        ((float*)(p.ws + WS_BIAS1))[gtid] = a0 + a1 + p.cmp_b1[gtid];
    }
}
__device__ void phase_convert_x(const float* xin, bf16_t* xb, float* ss, int wid0) {
    const int tid_ = otid(wid0); const int lane = tid_ & 63, wv = tid_ >> 6;
    const int gw = blockIdx.x * NWAVES + wv, ngw = gridDim.x * NWAVES;
    for (int r = gw; r < MTOK; r += ngw) {
        const float4* xr = (const float4*)(xin + (size_t)r * DM);
        float s = 0.f;
#pragma unroll
        for (int j = 0; j < 4; ++j) {
            const float4 v = xr[lane + 64 * j];
            s += v.x * v.x + v.y * v.y + v.z * v.z + v.w * v.w;
            uint2 w; w.x = pk2(v.x, v.y); w.y = pk2(v.z, v.w);
            *(uint2*)(xb + (size_t)r * DM + 4 * (lane + 64 * j)) = w;
        }
        s = wave_sum(s);
        if (lane == 0) ss[r] = s;
    }
}
__device__ void phase_final_norm(float* x, const float* g, int wid0) {
    const int tid_ = otid(wid0); const int lane = tid_ & 63, wv = tid_ >> 6;
    const int gw = blockIdx.x * NWAVES + wv, ngw = gridDim.x * NWAVES;
    for (int r = gw; r < MTOK; r += ngw) {
        float4* xr = (float4*)(x + (size_t)r * DM);
        float4 v[4];
        float s = 0.f;
#pragma unroll
        for (int j = 0; j < 4; ++j) { v[j] = xr[lane + 64 * j]; s += v[j].x * v[j].x + v[j].y * v[j].y + v[j].z * v[j].z + v[j].w * v[j].w; }
        s = wave_sum(s);
        const float rs = rsqrtf(s * (1.f / DM) + 1e-6f);
#pragma unroll
        for (int j = 0; j < 4; ++j) {
            const float4 gg = ((const float4*)g)[lane + 64 * j];
            float4 o;
            o.x = v[j].x * rs * gg.x; o.y = v[j].y * rs * gg.y; o.z = v[j].z * rs * gg.z; o.w = v[j].w * rs * gg.w;
            xr[lane + 64 * j] = o;
        }
    }
}

namespace att {
#define LAS3 __attribute__((address_space(3)))
typedef short bf16x8 __attribute__((ext_vector_type(8)));
typedef float f32x16 __attribute__((ext_vector_type(16)));
typedef float f32x4 __attribute__((ext_vector_type(4)));
typedef short v4i16_t __attribute__((ext_vector_type(4)));
typedef float f32x2_t __attribute__((ext_vector_type(2)));
typedef __bf16 bf16x2_t __attribute__((ext_vector_type(2)));
constexpr int L_KV = 0;
constexpr int L_WSF = 50176;
constexpr int L_BTAB = 52224;
constexpr int L_IMP = 40960;
constexpr int L_SELM = 57344;
constexpr float NEG_INF = -INFINITY;

__device__ __forceinline__ unsigned cvtpk(float lo, float hi) { f32x2_t v = {lo, hi}; bf16x2_t b = __builtin_convertvector(v, bf16x2_t); return __builtin_bit_cast(unsigned, b); }
__device__ __forceinline__ int crow(int r, int hi) { return (r & 3) + 8 * (r >> 2) + 4 * hi; }

struct Ctx {
    int tid, lane, r32, hi, wid;
    unsigned kofs[4];
    unsigned vofs0;
    unsigned stK, stV;
};
__device__ __forceinline__ Ctx make_ctx(int wid0) {
    Ctx c; c.tid = otid(wid0); c.lane = c.tid & 63; c.r32 = c.lane & 31; c.hi = c.lane >> 5; c.wid = __builtin_amdgcn_readfirstlane(c.tid >> 6);
#pragma unroll
    for (int d0 = 0; d0 < 4; ++d0) c.kofs[d0] = (unsigned)(c.r32 * 128 + (((2 * d0 + c.hi) ^ (c.r32 & 7)) << 4));
    const int q = (c.lane & 15) >> 2, p = c.lane & 3, g = (c.lane >> 4) & 1;
    c.vofs0 = (unsigned)((4 * c.hi + q) * 128 + (((2 * g + (p >> 1)) ^ ((q >> 1) << 2)) << 4) + 8 * (p & 1));
    const int kv = c.tid >> 3, ch = c.tid & 7;
    c.stK = (unsigned)(kv * 128 + ((ch ^ (kv & 7)) << 4));
    c.stV = (unsigned)(kv * 128 + ((ch ^ (((kv >> 1) & 1) << 2)) << 4));
    return c;
}
__device__ __forceinline__ void qk_tile(f32x16& p0, f32x16& p1, const LAS3 unsigned char* kb, const Ctx& c, const bf16x8 (&qf)[4]) {
#pragma unroll
    for (int d0 = 0; d0 < 4; ++d0) {
        const bf16x8 a0 = *(const LAS3 bf16x8*)(kb + c.kofs[d0]);
        const bf16x8 a1 = *(const LAS3 bf16x8*)(kb + 4096 + c.kofs[d0]);
        p0 = __builtin_amdgcn_mfma_f32_32x32x16_bf16(a0, qf[d0], p0, 0, 0, 0);
        p1 = __builtin_amdgcn_mfma_f32_32x32x16_bf16(a1, qf[d0], p1, 0, 0, 0);
    }
}
__device__ __forceinline__ bf16x8 pack8(const f32x16& p, int b) {
    typedef unsigned u32x4p_t __attribute__((ext_vector_type(4)));
    u32x4p_t w; w.x = cvtpk(p[b], p[b + 1]); w.y = cvtpk(p[b + 2], p[b + 3]); w.z = cvtpk(p[b + 4], p[b + 5]); w.w = cvtpk(p[b + 6], p[b + 7]);
    return __builtin_bit_cast(bf16x8, w);
}
__device__ __forceinline__ void pack_p(bf16x8 (&pa)[4], const f32x16& p0, const f32x16& p1) { pa[0] = pack8(p0, 0); pa[1] = pack8(p0, 8); pa[2] = pack8(p1, 0); pa[3] = pack8(p1, 8); }
__device__ __forceinline__ void pv_tile(f32x16 (&o)[2], const LAS3 unsigned char* vb, const Ctx& c, const bf16x8 (&pa)[4]) {
#pragma unroll
    for (int dblk = 0; dblk < 2; ++dblk) {
        if (dblk) asm volatile("" ::: "memory");
        const LAS3 unsigned char* vp = vb + (c.vofs0 ^ (unsigned)(dblk * 64));
#pragma unroll
        for (int s = 0; s < 4; ++s) {
            const v4i16_t lo = __builtin_amdgcn_ds_read_tr16_b64_v4i16((LAS3 v4i16_t*)(vp + s * 2048));
            const v4i16_t hi = __builtin_amdgcn_ds_read_tr16_b64_v4i16((LAS3 v4i16_t*)(vp + s * 2048 + 1024));
            const bf16x8 bfr = {lo[0], lo[1], lo[2], lo[3], hi[0], hi[1], hi[2], hi[3]};
            o[dblk] = __builtin_amdgcn_mfma_f32_32x32x16_bf16(pa[s], bfr, o[dblk], 0, 0, 0);
        }
    }
}
__device__ __forceinline__ void rows_to_o(float (&out)[16], float v, LAS3 float* wsf, const Ctx& c) {
    if (c.hi == 0) wsf[c.r32] = v;
    asm volatile("" ::: "memory");
#pragma unroll
    for (int i = 0; i < 4; ++i) {
        const f32x4 t = *(const LAS3 f32x4*)(wsf + 8 * i + 4 * c.hi);
        out[4 * i] = t[0]; out[4 * i + 1] = t[1]; out[4 * i + 2] = t[2]; out[4 * i + 3] = t[3];
    }
    asm volatile("" ::: "memory");
}
constexpr float SM_THR = 8.f;
__device__ __forceinline__ void softmax_step(f32x16& p0, f32x16& p1, float& mref, bool& started, float& l, f32x16 (&o)[2], LAS3 float* wsf, const Ctx& c) {
    float mx = fmaxf(p0[0], p1[0]);
#pragma unroll
    for (int r = 1; r < 16; ++r) mx = fmaxf(mx, fmaxf(p0[r], p1[r]));
    mx = pair_max(mx);
    const bool fin = mx > NEG_INF;
    const bool rc = fin && (!started || mx > SM_THR);
    if (__any(rc)) {
        const float delta = rc ? mx : 0.f;
        const float alpha = (rc && started) ? __builtin_amdgcn_exp2f(-delta) : 1.f;
        mref += delta;
        l *= alpha;
        float a16[16];
        rows_to_o(a16, alpha, wsf, c);
#pragma unroll
        for (int r = 0; r < 16; ++r) { o[0][r] *= a16[r]; o[1][r] *= a16[r]; p0[r] -= delta; p1[r] -= delta; }
    }
    started = started || fin;
    float s = 0.f;
#pragma unroll
    for (int r = 0; r < 16; ++r) { p0[r] = __builtin_amdgcn_exp2f(p0[r]); p1[r] = __builtin_amdgcn_exp2f(p1[r]); s += p0[r] + p1[r]; }
    l += s;
}
typedef unsigned u32x4_t __attribute__((ext_vector_type(4)));
constexpr int L_KR = 0, L_VR = 24576, L_AUXR = 49152, L_FLAG = 49152 + 768, L_UNIT = 49152 + 800;
#define ATT_WAITBAR0() asm volatile("s_waitcnt vmcnt(0) lgkmcnt(0)\n\ts_barrier" ::: "memory")
__device__ __forceinline__ void dma16(const void* g, LAS3 unsigned char* ldst) { __builtin_amdgcn_global_load_lds((const unsigned*)g, (LAS3 unsigned*)ldst, 16, 0, 0); }
__device__ __forceinline__ void dma4(const void* g, LAS3 unsigned char* ldst) { __builtin_amdgcn_global_load_lds((const unsigned*)g, (LAS3 unsigned*)ldst, 4, 0, 0); }
template <bool EXIT, bool AUX, bool HASV, class TileOf, class Need, class Init, class ProcA, class PV, class Done>
__device__ __forceinline__ void tile_pipeline(LAS3 unsigned char* L, const Ctx& c, const bf16x8 (&qf)[4], const bf16_t* K, const bf16_t* V, const float* aux,
                                              int count, TileOf tile_of, Need need, Init init, ProcA procA, PV pvf, Done done) {
    const int row = c.tid >> 3, chs = c.tid & 7;
    const unsigned gk = (unsigned)(row * 128 + ((chs ^ (row & 7)) << 4));
    const unsigned gv = (unsigned)(row * 128 + ((chs ^ (((row >> 1) & 1) << 2)) << 4));
    const unsigned wl = (unsigned)c.wid * 1024u;
    auto issue_k = [&](int i) { const int j = tile_of(i); const int s = i % 3;
        dma16((const unsigned char*)(K + (size_t)j * 4096) + gk, L + L_KR + s * 8192 + wl);
        if (AUX) dma4((const unsigned char*)(aux + j * 64) + c.lane * 4, L + L_AUXR + s * 256); };
    auto issue_v = [&](int i) { if (HASV) { const int j = tile_of(i); const int s = i % 3; dma16((const unsigned char*)(V + (size_t)j * 4096) + gv, L + L_VR + s * 8192 + wl); } };
    const bool ph1 = c.wid >= 4;
    issue_k(0); issue_v(0);
    if (count > 1) issue_k(1);
    if (EXIT && c.tid < 3) *(LAS3 unsigned*)(L + L_FLAG + c.tid * 4) = 0u;
    ATT_WAITBAR0();
    auto end_step = [&](int i) -> bool {
        if (EXIT) { if (!done() && c.lane == 0) *(LAS3 unsigned*)(L + L_FLAG + (i % 3) * 4) = 1u; }
        ATT_WAITBAR0();
        if (EXIT) {
            const unsigned f = *(LAS3 unsigned*)(L + L_FLAG + (i % 3) * 4);
            if (c.tid == 0) *(LAS3 unsigned*)(L + L_FLAG + ((i + 2) % 3) * 4) = 0u;
            if (f == 0u) return false;
        }
        return true;
    };
    if (!ph1) {
        f32x16 s0, s1; bool have = false;
        { const int j0 = tile_of(0); if (need(j0)) { init(j0, s0, s1, 0); qk_tile(s0, s1, L + L_KR, c, qf); have = true; } }
        for (int i = 0; i <= count; ++i) {
            if (i + 2 < count) issue_k(i + 2);
            if (i + 1 < count) issue_v(i + 1);
            if (i < count && have) {
                const int j = tile_of(i);
                procA(j, s0, s1);
                if (HASV) { bf16x8 pq[4]; pack_p(pq, s0, s1); pvf(pq, L + L_VR + (i % 3) * 8192); }
            }
            have = false;
            if (i + 1 < count) { const int j1 = tile_of(i + 1); if (need(j1)) { const int sl = (i + 1) % 3; init(j1, s0, s1, sl); qk_tile(s0, s1, L + L_KR + sl * 8192, c, qf); have = true; } }
            if (!end_step(i)) break;
        }
    } else {
        bf16x8 pa[4]; bool have = false; int i = 0;
        for (; i <= count; ++i) {
            if (i + 2 < count) issue_k(i + 2);
            if (i + 1 < count) issue_v(i + 1);
            if (HASV && have) pvf(pa, L + L_VR + ((i + 2) % 3) * 8192);
            have = false;
            if (i < count) { const int j = tile_of(i); if (need(j)) { const int sl = i % 3; f32x16 s0, s1; init(j, s0, s1, sl); qk_tile(s0, s1, L + L_KR + sl * 8192, c, qf); procA(j, s0, s1); if (HASV) pack_p(pa, s0, s1); have = true; } }
            if (!end_step(i)) break;
        }
        if (EXIT && HASV && have && i < count) pvf(pa, L + L_VR + (i % 3) * 8192);
    }
    if (EXIT) ATT_WAITBAR0();
}

__device__ void fox_unit(unsigned char* ws, unsigned char* ldsg, int b, int h, int qb, int wid0) {
    ws = opq(ws); ldsg = opq(ldsg);
    const Ctx c = make_ctx(wid0);
    LAS3 unsigned char* L = (LAS3 unsigned char*)ldsg;
    LAS3 float* wsf = (LAS3 float*)(L + L_WSF) + c.wid * 64;
    const int t0 = qb * 256;
    const int tw0 = t0 + c.wid * 32;
    const int t = tw0 + c.r32;
    const size_t hb = ((size_t)(b * 4 + h) * SEQ);
    const bf16_t* Q = (const bf16_t*)(ws + WS_QC) + (hb + t) * 64;
    const bf16_t* K = (const bf16_t*)(ws + WS_KCF) + hb * 64;
    const bf16_t* V = (const bf16_t*)(ws + WS_VCF) + hb * 64;
    const float* cf = (const float*)(ws + WS_CFOX) + hb;
    bf16x8 qf[4];
#pragma unroll
    for (int d0 = 0; d0 < 4; ++d0) qf[d0] = *(const bf16x8*)(Q + 16 * d0 + 8 * c.hi);
    const float cref = cf[t0 + 255];
    const float L2E = 1.4426950408889634f;
    float mref = 0.f, l = 0.f; bool started = false;
    f32x16 o[2]; o[0] = f32x16{}; o[1] = f32x16{};
    const int NT = (t0 + 256) / 64;
    const float cadd = cref * L2E;
    tile_pipeline<false, true, true>(L, c, qf, K, V, cf, NT,
        [&](int i) { return NT - 1 - i; },
        [&](int j) { return j * 64 <= tw0 + 31; },
        [&](int j, f32x16& p0, f32x16& p1, int abuf) {
            const LAS3 float* ax = (const LAS3 float*)(L + L_AUXR + abuf * 256);
#pragma unroll
            for (int i4 = 0; i4 < 4; ++i4) {
                const f32x4 a = *(const LAS3 f32x4*)(ax + 8 * i4 + 4 * c.hi);
                const f32x4 bq = *(const LAS3 f32x4*)(ax + 32 + 8 * i4 + 4 * c.hi);
#pragma unroll
                for (int e = 0; e < 4; ++e) { p0[4 * i4 + e] = __builtin_fmaf(a[e], -L2E, cadd - mref); p1[4 * i4 + e] = __builtin_fmaf(bq[e], -L2E, cadd - mref); }
            }
        },
        [&](int j, f32x16& p0, f32x16& p1) {
            if (j * 64 + 63 > tw0) {
                const int kv0 = j * 64 + 4 * c.hi;
#pragma unroll
                for (int r = 0; r < 16; ++r) {
                    const int kv = kv0 + (r & 3) + 8 * (r >> 2);
                    if (kv > t) p0[r] = NEG_INF;
                    if (kv + 32 > t) p1[r] = NEG_INF;
                }
            }
            softmax_step(p0, p1, mref, started, l, o, wsf, c);
        },
        [&](const bf16x8 (&pa)[4], const LAS3 unsigned char* vb) { pv_tile(o, vb, c, pa); },
        [&]() { return false; });
    l = pair_sum(l);
    float f16[16];
    rows_to_o(f16, 1.f / l, wsf, c);
    const bf16_t* Z = (const bf16_t*)(ws + WS_ZC);
    bf16_t* cat = (bf16_t*)(ws + WS_CAT);
#pragma unroll
    for (int r = 0; r < 16; ++r) {
        const size_t mrow = (size_t)b * SEQ + tw0 + crow(r, c.hi);
#pragma unroll
        for (int dblk = 0; dblk < 2; ++dblk) {
            const int d = 32 * dblk + c.r32;
            const float z = bf2f(Z[mrow * 256 + h * 64 + d]);
            cat[mrow * DM + 768 + h * 64 + d] = (bf16_t)f2bf(o[dblk][r] * f16[r] * (z / (1.f + __expf(-z))));
        }
    }
    __syncthreads();
}
}

__device__ void phase_fox(unsigned char* ws, unsigned char* ldsg, int wid0) {
    const int nunits = BATCH * 4 * 16;
    for (int u = blockIdx.x; u < nunits; u += gridDim.x) {
        const int k_ = (u % 256) / (BATCH * 4), bh = u % (BATCH * 4); const int qb = u < 256 ? 15 - k_ : k_;
        att::fox_unit(ws, ldsg, bh >> 2, bh & 3, qb, wid0);
    }
}

namespace att {
constexpr int L_IMPM = 54272, L_IMPS = 70656, L_OTOT = 87040;
__device__ __forceinline__ f32x16 splat16(float v) { f32x16 r;
#pragma unroll
    for (int i = 0; i < 16; ++i) r[i] = v;
    return r; }
__device__ __forceinline__ void stats_step(const f32x16& p0, const f32x16& p1, float& m, float& l) {
    float mx = fmaxf(p0[0], p1[0]);
#pragma unroll
    for (int r = 1; r < 16; ++r) mx = fmaxf(mx, fmaxf(p0[r], p1[r]));
    mx = pair_max(mx);
    const float mnew = fmaxf(m, mx);
    const float msafe = (mnew == NEG_INF) ? 0.f : mnew;
    l *= __builtin_amdgcn_exp2f(m - msafe);
    float s = 0.f;
#pragma unroll
    for (int r = 0; r < 16; ++r) s += __builtin_amdgcn_exp2f(p0[r] - msafe) + __builtin_amdgcn_exp2f(p1[r] - msafe);
    l += s;
    m = mnew;
}
__device__ __forceinline__ void bias_mask(f32x16& p0, f32x16& p1, const LAS3 float* bt, int t, int kp0, int kstride, int lo) {
#pragma unroll
    for (int r = 0; r < 16; ++r) {
        const int kl = (r & 3) + 8 * (r >> 2);
        const int ka = kp0 + kstride * kl, kb = ka + 32 * kstride;
        const int da = t - ka, db = t - kb;
        const float ba = bt[min(max(da, 0), 127)], bb = bt[min(max(db, 0), 127)];
        p0[r] = (da < 0 || ka < lo) ? NEG_INF : p0[r] + ba;
        p1[r] = (db < 0 || kb < lo) ? NEG_INF : p1[r] + bb;
        if ((r & 3) == 3) asm volatile("" ::: "memory");
    }
}

__device__ void nsa_unit(const Params& p, unsigned char* ws, unsigned char* ldsg, int b, int g, int qt, int wid0) {
    ws = opq(ws); ldsg = opq(ldsg);
    const Ctx c = make_ctx(wid0);
    LAS3 unsigned char* L = (LAS3 unsigned char*)ldsg;
    LAS3 float* wsf = (LAS3 float*)(L + L_WSF) + c.wid * 64;
    LAS3 float* btab = (LAS3 float*)(L + L_BTAB);
    LAS3 float* impm = (LAS3 float*)(L + L_IMPM);
    LAS3 float* imps = (LAS3 float*)(L + L_IMPS);
    const float L2E = 1.4426950408889634f;
    const int t0 = qt * 64;
    auto QL_ = [&]() { return 8 * c.wid + ((olane() & 31) >> 2); };
    auto HD_ = [&]() { return olane() & 3; };
    btab[c.tid] = p.rel_bias[bucket_of(c.tid & 127) * 8 + g * 4 + (c.tid >> 7)] * L2E;
    bf16x8 qf[4];
    {
        const bf16_t* Q = (const bf16_t*)(ws + WS_QB) + (size_t)(b * SEQ + t0 + QL_()) * 512 + g * 256 + HD_() * 64;
#pragma unroll
        for (int d0 = 0; d0 < 4; ++d0) qf[d0] = *(const bf16x8*)(Q + 16 * d0 + 8 * c.hi);
    }
    auto gate_logit = [&](int k) { const int ln = olane() & 31; return ((const float*)(ws + WS_GF))[(size_t)(b * SEQ + t0 + 8 * c.wid + (ln >> 2)) * 32 + (g * 4 + (ln & 3)) * 3 + k]; };
    __syncthreads();
    auto BT_ = [&]() { return btab + HD_() * 128; };
    const float b31 = BT_()[127];
    const size_t gb = (size_t)(b * 2 + g);
    f32x16 o[2];
    const bf16_t* KC = (const bf16_t*)(ws + WS_KCMP) + gb * 256 * 64;
    const bf16_t* VC = (const bf16_t*)(ws + WS_KCMP) + ((size_t)BATCH * 2 + gb) * 256 * 64;
    const int NTC = ((4 * qt + 2) >> 6) + 1;
    float mc = NEG_INF, lc = 0.f;
    tile_pipeline<false, false, false>(L, c, qf, KC, VC, nullptr, NTC,
        [&](int i) { return i; }, [&](int) { return true; },
        [&](int jc, f32x16& p0, f32x16& p1, int) { const float iv = (1024 * jc + 1039 + 128 <= t0) ? b31 : 0.f; p0 = splat16(iv); p1 = splat16(iv); },
        [&](int jc, f32x16& p0, f32x16& p1) {
            if (1024 * jc + 1039 + 128 > t0) bias_mask(p0, p1, BT_(), t0 + QL_(), 16 * (64 * jc + 4 * c.hi) + 31, 16, -(1 << 30));
            stats_step(p0, p1, mc, lc);
        },
        [&](const bf16x8 (&pa)[4], const LAS3 unsigned char* vb) { pv_tile(o, vb, c, pa); },
        [&]() { return false; });
    lc = pair_sum(lc);
    const float mcs = (mc == NEG_INF) ? 0.f : mc;
    const float rlc = lc > 0.f ? 1.f / lc : 0.f;
    o[0] = f32x16{}; o[1] = f32x16{};
    tile_pipeline<false, false, true>(L, c, qf, KC, VC, nullptr, NTC,
        [&](int i) { return i; }, [&](int) { return true; },
        [&](int jc, f32x16& p0, f32x16& p1, int) { const float iv = ((1024 * jc + 1039 + 128 <= t0) ? b31 : 0.f) - mcs; p0 = splat16(iv); p1 = splat16(iv); },
        [&](int jc, f32x16& p0, f32x16& p1) {
            if (1024 * jc + 1039 + 128 > t0) bias_mask(p0, p1, BT_(), t0 + QL_(), 16 * (64 * jc + 4 * c.hi) + 31, 16, -(1 << 30));
#pragma unroll
            for (int r = 0; r < 16; ++r) { p0[r] = __builtin_amdgcn_exp2f(p0[r]) * rlc; p1[r] = __builtin_amdgcn_exp2f(p1[r]) * rlc; }
#pragma unroll
            for (int blk = 0; blk < 2; ++blk)
#pragma unroll
                for (int i = 0; i < 4; ++i) {
                    const float x0 = blk ? p1[4 * i] : p0[4 * i], x1 = blk ? p1[4 * i + 1] : p0[4 * i + 1], x2 = blk ? p1[4 * i + 2] : p0[4 * i + 2], x3 = blk ? p1[4 * i + 3] : p0[4 * i + 3];
                    float a = (x0 + x1) + (x2 + 0.5f * x3), sp = 0.5f * x3;
                    a += dppf<0xB1>(a); sp += dppf<0xB1>(sp);
                    a += dppf<0x4E>(a); sp += dppf<0x4E>(sp);
                    const int sidx = 16 * jc + 8 * blk + 2 * i + c.hi;
                    if (HD_() == 0) { const int qloc = QL_(); impm[qloc * 64 + sidx] = a; if (sidx + 1 < 64) imps[qloc * 64 + sidx + 1] = sp; }
                }
        },
        [&](const bf16x8 (&pa)[4], const LAS3 unsigned char* vb) { pv_tile(o, vb, c, pa); },
        [&]() { return false; });
    {
        float f16[16];
        rows_to_o(f16, 1.f / (1.f + __expf(-gate_logit(0))), wsf, c);
        LAS3 float* otl = (LAS3 float*)(L + L_OTOT) + c.wid * 2048 + (olane() & 31);
#pragma unroll
        for (int r = 0; r < 16; ++r) { otl[crow(r, c.hi) * 64] = o[0][r] * f16[r]; otl[crow(r, c.hi) * 64 + 32] = o[1][r] * f16[r]; }
    }
    unsigned long long mymask = 0ull;
    for (int rep_ = 0; rep_ < PROBE_TOPK; ++rep_)
    for (int q2 = 0; q2 < 8; ++q2) {
        const int qq = 8 * c.wid + q2;
        const int ln = olane();
        float imp = impm[qq * 64 + ln] + (ln > 0 ? imps[qq * 64 + ln] : 0.f);
        if (ln == 0 || ln == qt || ln == qt - 1) imp = 1e4f;
        if (ln > qt) imp = -1e4f;
        int rank = 0;
#pragma unroll 16
        for (int s = 0; s < 64; ++s) {
            const float v = rdlane(imp, s);
            rank += (v > imp || (v == imp && s < ln)) ? 1 : 0;
        }
        const unsigned long long mask = __ballot(rank < 16);
        if (((ln & 31) >> 2) == q2) mymask = mask;
    }
    {
        const bf16_t* K = (const bf16_t*)(ws + WS_KSL) + gb * SEQ * 64;
        const bf16_t* V = (const bf16_t*)(ws + WS_VSL) + gb * SEQ * 64;
        float mref = 0.f, l = 0.f; bool started = false;
        o[0] = f32x16{}; o[1] = f32x16{};
        const int NT = qt + 1;
        for (int rep_ = 0; rep_ < PROBE_SEL; ++rep_)
        tile_pipeline<false, false, true>(L, c, qf, K, V, nullptr, NT,
            [&](int i) { return i; },
            [&](int j) { return __any((mymask >> j) & 1ull) != 0; },
            [&](int j, f32x16& p0, f32x16& p1, int) {
                const bool sel = (mymask >> j) & 1ull;
                const float init = sel ? (j + 2 >= qt ? 0.f : b31) - mref : NEG_INF;
                p0 = splat16(init); p1 = splat16(init);
            },
            [&](int j, f32x16& p0, f32x16& p1) {
                if (j + 2 >= qt) bias_mask(p0, p1, BT_(), t0 + QL_(), 64 * j + 4 * c.hi, 1, -(1 << 30));
                softmax_step(p0, p1, mref, started, l, o, wsf, c);
            },
            [&](const bf16x8 (&pa)[4], const LAS3 unsigned char* vb) { pv_tile(o, vb, c, pa); },
        [&]() { return false; });
        l = pair_sum(l);
        float f16[16];
        rows_to_o(f16, l > 0.f ? 1.f / ((1.f + __expf(-gate_logit(1))) * l) : 0.f, wsf, c);
        LAS3 float* otl = (LAS3 float*)(L + L_OTOT) + c.wid * 2048 + (olane() & 31);
#pragma unroll
        for (int r = 0; r < 16; ++r) { otl[crow(r, c.hi) * 64] += o[0][r] * f16[r]; otl[crow(r, c.hi) * 64 + 32] += o[1][r] * f16[r]; }
    }
    {
        const bf16_t* K = (const bf16_t*)(ws + WS_KWN) + gb * SEQ * 64;
        const bf16_t* V = (const bf16_t*)(ws + WS_VWN) + gb * SEQ * 64;
        float mref = 0.f, l = 0.f; bool started = false;
        o[0] = f32x16{}; o[1] = f32x16{};
        const int jlo = qt - 8 > 0 ? qt - 8 : 0;
        const int NT = qt - jlo + 1;
        for (int rep_ = 0; rep_ < PROBE_WIN; ++rep_)
        tile_pipeline<false, false, true>(L, c, qf, K, V, nullptr, NT,
            [&](int i) { return qt - i; }, [&](int) { return true; },
            [&](int j, f32x16& p0, f32x16& p1, int) { const float init = ((j + 2 >= qt) ? 0.f : b31) - mref; p0 = splat16(init); p1 = splat16(init); },
            [&](int j, f32x16& p0, f32x16& p1) {
                if (j + 2 >= qt) bias_mask(p0, p1, BT_(), t0 + QL_(), 64 * j + 4 * c.hi, 1, -(1 << 30));
                else if (j == qt - 8) {
                    const int lo = t0 + QL_() - 511, kp0 = 64 * j + 4 * c.hi;
#pragma unroll
                    for (int r = 0; r < 16; ++r) {
                        const int ka = kp0 + (r & 3) + 8 * (r >> 2);
                        if (ka < lo) p0[r] = NEG_INF;
                        if (ka + 32 < lo) p1[r] = NEG_INF;
                    }
                }
                softmax_step(p0, p1, mref, started, l, o, wsf, c);
            },
            [&](const bf16x8 (&pa)[4], const LAS3 unsigned char* vb) { pv_tile(o, vb, c, pa); },
        [&]() { return false; });
        l = pair_sum(l);
        float f16[16];
        rows_to_o(f16, l > 0.f ? 1.f / ((1.f + __expf(-gate_logit(2))) * l) : 0.f, wsf, c);
        LAS3 float* otl = (LAS3 float*)(L + L_OTOT) + c.wid * 2048 + (olane() & 31);
#pragma unroll
        for (int r = 0; r < 16; ++r) { otl[crow(r, c.hi) * 64] += o[0][r] * f16[r]; otl[crow(r, c.hi) * 64 + 32] += o[1][r] * f16[r]; }
    }
    {
        const bf16_t* Z = (const bf16_t*)(ws + WS_ZB);
        bf16_t* cat = (bf16_t*)(ws + WS_CAT);
        const int lnf = olane(), r32f = lnf & 31, hif = lnf >> 5;
        const LAS3 float* otl = (const LAS3 float*)(L + L_OTOT) + c.wid * 2048 + r32f;
#pragma unroll
        for (int r = 0; r < 16; ++r) {
            const int row = crow(r, hif);
            const size_t mr = (size_t)b * SEQ + t0 + 8 * c.wid + (row >> 2);
            const int h8 = g * 4 + (row & 3);
#pragma unroll
            for (int dblk = 0; dblk < 2; ++dblk) {
                const int d = 32 * dblk + r32f;
                const float z = bf2f(Z[mr * 512 + h8 * 64 + d]);
                cat[mr * DM + 256 + h8 * 64 + d] = (bf16_t)f2bf(otl[row * 64 + 32 * dblk] * (z / (1.f + __expf(-z))));
            }
        }
    }
    __syncthreads();
}
}
__device__ void phase_nsa(const Params& p, unsigned char* ws, unsigned char* ldsg, int wid0) {
    const int nunits = BATCH * 2 * 64;
    for (int u = blockIdx.x; u < nunits; u += gridDim.x) {
        const int qt = 63 - u / (BATCH * 2), bg = u % (BATCH * 2);
        att::nsa_unit(p, ws, ldsg, bg >> 1, bg & 1, qt, wid0);
    }
}

namespace att {
constexpr float SB_EXIT = 160.f;
__device__ void sb_unit(unsigned char* ws, unsigned char* ldsg, int b, int h, int qb, int wid0) {
    ws = opq(ws); ldsg = opq(ldsg);
    const Ctx c = make_ctx(wid0);
    LAS3 unsigned char* L = (LAS3 unsigned char*)ldsg;
    const int t0 = qb * 256;
    const int tw0 = t0 + c.wid * 32;
    const int t = tw0 + c.r32;
    const size_t hb = ((size_t)(b * 4 + h) * SEQ);
    const bf16_t* Q = (const bf16_t*)(ws + WS_QA) + (hb + t) * 64;
    const bf16_t* K = (const bf16_t*)(ws + WS_KA) + hb * 64;
    const bf16_t* V = (const bf16_t*)(ws + WS_VA) + hb * 64;
    bf16x8 qf[4];
#pragma unroll
    for (int d0 = 0; d0 < 4; ++d0) qf[d0] = *(const bf16x8*)(Q + 16 * d0 + 8 * c.hi);
    float carry = 0.f;
    f32x16 o[2]; o[0] = f32x16{}; o[1] = f32x16{};
    const int NT = (t0 + 256) / 64;
    tile_pipeline<true, false, true>(L, c, qf, K, V, nullptr, NT,
        [&](int i) { return NT - 1 - i; },
        [&](int j) { return (j * 64 <= tw0 + 31) && __any(carry <= SB_EXIT); },
        [&](int, f32x16& p0, f32x16& p1, int) { p0 = f32x16{}; p1 = f32x16{}; },
        [&](int j, f32x16& z0, f32x16& z1) {
            const int kv0 = j * 64 + 4 * c.hi;
            f32x16 e0, e1;
#pragma unroll
            for (int r = 0; r < 16; ++r) {
                const int kv = kv0 + (r & 3) + 8 * (r >> 2);
                const float a0 = z0[r], a1 = z1[r];
                const float s0 = fmaxf(a0, 0.f) + __builtin_amdgcn_logf(1.f + __builtin_amdgcn_exp2f(-fabsf(a0)));
                const float s1 = fmaxf(a1, 0.f) + __builtin_amdgcn_logf(1.f + __builtin_amdgcn_exp2f(-fabsf(a1)));
                e0[r] = kv < t ? s0 : 0.f;
                e1[r] = kv + 32 < t ? s1 : 0.f;
            }
            float cs[2][4], pc[2][4], after[2][4];
#pragma unroll
            for (int i4 = 0; i4 < 4; ++i4) {
                cs[0][i4] = (e0[4 * i4] + e0[4 * i4 + 1]) + (e0[4 * i4 + 2] + e0[4 * i4 + 3]);
                cs[1][i4] = (e1[4 * i4] + e1[4 * i4 + 1]) + (e1[4 * i4 + 2] + e1[4 * i4 + 3]);
                pc[0][i4] = pair_other(cs[0][i4], c.hi);
                pc[1][i4] = pair_other(cs[1][i4], c.hi);
            }
            float run = 0.f;
#pragma unroll
            for (int blk = 1; blk >= 0; --blk)
#pragma unroll
                for (int i4 = 3; i4 >= 0; --i4) { after[blk][i4] = run + (c.hi == 0 ? pc[blk][i4] : 0.f); run += cs[blk][i4] + pc[blk][i4]; }
#pragma unroll
            for (int i4 = 0; i4 < 4; ++i4) {
                {
                    const float base = carry + after[0][i4];
                    const float s3 = base + e0[4 * i4 + 3], s2 = s3 + e0[4 * i4 + 2], s1 = s2 + e0[4 * i4 + 1], s0 = s1 + e0[4 * i4];
                    const int kv = kv0 + 8 * i4;
                    z0[4 * i4] = kv < t ? __builtin_amdgcn_exp2f(z0[4 * i4] - s0) : 0.f;
                    z0[4 * i4 + 1] = kv + 1 < t ? __builtin_amdgcn_exp2f(z0[4 * i4 + 1] - s1) : 0.f;
                    z0[4 * i4 + 2] = kv + 2 < t ? __builtin_amdgcn_exp2f(z0[4 * i4 + 2] - s2) : 0.f;
                    z0[4 * i4 + 3] = kv + 3 < t ? __builtin_amdgcn_exp2f(z0[4 * i4 + 3] - s3) : 0.f;
                }
                {
                    const float base = carry + after[1][i4];
                    const float s3 = base + e1[4 * i4 + 3], s2 = s3 + e1[4 * i4 + 2], s1 = s2 + e1[4 * i4 + 1], s0 = s1 + e1[4 * i4];
                    const int kv = kv0 + 32 + 8 * i4;
                    z1[4 * i4] = kv < t ? __builtin_amdgcn_exp2f(z1[4 * i4] - s0) : 0.f;
                    z1[4 * i4 + 1] = kv + 1 < t ? __builtin_amdgcn_exp2f(z1[4 * i4 + 1] - s1) : 0.f;
                    z1[4 * i4 + 2] = kv + 2 < t ? __builtin_amdgcn_exp2f(z1[4 * i4 + 2] - s2) : 0.f;
                    z1[4 * i4 + 3] = kv + 3 < t ? __builtin_amdgcn_exp2f(z1[4 * i4 + 3] - s3) : 0.f;
                }
            }
            carry += run;
        },
        [&](const bf16x8 (&pa)[4], const LAS3 unsigned char* vb) { pv_tile(o, vb, c, pa); },
        [&]() { return __any(carry <= SB_EXIT) == 0; });
    const bf16_t* Z = (const bf16_t*)(ws + WS_ZA);
    bf16_t* cat = (bf16_t*)(ws + WS_CAT);
#pragma unroll
    for (int r = 0; r < 16; ++r) {
        const size_t mrow = (size_t)b * SEQ + tw0 + crow(r, c.hi);
#pragma unroll
        for (int dblk = 0; dblk < 2; ++dblk) {
            const int d = 32 * dblk + c.r32;
            const float z = bf2f(Z[mrow * 256 + h * 64 + d]);
            cat[mrow * DM + h * 64 + d] = (bf16_t)f2bf(o[dblk][r] * (z / (1.f + __expf(-z))));
        }
    }
    __syncthreads();
}
}

namespace pg8 {
struct EpiCompress {
    static constexpr bool PERM = false, AFTER_DRAIN = true;
    const float* bias1;
    const bf16_t* w2t;
    bf16_t* outp;
    __device__ __forceinline__ void fused(f32x4 (&acc)[2][2][4][2], const Unit& u, int wr, int wc, int fr, int fq, PG8_LAS unsigned char* lds, int wid, int lane) const {
        constexpr int PITCH = 528;
#pragma unroll
        for (int bj = 0; bj < 2; ++bj)
#pragma unroll
            for (int n = 0; n < 2; ++n) {
                const int col = bj * HALF + wc * 32 + n * 16 + 4 * fq;
                const f32x4 bv = *(const f32x4*)(bias1 + col);
#pragma unroll
                for (int ai = 0; ai < 2; ++ai)
#pragma unroll
                    for (int m = 0; m < 4; ++m) {
                        const int row = ai * HALF + wr * 64 + m * 16 + fr;
                        f32x4 v = acc[ai][bj][m][n] + bv;
#pragma unroll
                        for (int e = 0; e < 4; ++e) v[e] = v[e] / (1.f + __expf(-v[e]));
                        typedef unsigned u32x2_t __attribute__((ext_vector_type(2)));
                        u32x2_t w; w.x = pk2(v[0], v[1]); w.y = pk2(v[2], v[3]);
                        *(PG8_LAS u32x2_t*)(lds + row * PITCH + col * 2) = w;
                    }
            }
        asm volatile("s_waitcnt lgkmcnt(0)" ::: "memory"); __builtin_amdgcn_s_barrier(); asm volatile("" ::: "memory");
        typedef float f32x16 __attribute__((ext_vector_type(16)));
        const int r32 = lane & 31, hi = lane >> 5;
        f32x16 o0 = f32x16{}, o1 = f32x16{};
#pragma unroll
        for (int s = 0; s < 16; ++s) {
            const bf16x8 a = *(const PG8_LAS bf16x8*)(lds + (wid * 32 + r32) * PITCH + (16 * s + 8 * hi) * 2);
            const bf16x8 b0 = *(const bf16x8*)(w2t + (size_t)r32 * 256 + 16 * s + 8 * hi);
            const bf16x8 b1 = *(const bf16x8*)(w2t + (size_t)(32 + r32) * 256 + 16 * s + 8 * hi);
            o0 = __builtin_amdgcn_mfma_f32_32x32x16_bf16(a, b0, o0, 0, 0, 0);
            o1 = __builtin_amdgcn_mfma_f32_32x32x16_bf16(a, b1, o1, 0, 0, 0);
        }
        bf16_t* op = outp + ((size_t)u.pm * 256 + wid * 32) * 64;
#pragma unroll
        for (int r = 0; r < 16; ++r) {
            const int row = (r & 3) + 8 * (r >> 2) + 4 * hi;
            const bool pad = (wid * 32 + row) == 255;
            op[(size_t)row * 64 + r32] = pad ? (bf16_t)0 : (bf16_t)f2bf(o0[r]);
            op[(size_t)row * 64 + 32 + r32] = pad ? (bf16_t)0 : (bf16_t)f2bf(o1[r]);
        }
        asm volatile("s_waitcnt lgkmcnt(0)" ::: "memory"); __builtin_amdgcn_s_barrier(); asm volatile("" ::: "memory");
    }
};
}
__device__ void phase_mid(const Params& p, int layer, unsigned char* ws, unsigned char* ldsg, PG8_LAS unsigned char* lds3, int wid0) {
    ws = opq(ws);
    unsigned* ctr = (unsigned*)(ws + WS_CTR) + 32 + layer * 64;
    constexpr int NITEMS = 32 + 32 + BATCH * 4 * 16;
    for (;;) {
        __syncthreads();
        if (threadIdx.x == 0) *(volatile unsigned*)(ldsg + att::L_UNIT) = atomicAdd(ctr, 1u);
        __syncthreads();
        const int it = (int)*(volatile unsigned*)(ldsg + att::L_UNIT);
        if (it >= NITEMS) break;
        if (it < 32) {
            const int which = it >> 4;
            const int lw = layer * 2 + which;
            pg8::Gemm g{(const bf16_t*)(ws + (which ? WS_VC : WS_KC)), (const bf16_t*)(ws + WS_W1T) + (size_t)lw * 256 * 2048, BATCH * 2 * 256, 256, 2048, 1024, 2048};
            pg8::StaticOrder S; S.init(BATCH * 2 * 256, 256, 1 << 20, it & 15);
            pg8::EpiCompress E{(const float*)(ws + WS_BIAS1) + lw * 256, (const bf16_t*)(ws + WS_W2T) + (size_t)lw * 64 * 256, (bf16_t*)(ws + WS_KCMP) + (size_t)which * BATCH * 2 * 256 * 64};
            pg8::gemm_phase<pg8::EpiCompress, pg8::StaticOrder, false, true>(lds3, g, S, E, wid0);
        } else if (it < 64) {
            const int tid_ = otid(wid0);
            const int bi = it - 32, b = bi >> 2, h = bi & 3;
            const float* gf = (const float*)(ws + WS_GF);
            float* cfox = (float*)(ws + WS_CFOX) + ((size_t)(b * 4 + h)) * SEQ;
            const float fb = p.forget_b[layer * 4 + h];
            float lf[8]; double s = 0.0;
#pragma unroll
            for (int i = 0; i < 8; ++i) {
                const float v = gf[((size_t)b * SEQ + 8 * tid_ + i) * 32 + 24 + h] + fb;
                lf[i] = fminf(v, 0.f) - LN2 * __builtin_amdgcn_logf(1.f + __builtin_amdgcn_exp2f(-fabsf(v) * 1.4426950408889634f));
                s += (double)lf[i];
            }
            double* tsum = (double*)(ldsg + 100000);
            tsum[tid_] = s;
            __syncthreads();
            double run = 0.0;
            for (int k = 0; k < tid_; ++k) run += tsum[k];
#pragma unroll
            for (int i = 0; i < 8; ++i) { run += (double)lf[i]; cfox[8 * tid_ + i] = (float)run; }
        } else {
            const int u = it - 64;
            const int qb = 15 - u / (BATCH * 4), bh = u % (BATCH * 4);
            att::sb_unit(ws, ldsg, bh >> 2, bh & 3, qb, wid0);
        }
    }
}

__global__ void __launch_bounds__(NTHREADS, 2) mega(Params p) {
    cg::grid_group grid = cg::this_grid();
    extern __shared__ __attribute__((aligned(16))) unsigned char lds[];
    PG8_LAS unsigned char* lds3 = (PG8_LAS unsigned char*)lds;
    const int wid0 = __builtin_amdgcn_readfirstlane((int)(threadIdx.x >> 6));

    if (blockIdx.x == 0 && threadIdx.x < 128) ((unsigned*)(p.ws + WS_CTR))[threadIdx.x] = 0u;
    for (int rep_ = 0; rep_ < PROBE_P0; ++rep_) p0_weights(p, wid0);
    for (int rep_ = 0; rep_ < PROBE_CVT; ++rep_) phase_convert_x(p.x, (bf16_t*)(p.ws + WS_XB), (float*)(p.ws + WS_SS), wid0);
    grid.sync();
    for (int layer = 0; layer < DEPTH; ++layer) {
        const float* xin = layer == 0 ? p.x : p.out;
        unsigned char* ws = opq(p.ws);
        bf16_t* xb = (bf16_t*)(ws + WS_XB); bf16_t* cat = (bf16_t*)(ws + WS_CAT); float* ss = (float*)(ws + WS_SS);
        {
            pg8::Gemm g{xb, (const bf16_t*)(ws + WS_WTIN) + (size_t)layer * NPAD * DM, MTOK, NPAD, DM, DM, DM};
            pg8::StaticOrder S; S.init(MTOK, NPAD, (int)gridDim.x, (int)blockIdx.x);
            pg8::EpiInProj E{ws, ss};
            for (int rep_ = 0; rep_ < PROBE_INP; ++rep_) pg8::gemm_phase<pg8::EpiInProj, pg8::StaticOrder, true, true>(lds3, g, S, E, wid0);
        }
        grid.sync();
        for (int rep_ = 0; rep_ < PROBE_MID; ++rep_) { phase_mid(p, layer, ws, lds, lds3, wid0); if (rep_ + 1 < PROBE_MID) grid.sync(); }
        grid.sync();
        {
            for (int rep_ = 0; rep_ < PROBE_ATT; ++rep_) {
            unsigned* ctr = (unsigned*)(ws + WS_CTR) + layer * 64 + rep_ * 16;
            for (;;) {
                __syncthreads();
                if (threadIdx.x == 0) *(volatile unsigned*)(lds + att::L_UNIT) = atomicAdd(ctr, 1u);
                __syncthreads();
                const unsigned u = *(volatile unsigned*)(lds + att::L_UNIT);
                if (u >= (unsigned)N_ATT_UNITS) break;
                const unsigned code = c_unit_order[u];
                const int q = (code >> 5) & 63, x = code & 31;
                if (code >> 11) att::nsa_unit(p, ws, lds, x >> 1, x & 1, q, wid0);
                else att::fox_unit(ws, lds, x >> 2, x & 3, q, wid0);
            }
            }
        }
        grid.sync();
        {
            pg8::Gemm g{cat, (const bf16_t*)(ws + WS_WTOUT) + (size_t)layer * DM * DM, MTOK, DM, DM, DM, DM};
            pg8::StaticOrder S; S.init(MTOK, DM, (int)gridDim.x, (int)blockIdx.x);
            pg8::EpiOutProj E{xin, p.out};
            for (int rep_ = 0; rep_ < (layer == 0 ? PROBE_OUT : 1); ++rep_) pg8::gemm_phase<pg8::EpiOutProj, pg8::StaticOrder, true, true>(lds3, g, S, E, wid0);
        }
        grid.sync();
        if (layer == 0) { phase_convert_x(p.out, xb, ss, wid0); grid.sync(); }
    }
    phase_final_norm(p.out, p.final_g, wid0);
}

extern "C" void kernel_launch(void* const* d_in, const int* in_sizes, int n_in, void* d_out, int out_size, void* d_ws, size_t ws_size, hipStream_t stream) {
    static int grid_blocks = 0;
    if (!grid_blocks) {
        if (ws_size < WS_END) { fprintf(stderr, "kernel_launch: workspace too small (%zu < %zu)\n", ws_size, (size_t)WS_END); grid_blocks = -1; return; }
        int dev = 0, cus = 0, per_cu = 0;
        (void)hipGetDevice(&dev);
        (void)hipDeviceGetAttribute(&cus, hipDeviceAttributeMultiprocessorCount, dev);
        (void)hipFuncSetAttribute((const void*)mega, hipFuncAttributeMaxDynamicSharedMemorySize, LDS_BYTES);
        (void)hipOccupancyMaxActiveBlocksPerMultiprocessor(&per_cu, mega, NTHREADS, LDS_BYTES);
        if (per_cu < 1) { fprintf(stderr, "kernel_launch: occupancy query says %d blocks/CU\n", per_cu); per_cu = 1; }
        grid_blocks = cus;
    }
    if (grid_blocks < 0) return;
    Params p{};
    p.x = (const float*)d_in[0]; p.norm_g = (const float*)d_in[1]; p.w_in = (const float*)d_in[2]; p.w_out = (const float*)d_in[3];
    p.forget_b = (const float*)d_in[4]; p.cmp_w1 = (const float*)d_in[5]; p.cmp_b1 = (const float*)d_in[6]; p.cmp_w2 = (const float*)d_in[7];
    p.cmp_pe = (const float*)d_in[8]; p.rel_bias = (const float*)d_in[9]; p.final_g = (const float*)d_in[10];
    p.out = (float*)d_out; p.ws = (unsigned char*)d_ws;
    void* args[] = {&p};
    hipError_t e = hipLaunchCooperativeKernel((void*)mega, dim3(grid_blocks), dim3(NTHREADS), args, LDS_BYTES, stream);
    if (e != hipSuccess) fprintf(stderr, "cooperative launch failed: %s (grid %d)\n", hipGetErrorString(e), grid_blocks);
}
```

```cpp
#include <hip/hip_runtime.h>
#include <hip/hip_cooperative_groups.h>
#include <cstdio>
#include <cstdint>
namespace cg = cooperative_groups;
#define PROBE_FOX 1
#define PROBE_NSA 1
#define PROBE_MID 1
#define PROBE_INP 1
#define PROBE_P0 1
#define PROBE_CVT 1
#define PROBE_TIME 0
#define PROBE_SYNC 0
#define PROBE_ATT 1
#define PROBE_OUT 1
#define PROBE_TOPK 1
#define PROBE_SEL 1
#define PROBE_WIN 1

constexpr int DM = 1024, BATCH = 8, SEQ = 4096, DEPTH = 2, HD = 64, MTOK = BATCH * SEQ;
constexpr int INW = 3868, NPAD = 4096;
constexpr int C_QA = 0, C_KA = 256, C_VA = 512, C_ZA = 768, C_QB = 1024, C_KC = 1536, C_VC = 1664, C_KSL = 1792, C_VSL = 1920,
              C_KWN = 2048, C_VWN = 2176, C_GB = 2304, C_ZB = 2328, C_QC = 2840, C_KCF = 3096, C_VCF = 3352, C_FC = 3608, C_ZC = 3612;
constexpr int NCMP = 255;
constexpr float QSCALE = 0.125f * 1.4426950408889634f;
constexpr float LN2 = 0.6931471805599453f;
constexpr size_t MiB = 1u << 20;
constexpr size_t WS_WTIN = 0, WS_WTOUT = 16 * MiB, WS_W1T = 20 * MiB, WS_W2T = 24 * MiB, WS_BIAS1 = 25 * MiB, WS_SS = 25 * MiB + 512 * 1024, WS_CTR = 25 * MiB + 768 * 1024, WS_BAR = 25 * MiB + 800 * 1024, WS_KMAX = 25 * MiB + 900 * 1024,
                 WS_CFOX = 26 * MiB, WS_SEL = 27 * MiB, WS_KCMP = 28 * MiB, WS_GF = 30 * MiB, WS_XB = 36 * MiB, WS_CAT = 100 * MiB,
                 WS_QA = 164 * MiB, WS_KA = 180 * MiB, WS_VA = 196 * MiB, WS_ZA = 212 * MiB, WS_QB = 228 * MiB, WS_KC = 260 * MiB, WS_VC = 268 * MiB,
                 WS_KSL = 276 * MiB, WS_VSL = 284 * MiB, WS_KWN = 292 * MiB, WS_VWN = 300 * MiB, WS_ZB = 308 * MiB, WS_QC = 340 * MiB, WS_KCF = 356 * MiB,
                 WS_VCF = 372 * MiB, WS_ZC = 388 * MiB, WS_DBG_PROJF = 404 * MiB, WS_DBG_OCMP = 466 * MiB, WS_DBG_KCMPF = 475 * MiB, WS_END = 480 * MiB;
constexpr int LDS_BAR_OFF = 157184;
constexpr int LDS_BYTES = 157184 + 64;
constexpr int NTHREADS = 512, NWAVES = 8;

typedef unsigned short bf16_t;
__device__ __forceinline__ float bf2f(bf16_t v) { return __uint_as_float((unsigned)v << 16); }
__device__ __forceinline__ unsigned f2bf(float f) { unsigned u = __float_as_uint(f); return (u + 0x7fffu + ((u >> 16) & 1u)) >> 16; }
typedef float f32x2_hw_t __attribute__((ext_vector_type(2))); typedef __bf16 bf16x2_hw_t __attribute__((ext_vector_type(2)));
__device__ __forceinline__ unsigned pk2(float lo, float hi) { f32x2_hw_t v = {lo, hi}; bf16x2_hw_t b = __builtin_convertvector(v, bf16x2_hw_t); return __builtin_bit_cast(unsigned, b); }

__constant__ unsigned char c_bucket[128] = {0, 1, 2, 3, 4, 5, 6, 7, 8, 9, 10, 11, 12, 13, 14, 15, 16, 16, 16, 17, 17, 18, 18, 18, 19, 19, 19, 20, 20, 20, 20, 21, 21, 21, 21, 22, 22, 22, 22, 22, 23, 23, 23, 23, 23, 23, 24, 24, 24, 24, 24, 24, 25, 25, 25, 25, 25, 25, 25, 26, 26, 26, 26, 26, 26, 26, 26, 27, 27, 27, 27, 27, 27, 27, 27, 27, 27, 28, 28, 28, 28, 28, 28, 28, 28, 28, 28, 29, 29, 29, 29, 29, 29, 29, 29, 29, 29, 29, 29, 30, 30, 30, 30, 30, 30, 30, 30, 30, 30, 30, 30, 30, 30, 31, 31, 31, 31, 31, 31, 31, 31, 31, 31, 31, 31, 31, 31, 31};

struct Params {
    const float *x, *norm_g, *w_in, *w_out, *forget_b, *cmp_w1, *cmp_b1, *cmp_w2, *cmp_pe, *rel_bias, *final_g;
    float* out;
    unsigned char* ws;
};

template <int CTRL> __device__ __forceinline__ float dppf(float v) { return __int_as_float(__builtin_amdgcn_update_dpp(0, __float_as_int(v), CTRL, 0xF, 0xF, true)); }
__device__ __forceinline__ float rdlane(float v, int l) { return __int_as_float(__builtin_amdgcn_readlane(__float_as_int(v), l)); }
__device__ __forceinline__ float wave_sum(float v) {
    v += dppf<0xB1>(v); v += dppf<0x4E>(v); v += dppf<0x141>(v); v += dppf<0x140>(v);
    return (rdlane(v, 0) + rdlane(v, 16)) + (rdlane(v, 32) + rdlane(v, 48));
}
__device__ __forceinline__ float wave_max(float v) {
    v = fmaxf(v, dppf<0xB1>(v)); v = fmaxf(v, dppf<0x4E>(v)); v = fmaxf(v, dppf<0x141>(v)); v = fmaxf(v, dppf<0x140>(v));
    return fmaxf(fmaxf(rdlane(v, 0), rdlane(v, 16)), fmaxf(rdlane(v, 32), rdlane(v, 48)));
}
__device__ __forceinline__ void pair32(float v, float& lo, float& hi) { auto rr = __builtin_amdgcn_permlane32_swap(__float_as_uint(v), __float_as_uint(v), false, false); lo = __uint_as_float(rr[0]); hi = __uint_as_float(rr[1]); }
__device__ __forceinline__ float pair_max(float v) { float a, b; pair32(v, a, b); return fmaxf(a, b); }
__device__ __forceinline__ float pair_sum(float v) { float a, b; pair32(v, a, b); return a + b; }
__device__ __forceinline__ float pair_other(float v, int hi) { float a, b; pair32(v, a, b); return hi ? a : b; }
__device__ __forceinline__ float sigmoidf_(float v) { return 1.f / (1.f + expf(-v)); }
__device__ __forceinline__ float siluf_(float v) { return v / (1.f + expf(-v)); }
__device__ __forceinline__ float softplusf_(float z) { return fmaxf(z, 0.f) + log1pf(expf(-fabsf(z))); }
__device__ __forceinline__ int bucket_of(int dist) { return dist >= 128 ? 31 : (int)c_bucket[dist < 0 ? 0 : dist]; }
__device__ __forceinline__ int otid(int wid0) { unsigned z = 0u; asm volatile("" : "+v"(z)); int t = wid0 * 64 + (int)__builtin_amdgcn_mbcnt_hi(~0u, __builtin_amdgcn_mbcnt_lo(~0u, z)); asm volatile("" : "+v"(t)); return t; }
template <class T> __device__ __forceinline__ T* opq(T* p) { asm volatile("" : "+s"(p)); return p; }
__device__ __forceinline__ int opqi(int v) { asm volatile("" : "+v"(v)); return v; }
__device__ __forceinline__ int olane() { unsigned z = 0u; asm volatile("" : "+v"(z)); return (int)__builtin_amdgcn_mbcnt_hi(~0u, __builtin_amdgcn_mbcnt_lo(~0u, z)); }
constexpr int N_ATT_UNITS = 2112;
__constant__ unsigned short c_unit_order[N_ATT_UNITS] = {4096, 4097, 4098, 4099, 4100, 4101, 4102, 4103, 4104, 4105, 4106, 4107, 4108, 4109, 4110, 4111, 4112, 4113, 4114, 4115, 4116, 4117, 4118, 4119, 4120, 4121, 4122, 4123, 4124, 4125, 4126, 4127, 6144, 6145, 6146, 6147, 6148, 6149, 6150, 6151, 6152, 6153, 6154, 6155, 6156, 6157, 6158, 6159, 6160, 6161, 6162, 6163, 6164, 6165, 6166, 6167, 6168, 6169, 6170, 6171, 6172, 6173, 6174, 6175, 480, 481, 482, 483, 484, 485, 486, 487, 488, 489, 490, 491, 492, 493, 494, 495, 496, 497, 498, 499, 500, 501, 502, 503, 504, 505, 506, 507, 508, 509, 510, 511, 448, 449, 450, 451, 452, 453, 454, 455, 456, 457, 458, 459, 460, 461, 462, 463, 464, 465, 466, 467, 468, 469, 470, 471, 472, 473, 474, 475, 476, 477, 478, 479, 416, 417, 418, 419, 420, 421, 422, 423, 424, 425, 426, 427, 428, 429, 430, 431, 432, 433, 434, 435, 436, 437, 438, 439, 440, 441, 442, 443, 444, 445, 446, 447, 384, 385, 386, 387, 388, 389, 390, 391, 392, 393, 394, 395, 396, 397, 398, 399, 400, 401, 402, 403, 404, 405, 406, 407, 408, 409, 410, 411, 412, 413, 414, 415, 352, 353, 354, 355, 356, 357, 358, 359, 360, 361, 362, 363, 364, 365, 366, 367, 368, 369, 370, 371, 372, 373, 374, 375, 376, 377, 378, 379, 380, 381, 382, 383, 320, 321, 322, 323, 324, 325, 326, 327, 328, 329, 330, 331, 332, 333, 334, 335, 336, 337, 338, 339, 340, 341, 342, 343, 344, 345, 346, 347, 348, 349, 350, 351, 288, 289, 290, 291, 292, 293, 294, 295, 296, 297, 298, 299, 300, 301, 302, 303, 304, 305, 306, 307, 308, 309, 310, 311, 312, 313, 314, 315, 316, 317, 318, 319, 256, 257, 258, 259, 260, 261, 262, 263, 264, 265, 266, 267, 268, 269, 270, 271, 272, 273, 274, 275, 276, 277, 278, 279, 280, 281, 282, 283, 284, 285, 286, 287, 224, 225, 226, 227, 228, 229, 230, 231, 232, 233, 234, 235, 236, 237, 238, 239, 240, 241, 242, 243, 244, 245, 246, 247, 248, 249, 250, 251, 252, 253, 254, 255, 192, 193, 194, 195, 196, 197, 198, 199, 200, 201, 202, 203, 204, 205, 206, 207, 208, 209, 210, 211, 212, 213, 214, 215, 216, 217, 218, 219, 220, 221, 222, 223, 160, 161, 162, 163, 164, 165, 166, 167, 168, 169, 170, 171, 172, 173, 174, 175, 176, 177, 178, 179, 180, 181, 182, 183, 184, 185, 186, 187, 188, 189, 190, 191, 128, 129, 130, 131, 132, 133, 134, 135, 136, 137, 138, 139, 140, 141, 142, 143, 144, 145, 146, 147, 148, 149, 150, 151, 152, 153, 154, 155, 156, 157, 158, 159, 96, 97, 98, 99, 100, 101, 102, 103, 104, 105, 106, 107, 108, 109, 110, 111, 112, 113, 114, 115, 116, 117, 118, 119, 120, 121, 122, 123, 124, 125, 126, 127, 64, 65, 66, 67, 68, 69, 70, 71, 72, 73, 74, 75, 76, 77, 78, 79, 80, 81, 82, 83, 84, 85, 86, 87, 88, 89, 90, 91, 92, 93, 94, 95, 32, 33, 34, 35, 36, 37, 38, 39, 40, 41, 42, 43, 44, 45, 46, 47, 48, 49, 50, 51, 52, 53, 54, 55, 56, 57, 58, 59, 60, 61, 62, 63, 0, 1, 2, 3, 4, 5, 6, 7, 8, 9, 10, 11, 12, 13, 14, 15, 16, 17, 18, 19, 20, 21, 22, 23, 24, 25, 26, 27, 28, 29, 30, 31, 4064, 4065, 4066, 4067, 4068, 4069, 4070, 4071, 4072, 4073, 4074, 4075, 4076, 4077, 4078, 4079, 4032, 4033, 4034, 4035, 4036, 4037, 4038, 4039, 4040, 4041, 4042, 4043, 4044, 4045, 4046, 4047, 4000, 4001, 4002, 4003, 4004, 4005, 4006, 4007, 4008, 4009, 4010, 4011, 4012, 4013, 4014, 4015, 3968, 3969, 3970, 3971, 3972, 3973, 3974, 3975, 3976, 3977, 3978, 3979, 3980, 3981, 3982, 3983, 3936, 3937, 3938, 3939, 3940, 3941, 3942, 3943, 3944, 3945, 3946, 3947, 3948, 3949, 3950, 3951, 3904, 3905, 3906, 3907, 3908, 3909, 3910, 3911, 3912, 3913, 3914, 3915, 3916, 3917, 3918, 3919, 3872, 3873, 3874, 3875, 3876, 3877, 3878, 3879, 3880, 3881, 3882, 3883, 3884, 3885, 3886, 3887, 3840, 3841, 3842, 3843, 3844, 3845, 3846, 3847, 3848, 3849, 3850, 3851, 3852, 3853, 3854, 3855, 3808, 3809, 3810, 3811, 3812, 3813, 3814, 3815, 3816, 3817, 3818, 3819, 3820, 3821, 3822, 3823, 3776, 3777, 3778, 3779, 3780, 3781, 3782, 3783, 3784, 3785, 3786, 3787, 3788, 3789, 3790, 3791, 3744, 3745, 3746, 3747, 3748, 3749, 3750, 3751, 3752, 3753, 3754, 3755, 3756, 3757, 3758, 3759, 3712, 3713, 3714, 3715, 3716, 3717, 3718, 3719, 3720, 3721, 3722, 3723, 3724, 3725, 3726, 3727, 3680, 3681, 3682, 3683, 3684, 3685, 3686, 3687, 3688, 3689, 3690, 3691, 3692, 3693, 3694, 3695, 3648, 3649, 3650, 3651, 3652, 3653, 3654, 3655, 3656, 3657, 3658, 3659, 3660, 3661, 3662, 3663, 3616, 3617, 3618, 3619, 3620, 3621, 3622, 3623, 3624, 3625, 3626, 3627, 3628, 3629, 3630, 3631, 3584, 3585, 3586, 3587, 3588, 3589, 3590, 3591, 3592, 3593, 3594, 3595, 3596, 3597, 3598, 3599, 3552, 3553, 3554, 3555, 3556, 3557, 3558, 3559, 3560, 3561, 3562, 3563, 3564, 3565, 3566, 3567, 3520, 3521, 3522, 3523, 3524, 3525, 3526, 3527, 3528, 3529, 3530, 3531, 3532, 3533, 3534, 3535, 3488, 3489, 3490, 3491, 3492, 3493, 3494, 3495, 3496, 3497, 3498, 3499, 3500, 3501, 3502, 3503, 3456, 3457, 3458, 3459, 3460, 3461, 3462, 3463, 3464, 3465, 3466, 3467, 3468, 3469, 3470, 3471, 3424, 3425, 3426, 3427, 3428, 3429, 3430, 3431, 3432, 3433, 3434, 3435, 3436, 3437, 3438, 3439, 3392, 3393, 3394, 3395, 3396, 3397, 3398, 3399, 3400, 3401, 3402, 3403, 3404, 3405, 3406, 3407, 3360, 3361, 3362, 3363, 3364, 3365, 3366, 3367, 3368, 3369, 3370, 3371, 3372, 3373, 3374, 3375, 3328, 3329, 3330, 3331, 3332, 3333, 3334, 3335, 3336, 3337, 3338, 3339, 3340, 3341, 3342, 3343, 3296, 3297, 3298, 3299, 3300, 3301, 3302, 3303, 3304, 3305, 3306, 3307, 3308, 3309, 3310, 3311, 3264, 3265, 3266, 3267, 3268, 3269, 3270, 3271, 3272, 3273, 3274, 3275, 3276, 3277, 3278, 3279, 3232, 3233, 3234, 3235, 3236, 3237, 3238, 3239, 3240, 3241, 3242, 3243, 3244, 3245, 3246, 3247, 3200, 3201, 3202, 3203, 3204, 3205, 3206, 3207, 3208, 3209, 3210, 3211, 3212, 3213, 3214, 3215, 3168, 3169, 3170, 3171, 3172, 3173, 3174, 3175, 3176, 3177, 3178, 3179, 3180, 3181, 3182, 3183, 3136, 3137, 3138, 3139, 3140, 3141, 3142, 3143, 3144, 3145, 3146, 3147, 3148, 3149, 3150, 3151, 3104, 3105, 3106, 3107, 3108, 3109, 3110, 3111, 3112, 3113, 3114, 3115, 3116, 3117, 3118, 3119, 3072, 3073, 3074, 3075, 3076, 3077, 3078, 3079, 3080, 3081, 3082, 3083, 3084, 3085, 3086, 3087, 3040, 3041, 3042, 3043, 3044, 3045, 3046, 3047, 3048, 3049, 3050, 3051, 3052, 3053, 3054, 3055, 3008, 3009, 3010, 3011, 3012, 3013, 3014, 3015, 3016, 3017, 3018, 3019, 3020, 3021, 3022, 3023, 2976, 2977, 2978, 2979, 2980, 2981, 2982, 2983, 2984, 2985, 2986, 2987, 2988, 2989, 2990, 2991, 2944, 2945, 2946, 2947, 2948, 2949, 2950, 2951, 2952, 2953, 2954, 2955, 2956, 2957, 2958, 2959, 2912, 2913, 2914, 2915, 2916, 2917, 2918, 2919, 2920, 2921, 2922, 2923, 2924, 2925, 2926, 2927, 2880, 2881, 2882, 2883, 2884, 2885, 2886, 2887, 2888, 2889, 2890, 2891, 2892, 2893, 2894, 2895, 2848, 2849, 2850, 2851, 2852, 2853, 2854, 2855, 2856, 2857, 2858, 2859, 2860, 2861, 2862, 2863, 2816, 2817, 2818, 2819, 2820, 2821, 2822, 2823, 2824, 2825, 2826, 2827, 2828, 2829, 2830, 2831, 2784, 2785, 2786, 2787, 2788, 2789, 2790, 2791, 2792, 2793, 2794, 2795, 2796, 2797, 2798, 2799, 2752, 2753, 2754, 2755, 2756, 2757, 2758, 2759, 2760, 2761, 2762, 2763, 2764, 2765, 2766, 2767, 2720, 2721, 2722, 2723, 2724, 2725, 2726, 2727, 2728, 2729, 2730, 2731, 2732, 2733, 2734, 2735, 2688, 2689, 2690, 2691, 2692, 2693, 2694, 2695, 2696, 2697, 2698, 2699, 2700, 2701, 2702, 2703, 2656, 2657, 2658, 2659, 2660, 2661, 2662, 2663, 2664, 2665, 2666, 2667, 2668, 2669, 2670, 2671, 2624, 2625, 2626, 2627, 2628, 2629, 2630, 2631, 2632, 2633, 2634, 2635, 2636, 2637, 2638, 2639, 2592, 2593, 2594, 2595, 2596, 2597, 2598, 2599, 2600, 2601, 2602, 2603, 2604, 2605, 2606, 2607, 2560, 2561, 2562, 2563, 2564, 2565, 2566, 2567, 2568, 2569, 2570, 2571, 2572, 2573, 2574, 2575, 2528, 2529, 2530, 2531, 2532, 2533, 2534, 2535, 2536, 2537, 2538, 2539, 2540, 2541, 2542, 2543, 2496, 2497, 2498, 2499, 2500, 2501, 2502, 2503, 2504, 2505, 2506, 2507, 2508, 2509, 2510, 2511, 2464, 2465, 2466, 2467, 2468, 2469, 2470, 2471, 2472, 2473, 2474, 2475, 2476, 2477, 2478, 2479, 2432, 2433, 2434, 2435, 2436, 2437, 2438, 2439, 2440, 2441, 2442, 2443, 2444, 2445, 2446, 2447, 2400, 2401, 2402, 2403, 2404, 2405, 2406, 2407, 2408, 2409, 2410, 2411, 2412, 2413, 2414, 2415, 2368, 2369, 2370, 2371, 2372, 2373, 2374, 2375, 2376, 2377, 2378, 2379, 2380, 2381, 2382, 2383, 2336, 2337, 2338, 2339, 2340, 2341, 2342, 2343, 2344, 2345, 2346, 2347, 2348, 2349, 2350, 2351, 2304, 2305, 2306, 2307, 2308, 2309, 2310, 2311, 2312, 2313, 2314, 2315, 2316, 2317, 2318, 2319, 2272, 2273, 2274, 2275, 2276, 2277, 2278, 2279, 2280, 2281, 2282, 2283, 2284, 2285, 2286, 2287, 2240, 2241, 2242, 2243, 2244, 2245, 2246, 2247, 2248, 2249, 2250, 2251, 2252, 2253, 2254, 2255, 2208, 2209, 2210, 2211, 2212, 2213, 2214, 2215, 2216, 2217, 2218, 2219, 2220, 2221, 2222, 2223, 2176, 2177, 2178, 2179, 2180, 2181, 2182, 2183, 2184, 2185, 2186, 2187, 2188, 2189, 2190, 2191, 2144, 2145, 2146, 2147, 2148, 2149, 2150, 2151, 2152, 2153, 2154, 2155, 2156, 2157, 2158, 2159, 2112, 2113, 2114, 2115, 2116, 2117, 2118, 2119, 2120, 2121, 2122, 2123, 2124, 2125, 2126, 2127, 2080, 2081, 2082, 2083, 2084, 2085, 2086, 2087, 2088, 2089, 2090, 2091, 2092, 2093, 2094, 2095, 2048, 2049, 2050, 2051, 2052, 2053, 2054, 2055, 2056, 2057, 2058, 2059, 2060, 2061, 2062, 2063, 8672, 8673, 8674, 8675, 8676, 8677, 8678, 8679, 8680, 8681, 8682, 8683, 8684, 8685, 8686, 8687, 8688, 8689, 8690, 8691, 8692, 8693, 8694, 8695, 8696, 8697, 8698, 8699, 8700, 8701, 8702, 8703, 8640, 8641, 8642, 8643, 8644, 8645, 8646, 8647, 8648, 8649, 8650, 8651, 8652, 8653, 8654, 8655, 8656, 8657, 8658, 8659, 8660, 8661, 8662, 8663, 8664, 8665, 8666, 8667, 8668, 8669, 8670, 8671, 8608, 8609, 8610, 8611, 8612, 8613, 8614, 8615, 8616, 8617, 8618, 8619, 8620, 8621, 8622, 8623, 8624, 8625, 8626, 8627, 8628, 8629, 8630, 8631, 8632, 8633, 8634, 8635, 8636, 8637, 8638, 8639, 8576, 8577, 8578, 8579, 8580, 8581, 8582, 8583, 8584, 8585, 8586, 8587, 8588, 8589, 8590, 8591, 8592, 8593, 8594, 8595, 8596, 8597, 8598, 8599, 8600, 8601, 8602, 8603, 8604, 8605, 8606, 8607, 8544, 8545, 8546, 8547, 8548, 8549, 8550, 8551, 8552, 8553, 8554, 8555, 8556, 8557, 8558, 8559, 8560, 8561, 8562, 8563, 8564, 8565, 8566, 8567, 8568, 8569, 8570, 8571, 8572, 8573, 8574, 8575, 8512, 8513, 8514, 8515, 8516, 8517, 8518, 8519, 8520, 8521, 8522, 8523, 8524, 8525, 8526, 8527, 8528, 8529, 8530, 8531, 8532, 8533, 8534, 8535, 8536, 8537, 8538, 8539, 8540, 8541, 8542, 8543, 8480, 8481, 8482, 8483, 8484, 8485, 8486, 8487, 8488, 8489, 8490, 8491, 8492, 8493, 8494, 8495, 8496, 8497, 8498, 8499, 8500, 8501, 8502, 8503, 8504, 8505, 8506, 8507, 8508, 8509, 8510, 8511, 8448, 8449, 8450, 8451, 8452, 8453, 8454, 8455, 8456, 8457, 8458, 8459, 8460, 8461, 8462, 8463, 8464, 8465, 8466, 8467, 8468, 8469, 8470, 8471, 8472, 8473, 8474, 8475, 8476, 8477, 8478, 8479, 8416, 8417, 8418, 8419, 8420, 8421, 8422, 8423, 8424, 8425, 8426, 8427, 8428, 8429, 8430, 8431, 8432, 8433, 8434, 8435, 8436, 8437, 8438, 8439, 8440, 8441, 8442, 8443, 8444, 8445, 8446, 8447, 8384, 8385, 8386, 8387, 8388, 8389, 8390, 8391, 8392, 8393, 8394, 8395, 8396, 8397, 8398, 8399, 8400, 8401, 8402, 8403, 8404, 8405, 8406, 8407, 8408, 8409, 8410, 8411, 8412, 8413, 8414, 8415, 8352, 8353, 8354, 8355, 8356, 8357, 8358, 8359, 8360, 8361, 8362, 8363, 8364, 8365, 8366, 8367, 8368, 8369, 8370, 8371, 8372, 8373, 8374, 8375, 8376, 8377, 8378, 8379, 8380, 8381, 8382, 8383, 8320, 8321, 8322, 8323, 8324, 8325, 8326, 8327, 8328, 8329, 8330, 8331, 8332, 8333, 8334, 8335, 8336, 8337, 8338, 8339, 8340, 8341, 8342, 8343, 8344, 8345, 8346, 8347, 8348, 8349, 8350, 8351, 8288, 8289, 8290, 8291, 8292, 8293, 8294, 8295, 8296, 8297, 8298, 8299, 8300, 8301, 8302, 8303, 8304, 8305, 8306, 8307, 8308, 8309, 8310, 8311, 8312, 8313, 8314, 8315, 8316, 8317, 8318, 8319, 8256, 8257, 8258, 8259, 8260, 8261, 8262, 8263, 8264, 8265, 8266, 8267, 8268, 8269, 8270, 8271, 8272, 8273, 8274, 8275, 8276, 8277, 8278, 8279, 8280, 8281, 8282, 8283, 8284, 8285, 8286, 8287, 8224, 8225, 8226, 8227, 8228, 8229, 8230, 8231, 8232, 8233, 8234, 8235, 8236, 8237, 8238, 8239, 8240, 8241, 8242, 8243, 8244, 8245, 8246, 8247, 8248, 8249, 8250, 8251, 8252, 8253, 8254, 8255, 8192, 8193, 8194, 8195, 8196, 8197, 8198, 8199, 8200, 8201, 8202, 8203, 8204, 8205, 8206, 8207, 8208, 8209, 8210, 8211, 8212, 8213, 8214, 8215, 8216, 8217, 8218, 8219, 8220, 8221, 8222, 8223};
#if PROBE_TIME
#define TBEG(K, Lp, widv) do { if (PROBE_TIME == (K) && (widv) == 0) *(__attribute__((address_space(3))) long long*)((Lp) + 157184 + 24) = clock64(); } while (0)
#define TEND(K, Lp, widv) do { if (PROBE_TIME == (K) && (widv) == 0) { const long long d_ = clock64() - *(__attribute__((address_space(3))) long long*)((Lp) + 157184 + 24); if (olane() == 0) *(__attribute__((address_space(3))) long long*)((Lp) + 157184 + 16) += d_; } } while (0)
#else
#define TBEG(K, Lp, widv) do {} while (0)
#define TEND(K, Lp, widv) do {} while (0)
#endif
#define LAS __attribute__((address_space(3)))
#define XB_TMO      128
#define XB_XCNT(j)  (256  + 64 * (j))
#define XB_XSUB(j)  (1280 + 64 * (j))
#define XB_XGEN(j)  (2304 + 64 * (j))
#define XB_TOP      3328
#define XB_TOPGEN   3392
#define XCD_BAR_WORDS 3456
#define XB_SPIN_CAP (1u << 18)

__device__ __forceinline__ unsigned xb_ld(unsigned* p)              { return __hip_atomic_load(p, __ATOMIC_RELAXED, __HIP_MEMORY_SCOPE_AGENT); }
__device__ __forceinline__ unsigned xb_add(unsigned* p, unsigned v) { return __hip_atomic_fetch_add(p, v, __ATOMIC_RELAXED, __HIP_MEMORY_SCOPE_AGENT); }
__device__ __forceinline__ unsigned xb_xcc_id() { return (unsigned)__builtin_amdgcn_s_getreg((3 << 11) | 20) & 0xFu; }
#define XB_SPIN(cond, bar) do { unsigned _sp = 0; while (cond) { __builtin_amdgcn_s_sleep(1); \
    if ((++_sp & 255u) == 0u) { if (xb_ld(&(bar)[XB_TMO])) break; if (_sp > XB_SPIN_CAP) { atomicAdd(&(bar)[XB_TMO], 1u); break; } } } } while (0)

struct XcdBarrier {
    unsigned* bar; unsigned x;
    volatile LAS unsigned* st;
};

__device__ __forceinline__ XcdBarrier xcd_barrier_post(unsigned* bar, volatile LAS unsigned* st) {
    XcdBarrier b; b.bar = bar; b.x = xb_xcc_id(); b.st = st;
    if (threadIdx.x == 0) (void)xb_add(&bar[XB_XCNT(b.x)], 1u);
    return b;
}
__device__ __forceinline__ void xcd_barrier_complete(unsigned* bar, unsigned x, unsigned& nloc, unsigned& nx) {
    const unsigned G = gridDim.x * gridDim.y * gridDim.z;
    unsigned sum, cnt, mine, sp = 0u;
    for (;;) {
        sum = 0u; cnt = 0u; mine = 0u;
#pragma unroll
        for (unsigned j = 0; j < 16; ++j) { const unsigned c = xb_ld(&bar[XB_XCNT(j)]); sum += c; cnt += (c > 0u) ? 1u : 0u; mine = (j == x) ? c : mine; }
        if (sum == G) break;
        __builtin_amdgcn_s_sleep(1);
        if ((++sp & 255u) == 0u) { if (xb_ld(&bar[XB_TMO])) break; if (sp > XB_SPIN_CAP) { atomicAdd(&bar[XB_TMO], 1u); break; } }
    }
    nloc = mine > 0u ? mine : 1u; nx = cnt > 0u ? cnt : 1u;
}

__device__ __forceinline__ void xcd_barrier(const XcdBarrier& b) {
    asm volatile("s_waitcnt vmcnt(0)" ::: "memory");
    __syncthreads();
    if (threadIdx.x == 0) {
        unsigned* bar = b.bar; asm volatile("" : "+s"(bar));
        const unsigned bx = xb_xcc_id();
        __builtin_amdgcn_s_waitcnt(0);
        unsigned nloc = b.st[0], nx = b.st[1];
        if (nloc == 0u) { xcd_barrier_complete(bar, bx, nloc, nx); b.st[0] = nloc; b.st[1] = nx; }
        const unsigned old = xb_add(&bar[XB_XSUB(bx)], 1u);
        const unsigned gen = old / nloc;
        if (old + 1u == (gen + 1u) * nloc) {
            __builtin_amdgcn_fence(__ATOMIC_RELEASE, "agent");
            asm volatile("s_waitcnt vmcnt(0)" ::: "memory");
            const unsigned og = xb_add(&bar[XB_TOP], 1u);
            const unsigned tg = og / nx;
            if (og + 1u == (tg + 1u) * nx) xb_add(&bar[XB_TOPGEN], 1u);
            else XB_SPIN(xb_ld(&bar[XB_TOPGEN]) == tg, bar);
            __builtin_amdgcn_fence(__ATOMIC_ACQUIRE, "agent");
            xb_add(&bar[XB_XGEN(bx)], 1u);
            asm volatile("s_waitcnt vmcnt(0)" ::: "memory");
        } else {
            XB_SPIN(xb_ld(&bar[XB_XGEN(bx)]) == gen, bar);
            __builtin_amdgcn_fence(__ATOMIC_ACQUIRE, "agent");
            asm volatile("s_waitcnt vmcnt(0)" ::: "memory");
        }
    }
    __syncthreads();
}


namespace pg8 {
#define PG8_LAS __attribute__((address_space(3)))
typedef unsigned short bf16_t;
typedef short bf16x8 __attribute__((ext_vector_type(8)));
typedef float f32x4 __attribute__((ext_vector_type(4)));
typedef unsigned u32x4 __attribute__((ext_vector_type(4)));
constexpr int BM = 256, BK = 64, HALF = 128, HTB = HALF * BK * 2  , STAGE_BYTES = 8 * HTB, NXCD = 8, WGM = 8;

__host__ __device__ __forceinline__ int lds_byte(int r, int c) { const int st = (r >> 4) * 2 + (c >> 5), rr = r & 15, cc = c & 31, ob = rr * 64 + cc * 2; return st * 1024 + (ob ^ (((ob >> 9) & 1) << 5)); }
__host__ __device__ __forceinline__ void stage_rc(int b, int& R, int& C) { const int st = b / 1024, sb = b % 1024, swz = sb ^ (((sb >> 9) & 1) << 5); R = (st >> 1) * 16 + swz / 64; C = (st & 1) * 32 + (swz % 64) / 2; }
__host__ __device__ __forceinline__ int perm32(int rho) { const int n = rho >> 4, i = rho & 15; return 8 * (i >> 2) + 4 * n + (i & 3); }

struct Unit { int pm, pn; };
struct Gemm { const bf16_t* A; const bf16_t* Bt; int M, N, K, lda, ldb; };

struct StaticOrder {
    int nM, nN, nwg, G, c;
    __host__ __device__ void init(int M, int N, int G_, int c_) { nM = M / BM; nN = N / BM; nwg = nM * nN; G = G_; c = c_; }
    __host__ __device__ bool next(int i, Unit& u) const {
        const long L = (long)i * G + c; if (L >= nwg) return false;
        int wgid = (int)L; { const int q = nwg / NXCD, r = nwg % NXCD, xcd = wgid % NXCD, off = wgid / NXCD; wgid = (xcd < r ? xcd * (q + 1) : r * (q + 1) + (xcd - r) * q) + off; }
        const int nig = WGM * nN, gid = wgid / nig, fm = gid * WGM, gsz = (nM - fm) < WGM ? (nM - fm) : WGM;
        u.pm = fm + ((wgid % nig) % gsz); u.pn = (wgid % nig) / gsz; return true;
    }
    __device__ __forceinline__ void a_ready(const Unit&) const {}
    __device__ __forceinline__ void done(const Unit&) const {}
};


template <class Epi, class Sched, bool ALIGN_EPI = false, bool SP2 = false>
__device__ __forceinline__ void gemm_phase(PG8_LAS unsigned char* lds, const Gemm g, const Sched& S, const Epi& E, int wid0) {
    const int tid = otid(wid0), wid = __builtin_amdgcn_readfirstlane(tid >> 6), lane = tid & 63, wr = wid >> 2, wc = wid & 3, fr = lane & 15, fq = lane >> 4;
    const int K = g.K, nt = K / BK;
    unsigned voffA[2], voffB[2];
#pragma unroll
    for (int i = 0; i < 2; ++i) { int R, C; stage_rc(tid * 16 + i * 8192, R, C); const int Rb = Epi::PERM ? ((R & ~31) + perm32(R & 31)) : R;
        voffA[i] = (unsigned)(R * g.lda + C) * 2u; voffB[i] = (unsigned)(Rb * g.ldb + C) * 2u; }
    const size_t kstep = (size_t)(BK * 2);
    const size_t hstepA = (size_t)HALF * g.lda * 2, hstepB = (size_t)HALF * g.ldb * 2;
    const size_t tstepA = 2 * hstepA, tstepB = 2 * hstepB;
    const unsigned ldsw = (unsigned)wid * 1024u;
    const int aoff = lds_byte(wr * 64 + fr, fq * 8), boff = lds_byte(wc * 32 + fr, fq * 8);
#define PG8_SA(b, h) (((b) * 2 + (h)) * HTB)
#define PG8_SB(b, h) ((4 + (b) * 2 + (h)) * HTB)
#define PG8_STAGE(bufoff, gbase, voff) do { _Pragma("unroll") for (int _i = 0; _i < 2; ++_i) \
        __builtin_amdgcn_global_load_lds((const unsigned*)((const char*)(gbase) + (voff)[_i]), (PG8_LAS unsigned*)(lds + (bufoff) + ldsw + _i * 8192), 16, 0, 0); } while (0)
#define PG8_LDA(dst, b, h) do { _Pragma("unroll") for (int m = 0; m < 4; ++m) _Pragma("unroll") for (int k = 0; k < 2; ++k) dst[m][k] = *(const PG8_LAS bf16x8*)(lds + PG8_SA(b, h) + aoff + m * 2048 + k * 1024); } while (0)
#define PG8_LDB(dst, b, h) do { _Pragma("unroll") for (int n = 0; n < 2; ++n) _Pragma("unroll") for (int k = 0; k < 2; ++k) dst[n][k] = *(const PG8_LAS bf16x8*)(lds + PG8_SB(b, h) + boff + n * 2048 + k * 1024); } while (0)
#define PG8_MMA(ai, bj, At, Bt) do { __builtin_amdgcn_s_setprio(1); _Pragma("unroll") for (int m = 0; m < 4; ++m) _Pragma("unroll") for (int n = 0; n < 2; ++n) _Pragma("unroll") for (int k = 0; k < 2; ++k) \
        acc[ai][bj][m][n] = __builtin_amdgcn_mfma_f32_16x16x32_bf16(Bt[n][k], At[m][k], acc[ai][bj][m][n], 0, 0, 0); __builtin_amdgcn_s_setprio(0); } while (0)
#define PG8_WAIT_V(n) asm volatile("s_waitcnt vmcnt(" #n ")" ::: "memory")
#define PG8_WAIT_L(n) asm volatile("s_waitcnt lgkmcnt(" #n ")" ::: "memory")
#define PG8_BAR __builtin_amdgcn_s_barrier()
#define PG8_SCHED __builtin_amdgcn_sched_barrier(0)
    Unit cur, nxt; int ui = 0;
    if (!S.next(0, cur)) return;
    f32x4 acc[2][2][4][2];
#pragma unroll
    for (int a = 0; a < 2; ++a)
#pragma unroll
        for (int b = 0; b < 2; ++b)
#pragma unroll
            for (int m = 0; m < 4; ++m)
#pragma unroll
                for (int n = 0; n < 2; ++n) acc[a][b][m][n] = (f32x4){0.f, 0.f, 0.f, 0.f};
    bf16x8 At[4][2], B0[2][2], B1[2][2];
    const char* cA = (const char*)g.A + (size_t)cur.pm * tstepA; const char* cB = (const char*)g.Bt + (size_t)cur.pn * tstepB;
    S.a_ready(cur);
    if constexpr (SP2) {
        PG8_STAGE(PG8_SB(0, 0), cB, voffB); PG8_STAGE(PG8_SB(0, 1), cB + hstepB, voffB); PG8_STAGE(PG8_SA(0, 0), cA, voffA); PG8_STAGE(PG8_SA(0, 1), cA + hstepA, voffA);
        if (wr == 1) PG8_BAR;
        PG8_WAIT_V(2); PG8_BAR;
        PG8_STAGE(PG8_SB(1, 0), cB + kstep, voffB); PG8_STAGE(PG8_SA(1, 0), cA + kstep, voffA); PG8_STAGE(PG8_SB(1, 1), cB + hstepB + kstep, voffB);
        PG8_WAIT_V(6); PG8_BAR;
    } else {
        PG8_STAGE(PG8_SB(0, 0), cB, voffB); PG8_STAGE(PG8_SA(0, 0), cA, voffA); PG8_STAGE(PG8_SB(0, 1), cB + hstepB, voffB); PG8_STAGE(PG8_SA(0, 1), cA + hstepA, voffA);
        if (wr == 1) PG8_BAR;
        PG8_WAIT_V(4); PG8_BAR;
        PG8_STAGE(PG8_SB(1, 0), cB + kstep, voffB); PG8_STAGE(PG8_SA(1, 0), cA + kstep, voffA); PG8_STAGE(PG8_SB(1, 1), cB + hstepB + kstep, voffB);
        PG8_WAIT_V(6); PG8_BAR;
    }
    for (;;) {
        const bool has_next = S.next(ui + 1, nxt);
        const char* nA = has_next ? (const char*)g.A + (size_t)nxt.pm * tstepA : cA; const char* nB = has_next ? (const char*)g.Bt + (size_t)nxt.pn * tstepB : cB;
        for (int t = 0; t < nt; t += 2) {
            const bool last = (t == nt - 2);
            const char* a1 = cA + (size_t)(t + 1) * kstep;
            const char* a2 = last ? nA : cA + (size_t)(t + 2) * kstep; const char* b2 = last ? nB : cB + (size_t)(t + 2) * kstep;
            const char* a3 = a2 + kstep; const char* b3 = b2 + kstep;
            if (last && has_next) S.a_ready(nxt);
            if constexpr (SP2) {
            PG8_LDB(B0, 0, 0); PG8_LDB(B1, 0, 1); PG8_SCHED; PG8_LDA(At, 0, 0); PG8_STAGE(PG8_SA(1, 1), a1 + hstepA, voffA);
            PG8_WAIT_V(8); PG8_WAIT_L(0); PG8_BAR; PG8_MMA(0, 0, At, B0); PG8_MMA(0, 1, At, B1); PG8_BAR; PG8_SCHED;
            PG8_LDA(At, 0, 1); PG8_STAGE(PG8_SB(0, 0), b2, voffB); PG8_STAGE(PG8_SB(0, 1), b2 + hstepB, voffB); PG8_STAGE(PG8_SA(0, 0), a2, voffA);
            PG8_WAIT_V(8); PG8_WAIT_L(0); PG8_BAR; PG8_MMA(1, 0, At, B0); PG8_MMA(1, 1, At, B1); PG8_BAR; PG8_SCHED;
            PG8_LDB(B0, 1, 0); PG8_LDB(B1, 1, 1); PG8_SCHED; PG8_LDA(At, 1, 0); PG8_STAGE(PG8_SA(0, 1), a2 + hstepA, voffA);
            PG8_WAIT_V(8); PG8_WAIT_L(0); PG8_BAR; PG8_MMA(0, 0, At, B0); PG8_MMA(0, 1, At, B1); PG8_BAR; PG8_SCHED;
            PG8_LDA(At, 1, 1); PG8_STAGE(PG8_SB(1, 0), b3, voffB); PG8_STAGE(PG8_SB(1, 1), b3 + hstepB, voffB); PG8_STAGE(PG8_SA(1, 0), a3, voffA);
            PG8_WAIT_V(8); PG8_WAIT_L(0); PG8_BAR; PG8_MMA(1, 0, At, B0); PG8_MMA(1, 1, At, B1); PG8_BAR; PG8_SCHED;
            } else {
            PG8_LDB(B0, 0, 0); PG8_SCHED; PG8_LDA(At, 0, 0); PG8_STAGE(PG8_SA(1, 1), a1 + hstepA, voffA);
            PG8_WAIT_L(8); PG8_BAR; PG8_WAIT_L(0); PG8_MMA(0, 0, At, B0); PG8_BAR; PG8_SCHED;
            PG8_LDB(B1, 0, 1); PG8_STAGE(PG8_SB(0, 0), b2, voffB);
            PG8_BAR; PG8_WAIT_L(0); PG8_MMA(0, 1, At, B1); PG8_BAR;
            PG8_LDA(At, 0, 1); PG8_STAGE(PG8_SA(0, 0), a2, voffA);
            PG8_BAR; PG8_WAIT_L(0); PG8_MMA(1, 0, At, B0); PG8_BAR; PG8_SCHED;
            PG8_STAGE(PG8_SB(0, 1), b2 + hstepB, voffB);
            PG8_WAIT_V(6); PG8_BAR; PG8_MMA(1, 1, At, B1); PG8_BAR;
            PG8_LDB(B0, 1, 0); PG8_SCHED; PG8_LDA(At, 1, 0); PG8_STAGE(PG8_SA(0, 1), a2 + hstepA, voffA);
            PG8_WAIT_L(8); PG8_BAR; PG8_WAIT_L(0); PG8_MMA(0, 0, At, B0); PG8_BAR; PG8_SCHED;
            PG8_LDB(B1, 1, 1); PG8_STAGE(PG8_SB(1, 0), b3, voffB);
            PG8_BAR; PG8_WAIT_L(0); PG8_MMA(0, 1, At, B1); PG8_BAR;
            PG8_LDA(At, 1, 1); PG8_STAGE(PG8_SA(1, 0), a3, voffA);
            PG8_BAR; PG8_WAIT_L(0); PG8_MMA(1, 0, At, B0); PG8_BAR; PG8_SCHED;
            PG8_STAGE(PG8_SB(1, 1), b3 + hstepB, voffB);
            PG8_WAIT_V(6); PG8_BAR; PG8_MMA(1, 1, At, B1); PG8_BAR;
            }
        }
        if constexpr (ALIGN_EPI) { if (wr == 0) PG8_BAR; }
        if constexpr (!Epi::AFTER_DRAIN) { E(acc, cur, wr, wc, fr, fq); S.done(cur); }
        if (!has_next) break;
#pragma unroll
        for (int a = 0; a < 2; ++a)
#pragma unroll
            for (int b = 0; b < 2; ++b)
#pragma unroll
                for (int m = 0; m < 4; ++m)
#pragma unroll
                    for (int n = 0; n < 2; ++n) acc[a][b][m][n] = (f32x4){0.f, 0.f, 0.f, 0.f};
        cur = nxt; cA = nA; cB = nB; ++ui;
        if constexpr (ALIGN_EPI) { if (wr == 1) PG8_BAR; }
    }
    PG8_WAIT_V(0);
    if constexpr (!ALIGN_EPI) { if (wr == 0) PG8_BAR; }
    PG8_BAR;
    if constexpr (Epi::AFTER_DRAIN) { E.fused(acc, cur, wr, wc, fr, fq, lds, wid, lane); S.done(cur); }
#undef PG8_SA
#undef PG8_SB
#undef PG8_STAGE
#undef PG8_LDA
#undef PG8_LDB
#undef PG8_MMA
#undef PG8_WAIT_V
#undef PG8_WAIT_L
#undef PG8_BAR
#undef PG8_SCHED
}
}

namespace pg8 {
struct EpiInProj {
    static constexpr bool PERM = true, AFTER_DRAIN = false;
    unsigned char* ws; const float* ss;
    __device__ __forceinline__ void operator()(const f32x4 (&acc)[2][2][4][2], const Unit& u, int wr, int wc, int fr, int fq) const {
        const int pn = u.pn;
        const int b = u.pm >> 4, t0 = (u.pm & 15) * 256 + wr * 64 + fr;
        size_t base0 = 0, base1 = 0; int mul = 64, H = 4; float sc = 1.f; int kind = 0;
        int W = 0, coff = 0;
        switch (pn) {
            case 0: base0 = base1 = WS_QA; sc = QSCALE; break;
            case 1: base0 = base1 = WS_KA; break;
            case 2: base0 = base1 = WS_VA; break;
            case 3: kind = 1; base0 = base1 = WS_ZA; W = 256; break;
            case 4: kind = 1; base0 = base1 = WS_QB; W = 512; sc = QSCALE; break;
            case 5: kind = 1; base0 = base1 = WS_QB; W = 512; coff = 256; sc = QSCALE; break;
            case 6: H = 2; base0 = WS_KC; base1 = WS_VC; break;
            case 7: H = 2; base0 = WS_KSL; base1 = WS_VSL; break;
            case 8: H = 2; base0 = WS_KWN; base1 = WS_VWN; break;
            case 9: kind = 1; base0 = base1 = WS_ZB; W = 512; break;
            case 10: kind = 1; base0 = base1 = WS_ZB; W = 512; coff = 256; break;
            case 11: base0 = base1 = WS_QC; sc = QSCALE; break;
            case 12: base0 = base1 = WS_KCF; break;
            case 13: base0 = base1 = WS_VCF; break;
            case 14: kind = 1; base0 = base1 = WS_ZC; W = 256; break;
            default: kind = 2; break;
        }
        const int chl = 32 * wc + 8 * fq;
        if (kind == 2) {
            if (wc == 0) {
                float* gf = (float*)(ws + WS_GF) + (size_t)(b * SEQ + t0) * 32 + chl;
#pragma unroll
                for (int ai = 0; ai < 2; ++ai)
#pragma unroll
                    for (int m = 0; m < 4; ++m) {
                        const int tl = ai * HALF + m * 16;
                        const float r = rsqrtf(ss[b * SEQ + t0 + tl] * (1.f / DM) + 1e-6f);
                        *(f32x4*)(gf + (size_t)tl * 32) = acc[ai][0][m][0] * r;
                        *(f32x4*)(gf + (size_t)tl * 32 + 4) = acc[ai][0][m][1] * r;
                    }
            }
            return;
        }
        unsigned cst0, cst1;
        if (kind == 0) {
            mul = 64;
            if (H == 4) { cst0 = (unsigned)(((b * 4 + (chl >> 6)) * SEQ) * 64 + (chl & 63)); cst1 = (unsigned)(((b * 4 + 2 + (chl >> 6)) * SEQ) * 64 + (chl & 63)); }
            else { cst0 = cst1 = (unsigned)(((b * 2 + (chl >> 6)) * SEQ) * 64 + (chl & 63)); }
        } else {
            mul = W;
            cst0 = (unsigned)(b * SEQ) * (unsigned)W + coff + chl; cst1 = cst0 + 128;
        }
        bf16_t* d0 = (bf16_t*)(ws + base0) + cst0 + (size_t)t0 * mul;
        bf16_t* d1 = (bf16_t*)(ws + base1) + cst1 + (size_t)t0 * mul;
#pragma unroll
        for (int ai = 0; ai < 2; ++ai)
#pragma unroll
            for (int m = 0; m < 4; ++m) {
                const int tl = ai * HALF + m * 16;
                const float r = rsqrtf(ss[b * SEQ + t0 + tl] * (1.f / DM) + 1e-6f) * sc;
#pragma unroll
                for (int bj = 0; bj < 2; ++bj) {
                    const f32x4 v0 = acc[ai][bj][m][0] * r, v1 = acc[ai][bj][m][1] * r;
                    u32x4 w; w.x = pk2(v0[0], v0[1]); w.y = pk2(v0[2], v0[3]); w.z = pk2(v1[0], v1[1]); w.w = pk2(v1[2], v1[3]);
                    *(u32x4*)((bj ? d1 : d0) + (size_t)tl * mul) = w;
                }
            }
    }
};
template <bool NEXT> struct EpiOutProj {
    static constexpr bool PERM = false, AFTER_DRAIN = false;
    const float* xin; float* xout; bf16_t* xb; float* ss;
    __device__ __forceinline__ void operator()(const f32x4 (&acc)[2][2][4][2], const Unit& u, int wr, int wc, int fr, int fq) const {
        const int col0 = u.pn * BM + wc * 32 + 4 * fq;
#pragma unroll
        for (int ai = 0; ai < 2; ++ai)
#pragma unroll
            for (int m = 0; m < 4; ++m) {
                const int row = u.pm * BM + ai * HALF + wr * 64 + m * 16 + fr;
                const size_t roff = (size_t)row * DM + col0;
                float sq = 0.f;
#pragma unroll
                for (int bj = 0; bj < 2; ++bj)
#pragma unroll
                    for (int n = 0; n < 2; ++n) {
                        const f32x4 r = *(const f32x4*)(xin + roff + bj * HALF + n * 16);
                        const f32x4 v = r + acc[ai][bj][m][n];
                        *(f32x4*)(xout + roff + bj * HALF + n * 16) = v;
                        if (NEXT) {
                            typedef unsigned u32x2_t __attribute__((ext_vector_type(2)));
                            u32x2_t w; w.x = pk2(v[0], v[1]); w.y = pk2(v[2], v[3]);
                            *(u32x2_t*)(xb + roff + bj * HALF + n * 16) = w;
                            sq += (v[0] * v[0] + v[1] * v[1]) + (v[2] * v[2] + v[3] * v[3]);
                        }
                    }
                if (NEXT) {
                    const int ln = olane();
                    sq += __int_as_float(__builtin_amdgcn_ds_bpermute((ln ^ 16) << 2, __float_as_int(sq)));
                    sq += __int_as_float(__builtin_amdgcn_ds_bpermute((ln ^ 32) << 2, __float_as_int(sq)));
                    if (fq == 0) atomicAdd(ss + row, sq);
                }
            }
    }
};
}

__device__ __forceinline__ int in_src_col(int n) {
    if (n < 2304) return n;
    if (n < 3584) return n + 24;
    if (n < 3840) return n + 28;
    if (n < 3864) return C_GB + (n - 3840);
    if (n < 3868) return C_FC + (n - 3864);
    return -1;
}
template <bool INMAP> __device__ __forceinline__ void transpose_item(const float* W, int ldsrc, int K, const float* scale, bf16_t* WT, int nblk, int item, float* scr, int lane) {
    const int kb = item / nblk, nb = item % nblk, k0 = 64 * kb, n0 = 32 * nb;
    const int n = n0 + (lane & 31);
    const int col = INMAP ? in_src_col(n) : n;
    float vv[32];
#pragma unroll
    for (int i = 0; i < 32; ++i) { const int kk = 2 * i + (lane >> 5); vv[i] = col >= 0 ? W[(size_t)(k0 + kk) * ldsrc + col] : 0.f; }
    if (scale) {
#pragma unroll
        for (int i = 0; i < 32; ++i) vv[i] *= scale[k0 + 2 * i + (lane >> 5)];
    }
#pragma unroll
    for (int i = 0; i < 32; ++i) scr[(2 * i + (lane >> 5)) * 33 + (lane & 31)] = vv[i];
    asm volatile("s_waitcnt lgkmcnt(0)" ::: "memory");
    const int c8 = lane & 7;
#pragma unroll
    for (int j = 0; j < 4; ++j) {
        const int nn = (lane >> 3) + 8 * j;
        const float* s = scr + (8 * c8) * 33 + nn;
        uint4 o; o.x = pk2(s[0 * 33], s[1 * 33]); o.y = pk2(s[2 * 33], s[3 * 33]); o.z = pk2(s[4 * 33], s[5 * 33]); o.w = pk2(s[6 * 33], s[7 * 33]);
        *(uint4*)(WT + (size_t)(n0 + nn) * K + k0 + 8 * c8) = o;
    }
    asm volatile("s_waitcnt lgkmcnt(0)" ::: "memory");
}
__device__ void p0_weights(const Params& p, unsigned char* ldsg, int wid0) {
    const int tid_ = otid(wid0); const int lane = tid_ & 63, wv = tid_ >> 6;
    float* scr = (float*)ldsg + wv * (64 * 33);
    const int gw = blockIdx.x * NWAVES + wv, ngw = gridDim.x * NWAVES;
    constexpr int I_IN = (DM / 64) * (NPAD / 32), I_OUT = (DM / 64) * (DM / 32), I_W1 = (2048 / 64) * (256 / 32), I_W2 = (256 / 64) * (64 / 32);
    constexpr int TOTAL = 2 * I_IN + 2 * I_OUT + 4 * I_W1 + 4 * I_W2;
    for (int it = gw; it < TOTAL; it += ngw) {
        int r = it;
        if (r < 2 * I_IN) { const int l = r / I_IN; r %= I_IN;
            transpose_item<true>(p.w_in + (size_t)l * DM * INW, INW, DM, p.norm_g + l * DM, (bf16_t*)(p.ws + WS_WTIN) + (size_t)l * NPAD * DM, NPAD / 32, r, scr, lane); continue; }
        r -= 2 * I_IN;
        if (r < 2 * I_OUT) { const int l = r / I_OUT; r %= I_OUT;
            transpose_item<false>(p.w_out + (size_t)l * DM * DM, DM, DM, nullptr, (bf16_t*)(p.ws + WS_WTOUT) + (size_t)l * DM * DM, DM / 32, r, scr, lane); continue; }
        r -= 2 * I_OUT;
        if (r < 4 * I_W1) { const int lw = r / I_W1; r %= I_W1;
            transpose_item<false>(p.cmp_w1 + (size_t)lw * 2048 * 256, 256, 2048, nullptr, (bf16_t*)(p.ws + WS_W1T) + (size_t)lw * 256 * 2048, 256 / 32, r, scr, lane); continue; }
        r -= 4 * I_W1;
        { const int lw = r / I_W2; r %= I_W2;
            transpose_item<false>(p.cmp_w2 + (size_t)lw * 256 * 64, 64, 256, nullptr, (bf16_t*)(p.ws + WS_W2T) + (size_t)lw * 64 * 256, 64 / 32, r, scr, lane); }
    }
    for (int it = gw; it < 4 * 64; it += ngw) {
        const int lw = it >> 6, i0 = (it & 63) * 32;
        const float* w1 = p.cmp_w1 + (size_t)lw * 2048 * 256; const float* pe = p.cmp_pe + (size_t)lw * 2048;
        float a0 = 0.f, a1 = 0.f, a2 = 0.f, a3 = 0.f;
#pragma unroll 4
        for (int i = i0; i < i0 + 32; ++i) {
            const float pv = pe[i]; const float* wr_ = w1 + (size_t)i * 256 + lane;
            a0 += pv * wr_[0]; a1 += pv * wr_[64]; a2 += pv * wr_[128]; a3 += pv * wr_[192];
        }
        float* bo = (float*)(p.ws + WS_BIAS1) + lw * 256 + lane;
        atomicAdd(bo, a0); atomicAdd(bo + 64, a1); atomicAdd(bo + 128, a2); atomicAdd(bo + 192, a3);
    }
}
__device__ void phase_convert_x(const float* xin, bf16_t* xb, float* ss, int wid0) {
    xin = opq(xin); xb = opq(xb); ss = opq(ss);
    const int tid_ = otid(wid0); const int lane = tid_ & 63, wv = tid_ >> 6;
    const int gw = blockIdx.x * NWAVES + wv, ngw = gridDim.x * NWAVES;
    for (int r0 = gw * 4; r0 < MTOK; r0 += ngw * 4) {
        float4 v[4][4];
#pragma unroll
        for (int q = 0; q < 4; ++q)
#pragma unroll
            for (int j = 0; j < 4; ++j) v[q][j] = ((const float4*)(xin + (size_t)(r0 + q) * DM))[lane + 64 * j];
#pragma unroll
        for (int q = 0; q < 4; ++q) {
            float s = 0.f;
#pragma unroll
            for (int j = 0; j < 4; ++j) {
                const float4 t = v[q][j];
                s += t.x * t.x + t.y * t.y + t.z * t.z + t.w * t.w;
                uint2 w; w.x = pk2(t.x, t.y); w.y = pk2(t.z, t.w);
                *(uint2*)(xb + (size_t)(r0 + q) * DM + 4 * (lane + 64 * j)) = w;
            }
            s = wave_sum(s);
            if (lane == 0) ss[r0 + q] = s;
        }
    }
}
__device__ void phase_final_norm(float* x, const float* g, int wid0) {
    x = opq(x); g = opq(g);
    const int tid_ = otid(wid0); const int lane = tid_ & 63, wv = tid_ >> 6;
    const int gw = blockIdx.x * NWAVES + wv, ngw = gridDim.x * NWAVES;
    float4 gg[4];
#pragma unroll
    for (int j = 0; j < 4; ++j) gg[j] = ((const float4*)g)[lane + 64 * j];
    for (int r0 = gw * 2; r0 < MTOK; r0 += ngw * 2) {
        float4 v[2][4];
#pragma unroll
        for (int q = 0; q < 2; ++q)
#pragma unroll
            for (int j = 0; j < 4; ++j) v[q][j] = ((const float4*)(x + (size_t)(r0 + q) * DM))[lane + 64 * j];
#pragma unroll
        for (int q = 0; q < 2; ++q) {
            float s = 0.f;
#pragma unroll
            for (int j = 0; j < 4; ++j) s += v[q][j].x * v[q][j].x + v[q][j].y * v[q][j].y + v[q][j].z * v[q][j].z + v[q][j].w * v[q][j].w;
            s = wave_sum(s);
            const float rs = rsqrtf(s * (1.f / DM) + 1e-6f);
#pragma unroll
            for (int j = 0; j < 4; ++j) {
                float4 o;
                o.x = v[q][j].x * rs * gg[j].x; o.y = v[q][j].y * rs * gg[j].y; o.z = v[q][j].z * rs * gg[j].z; o.w = v[q][j].w * rs * gg[j].w;
                ((float4*)(x + (size_t)(r0 + q) * DM))[lane + 64 * j] = o;
            }
        }
    }
}

namespace att {
#define LAS3 __attribute__((address_space(3)))
typedef short bf16x8 __attribute__((ext_vector_type(8)));
typedef float f32x16 __attribute__((ext_vector_type(16)));
typedef float f32x4 __attribute__((ext_vector_type(4)));
typedef short v4i16_t __attribute__((ext_vector_type(4)));
typedef float f32x2_t __attribute__((ext_vector_type(2)));
typedef __bf16 bf16x2_t __attribute__((ext_vector_type(2)));
constexpr int L_KV = 0;
constexpr int L_WSF = 67584;
constexpr int L_BTAB = 69632;
constexpr int L_IMP = 40960;
constexpr int L_SELM = 57344;
constexpr float NEG_INF = -INFINITY;

__device__ __forceinline__ unsigned cvtpk(float lo, float hi) { f32x2_t v = {lo, hi}; bf16x2_t b = __builtin_convertvector(v, bf16x2_t); return __builtin_bit_cast(unsigned, b); }
__device__ __forceinline__ int crow(int r, int hi) { return (r & 3) + 8 * (r >> 2) + 4 * hi; }

struct Ctx {
    int tid, lane, r32, hi, wid;
    unsigned kofs[4];
    unsigned vofs0;
    unsigned stK, stV;
};
__device__ __forceinline__ Ctx make_ctx(int wid0) {
    Ctx c; c.tid = otid(wid0); c.lane = c.tid & 63; c.r32 = c.lane & 31; c.hi = c.lane >> 5; c.wid = __builtin_amdgcn_readfirstlane(c.tid >> 6);
#pragma unroll
    for (int d0 = 0; d0 < 4; ++d0) c.kofs[d0] = (unsigned)(c.r32 * 128 + (((2 * d0 + c.hi) ^ ((c.r32 >> 1) & 7)) << 4));
    const int q = (c.lane & 15) >> 2, p = c.lane & 3, g = (c.lane >> 4) & 1;
    c.vofs0 = (unsigned)((4 * c.hi + q) * 128 + (((2 * g + (p >> 1)) ^ ((q >> 1) << 2)) << 4) + 8 * (p & 1));
    const int kv = c.tid >> 3, ch = c.tid & 7;
    c.stK = (unsigned)(kv * 128 + ((ch ^ (kv & 7)) << 4));
    c.stV = (unsigned)(kv * 128 + ((ch ^ (((kv >> 1) & 1) << 2)) << 4));
    return c;
}
__device__ __forceinline__ void qk_tile(f32x16& p0, f32x16& p1, const LAS3 unsigned char* kb, const Ctx& c, const bf16x8 (&qf)[4]) {
    bf16x8 a0[4], a1[4];
#pragma unroll
    for (int d0 = 0; d0 < 4; ++d0) { a0[d0] = *(const LAS3 bf16x8*)(kb + c.kofs[d0]); a1[d0] = *(const LAS3 bf16x8*)(kb + 4096 + c.kofs[d0]); }
    __builtin_amdgcn_s_setprio(1);
#pragma unroll
    for (int d0 = 0; d0 < 4; ++d0) {
        p0 = __builtin_amdgcn_mfma_f32_32x32x16_bf16(a0[d0], qf[d0], p0, 0, 0, 0);
        p1 = __builtin_amdgcn_mfma_f32_32x32x16_bf16(a1[d0], qf[d0], p1, 0, 0, 0);
    }
    __builtin_amdgcn_s_setprio(0);
}
__device__ __forceinline__ bf16x8 pack8(const f32x16& p, int b) {
    typedef unsigned u32x4p_t __attribute__((ext_vector_type(4)));
    u32x4p_t w; w.x = cvtpk(p[b], p[b + 1]); w.y = cvtpk(p[b + 2], p[b + 3]); w.z = cvtpk(p[b + 4], p[b + 5]); w.w = cvtpk(p[b + 6], p[b + 7]);
    return __builtin_bit_cast(bf16x8, w);
}
__device__ __forceinline__ void pack_p(bf16x8 (&pa)[4], const f32x16& p0, const f32x16& p1) { pa[0] = pack8(p0, 0); pa[1] = pack8(p0, 8); pa[2] = pack8(p1, 0); pa[3] = pack8(p1, 8); }
__device__ __forceinline__ void pv_tile(f32x16 (&o)[2], const LAS3 unsigned char* vb, const Ctx& c, const bf16x8 (&pa)[4]) {
#pragma unroll
    for (int dblk = 0; dblk < 2; ++dblk) {
        const LAS3 unsigned char* vp = vb + (c.vofs0 ^ (unsigned)(dblk * 64));
        bf16x8 bfr[4];
#pragma unroll
        for (int s = 0; s < 4; ++s) {
            const v4i16_t lo = __builtin_amdgcn_ds_read_tr16_b64_v4i16((LAS3 v4i16_t*)(vp + s * 2048));
            const v4i16_t hi = __builtin_amdgcn_ds_read_tr16_b64_v4i16((LAS3 v4i16_t*)(vp + s * 2048 + 1024));
            bfr[s] = (bf16x8){lo[0], lo[1], lo[2], lo[3], hi[0], hi[1], hi[2], hi[3]};
        }
        __builtin_amdgcn_s_setprio(1);
#pragma unroll
        for (int s = 0; s < 4; ++s) o[dblk] = __builtin_amdgcn_mfma_f32_32x32x16_bf16(pa[s], bfr[s], o[dblk], 0, 0, 0);
        __builtin_amdgcn_s_setprio(0);
    }
}
__device__ __forceinline__ void rows_to_o(float (&out)[16], float v, LAS3 float* wsf, const Ctx& c) {
    if (c.hi == 0) wsf[c.r32] = v;
    asm volatile("" ::: "memory");
#pragma unroll
    for (int i = 0; i < 4; ++i) {
        const f32x4 t = *(const LAS3 f32x4*)(wsf + 8 * i + 4 * c.hi);
        out[4 * i] = t[0]; out[4 * i + 1] = t[1]; out[4 * i + 2] = t[2]; out[4 * i + 3] = t[3];
    }
    asm volatile("" ::: "memory");
}
constexpr float SM_THR = 8.f;
constexpr float FOX_SKIP = 48.f;
__device__ __forceinline__ float max3f(float x, float y, float z) { float r; asm("v_max3_f32 %0, %1, %2, %3" : "=v"(r) : "v"(x), "v"(y), "v"(z)); return r; }
__device__ __forceinline__ float max2f(float x, float y) { float r; asm("v_max_f32_e32 %0, %1, %2" : "=v"(r) : "v"(x), "v"(y)); return r; }
__device__ __forceinline__ float fadd_s(float x, float y) { float r; asm("v_add_f32_e32 %0, %1, %2" : "=v"(r) : "v"(x), "v"(y)); return r; }
__device__ __forceinline__ void softmax_step(f32x16& p0, f32x16& p1, float& mref, bool& started, float& l, f32x16 (&o)[2], LAS3 float* wsf, const Ctx& c) {
    asm volatile("s_nop 15\n\ts_nop 7" : "+v"(p0), "+v"(p1));
    float ma = max3f(p0[0], p0[1], p1[0]), mb = max3f(p0[2], p0[3], p1[1]);
    ma = max3f(ma, p1[2], p1[3]);
#pragma unroll
    for (int r = 4; r < 16; r += 4) { ma = max3f(ma, p0[r], p0[r + 1]); mb = max3f(mb, p0[r + 2], p0[r + 3]); ma = max3f(ma, p1[r], p1[r + 1]); mb = max3f(mb, p1[r + 2], p1[r + 3]); }
    float mx = pair_max(max2f(ma, mb));
    const bool fin = mx > NEG_INF;
    const bool rc = fin && (!started || mx > SM_THR);
    if (__any(rc)) {
        const float delta = rc ? mx : 0.f;
        const float alpha = (rc && started) ? __builtin_amdgcn_exp2f(-delta) : 1.f;
        mref += delta;
        l *= alpha;
        float a16[16];
        rows_to_o(a16, alpha, wsf, c);
#pragma unroll
        for (int r = 0; r < 16; ++r) { o[0][r] *= a16[r]; o[1][r] *= a16[r]; p0[r] -= delta; p1[r] -= delta; }
    }
    started = started || fin;
    float s = 0.f;
#pragma unroll
    for (int r = 0; r < 16; ++r) { p0[r] = __builtin_amdgcn_exp2f(p0[r]); p1[r] = __builtin_amdgcn_exp2f(p1[r]); }
#pragma unroll
    for (int r = 0; r < 16; ++r) { s += p0[r]; s += p1[r]; }
    l += s;
}
typedef unsigned u32x4_t __attribute__((ext_vector_type(4)));
constexpr int L_KR = 0, L_VR = 32768, L_AUXR = 65536, L_FLAG = 65536 + 1024, L_UNIT = 65536 + 1056, L_TACC = 157184 + 16;
#define ATT_WAITBAR0() asm volatile("s_waitcnt vmcnt(0) lgkmcnt(0)\n\ts_barrier" ::: "memory")
#define ATT_WAITBAR(N) asm volatile("s_waitcnt vmcnt(" #N ") lgkmcnt(0)\n\ts_barrier" ::: "memory")
__device__ __forceinline__ void dma16(const void* g, LAS3 unsigned char* ldst) {
    const unsigned la = (unsigned)__builtin_amdgcn_readfirstlane((int)(unsigned)(size_t)ldst);
    unsigned keep;
    asm volatile("s_mov_b32 %0, m0\n\ts_mov_b32 m0, %2\n\ts_nop 0\n\tglobal_load_lds_dwordx4 %1, off\n\ts_mov_b32 m0, %0" : "=&s"(keep) : "v"(g), "s"(la) : "memory");
}
__device__ __forceinline__ void dma4(const void* g, LAS3 unsigned char* ldst) {
    const unsigned la = (unsigned)__builtin_amdgcn_readfirstlane((int)(unsigned)(size_t)ldst);
    unsigned keep;
    asm volatile("s_mov_b32 %0, m0\n\ts_mov_b32 m0, %2\n\ts_nop 0\n\tglobal_load_lds_dword %1, off\n\ts_mov_b32 m0, %0" : "=&s"(keep) : "v"(g), "s"(la) : "memory");
}
template <bool AUX, bool HASV, class TileOf>
__device__ __forceinline__ void pipe_prefetch(LAS3 unsigned char* L, const Ctx& c, const bf16_t* K, const bf16_t* V, const float* aux, int count, TileOf tile_of) {
    const int row = c.tid >> 3, chs = c.tid & 7;
    const unsigned gk = (unsigned)(row * 128 + ((chs ^ ((row >> 1) & 7)) << 4));
    const unsigned gv = (unsigned)(row * 128 + ((chs ^ (((row >> 1) & 1) << 2)) << 4));
    const unsigned wl = (unsigned)c.wid * 1024u;
    for (int i = 0; i < 3 && i < count; ++i) {
        const int j = tile_of(i);
        dma16((const unsigned char*)(K + (size_t)j * 4096) + gk, L + L_KR + i * 8192 + wl);
        if (AUX) dma4((const unsigned char*)(aux + j * 64) + c.lane * 4, L + L_AUXR + i * 256);
        if (HASV && i < 2) dma16((const unsigned char*)(V + (size_t)j * 4096) + gv, L + L_VR + i * 8192 + wl);
    }
}
template <bool EXIT, bool AUX, bool HASV, bool PRE, class TileOf, class Need, class Init, class ProcA, class PV, class Adj, class Done>
__device__ __forceinline__ void tile_pipeline(LAS3 unsigned char* L, const Ctx& c, const bf16x8 (&qf)[4], const bf16_t* K, const bf16_t* V, const float* aux,
                                              int count, TileOf tile_of, Need need, Init init, ProcA procA, PV pvf, Adj adj, Done done) {
    TBEG(1, L, c.wid);
    const int row = c.tid >> 3, chs = c.tid & 7;
    const unsigned gk = (unsigned)(row * 128 + ((chs ^ ((row >> 1) & 7)) << 4));
    const unsigned gv = (unsigned)(row * 128 + ((chs ^ (((row >> 1) & 1) << 2)) << 4));
    const unsigned wl = (unsigned)c.wid * 1024u;
    auto issue_k = [&](int i) { const int j = tile_of(i); const int s = i & 3;
        dma16((const unsigned char*)(K + (size_t)j * 4096) + gk, L + L_KR + s * 8192 + wl);
        if (AUX) dma4((const unsigned char*)(aux + j * 64) + c.lane * 4, L + L_AUXR + s * 256); };
    auto issue_v = [&](int i) { if (HASV) { const int j = tile_of(i); const int s = i & 3; dma16((const unsigned char*)(V + (size_t)j * 4096) + gv, L + L_VR + s * 8192 + wl); } };
    const bool ph1 = c.wid >= 4;
    if (!PRE) { issue_k(0); issue_v(0); if (count > 1) { issue_k(1); issue_v(1); } if (count > 2) issue_k(2); }
    if (EXIT && c.tid < 3) *(LAS3 unsigned*)(L + L_FLAG + c.tid * 4) = 0u;
    ATT_WAITBAR0();
    TBEG(2, L, c.wid);
    auto end_step = [&](int i) -> bool {
        if (EXIT) { if (!done() && c.lane == 0) *(LAS3 unsigned*)(L + L_FLAG + (i % 3) * 4) = 1u; }
        if (i + 3 < count && (!HASV || i + 2 < count)) { if (AUX) ATT_WAITBAR(3); else if (HASV) ATT_WAITBAR(2); else ATT_WAITBAR(1); } else ATT_WAITBAR0();
        if (EXIT) {
            const unsigned f = *(LAS3 unsigned*)(L + L_FLAG + (i % 3) * 4);
            if (c.tid == 0) *(LAS3 unsigned*)(L + L_FLAG + ((i + 2) % 3) * 4) = 0u;
            if (f == 0u) return false;
        }
        return true;
    };
    if (!ph1) {
        f32x16 a0, a1, b0, b1; bool haveA = false, haveB = false;
        { const int j0 = tile_of(0); if (need(j0)) { init(j0, a0, a1, 0); qk_tile(a0, a1, L + L_KR, c, qf); haveA = true; } }
        auto step0 = [&](int i, f32x16& c0, f32x16& c1, bool& haveC, f32x16& n0, f32x16& n1, bool& haveN) -> bool {
            if (i + 3 < count) issue_k(i + 3);
            if (i + 2 < count) issue_v(i + 2);
            haveN = false;
            if (i + 1 < count) { const int j1 = tile_of(i + 1); if (need(j1)) { const int sl = (i + 1) & 3; init(j1, n0, n1, sl); qk_tile(n0, n1, L + L_KR + sl * 8192, c, qf); haveN = true; } }
            if (i < count && haveC) {
                const int j = tile_of(i);
                procA(j, c0, c1);
                if (haveN) adj(n0, n1);
                if (HASV) { bf16x8 pq[4]; pack_p(pq, c0, c1); pvf(pq, L + L_VR + (i & 3) * 8192); }
            }
            haveC = false;
            return end_step(i);
        };
        const int nsteps = count + (HASV ? 1 : 0);
        for (int i = 0; i < nsteps; i += 2) {
            if (!step0(i, a0, a1, haveA, b0, b1, haveB)) break;
            if (i + 1 >= nsteps) break;
            if (!step0(i + 1, b0, b1, haveB, a0, a1, haveA)) break;
        }
    } else {
        bf16x8 pa[4]; bool have = false; int i = 0;
        const int nsteps = count + (HASV ? 1 : 0);
        for (; i < nsteps; ++i) {
            if (i + 3 < count) issue_k(i + 3);
            if (i + 2 < count) issue_v(i + 2);
            f32x16 s0, s1; bool nj = false; int j = 0;
            if (i < count) { j = tile_of(i); nj = need(j); if (nj) { const int sl = i & 3; init(j, s0, s1, sl); qk_tile(s0, s1, L + L_KR + sl * 8192, c, qf); } }
            if (HASV && have) pvf(pa, L + L_VR + ((i + 3) & 3) * 8192);
            have = false;
            if (nj) { procA(j, s0, s1); if (HASV) pack_p(pa, s0, s1); have = true; }
            if (!end_step(i)) break;
        }
        if (EXIT && HASV && have && i < count) pvf(pa, L + L_VR + (i & 3) * 8192);
    }
    if (EXIT) ATT_WAITBAR0();
    TEND(1, L, c.wid); TEND(2, L, c.wid);
}

constexpr int L_OSTG = 71680;
__device__ __forceinline__ void store_gated(LAS3 unsigned char* L, const Ctx& c, const f32x16 (&o)[2], const float (&f16)[16], const bf16_t* Zrow0, int zpitch, bf16_t* Crow0) {
    LAS3 float* st = (LAS3 float*)(L + L_OSTG) + c.wid * 2048;
#pragma unroll
    for (int r = 0; r < 16; ++r) { st[crow(r, c.hi) * 64 + c.r32] = o[0][r] * f16[r]; st[crow(r, c.hi) * 64 + 32 + c.r32] = o[1][r] * f16[r]; }
    asm volatile("" ::: "memory");
    const int ch = c.lane & 7;
#pragma unroll
    for (int it = 0; it < 4; ++it) {
        const int row = it * 8 + (c.lane >> 3);
        const f32x4 o0 = *(const LAS3 f32x4*)(st + row * 64 + ch * 8), o1 = *(const LAS3 f32x4*)(st + row * 64 + ch * 8 + 4);
        const u32x4_t zz = *(const u32x4_t*)(Zrow0 + (size_t)row * zpitch + ch * 8);
        float rr[8];
#pragma unroll
        for (int e = 0; e < 8; ++e) {
            const float z = __uint_as_float((e & 1) ? (zz[e >> 1] & 0xffff0000u) : (zz[e >> 1] << 16));
            const float ov = e < 4 ? o0[e] : o1[e - 4];
            rr[e] = ov * (z / (1.f + __expf(-z)));
        }
        u32x4_t w; w.x = cvtpk(rr[0], rr[1]); w.y = cvtpk(rr[2], rr[3]); w.z = cvtpk(rr[4], rr[5]); w.w = cvtpk(rr[6], rr[7]);
        *(u32x4_t*)(Crow0 + (size_t)row * DM + ch * 8) = w;
    }
}

__device__ void fox_unit(unsigned char* ws, unsigned char* ldsg, int b, int h, int qb, int wid0) {
    ws = opq(ws); ldsg = opq(ldsg);
    const Ctx c = make_ctx(wid0);
    LAS3 unsigned char* L = (LAS3 unsigned char*)ldsg;
    LAS3 float* wsf = (LAS3 float*)(L + L_WSF) + c.wid * 64;
    const int t0 = qb * 256;
    const int tw0 = t0 + c.wid * 32;
    const int t = tw0 + c.r32;
    const size_t hb = ((size_t)(b * 4 + h) * SEQ);
    const bf16_t* Q = (const bf16_t*)(ws + WS_QC) + (hb + t) * 64;
    const bf16_t* K = (const bf16_t*)(ws + WS_KCF) + hb * 64;
    const bf16_t* V = (const bf16_t*)(ws + WS_VCF) + hb * 64;
    const float* cf = (const float*)(ws + WS_CFOX) + hb;
    bf16x8 qf[4];
#pragma unroll
    for (int d0 = 0; d0 < 4; ++d0) qf[d0] = *(const bf16x8*)(Q + 16 * d0 + 8 * c.hi);
    const float cref = cf[t0 + 255];
    const float kmax = ((const float*)(ws + WS_KMAX))[b * 4 + h];
    float qn;
    {
        float s2 = 0.f;
#pragma unroll
        for (int d0 = 0; d0 < 4; ++d0)
#pragma unroll
            for (int e = 0; e < 8; ++e) { const float x = bf2f((bf16_t)qf[d0][e]); s2 += x * x; }
        qn = sqrtf(pair_sum(s2)) * kmax;
    }
    int jlast = (t0 + 256) / 64;
    const float L2E = 1.4426950408889634f;
    float mref = 0.f, mref_init = 0.f, l = 0.f; bool started = false;
    f32x16 o[2]; o[0] = f32x16{}; o[1] = f32x16{};
    const int NT = (t0 + 256) / 64;
    const float cadd = cref * L2E;
    tile_pipeline<true, true, true, false>(L, c, qf, K, V, cf, NT,
        [&](int i) { return NT - 1 - i; },
        [&](int j) { return j * 64 <= tw0 + 31; },
        [&](int j, f32x16& p0, f32x16& p1, int abuf) {
            mref_init = mref;
            const LAS3 float* ax = (const LAS3 float*)(L + L_AUXR + abuf * 256);
#pragma unroll
            for (int i4 = 0; i4 < 4; ++i4) {
                const f32x4 a = *(const LAS3 f32x4*)(ax + 8 * i4 + 4 * c.hi);
                const f32x4 bq = *(const LAS3 f32x4*)(ax + 32 + 8 * i4 + 4 * c.hi);
#pragma unroll
                for (int e = 0; e < 4; ++e) { p0[4 * i4 + e] = __builtin_fmaf(a[e], -L2E, cadd - mref); p1[4 * i4 + e] = __builtin_fmaf(bq[e], -L2E, cadd - mref); }
            }
        },
        [&](int j, f32x16& p0, f32x16& p1) {
            jlast = j;
            if (j * 64 + 63 > tw0) {
                const int kv0 = j * 64 + 4 * c.hi;
#pragma unroll
                for (int r = 0; r < 16; ++r) {
                    const int kv = kv0 + (r & 3) + 8 * (r >> 2);
                    if (kv > t) p0[r] = NEG_INF;
                    if (kv + 32 > t) p1[r] = NEG_INF;
                }
            }
            softmax_step(p0, p1, mref, started, l, o, wsf, c);
        },
        [&](const bf16x8 (&pa)[4], const LAS3 unsigned char* vb) { pv_tile(o, vb, c, pa); },
        [&](f32x16& n0, f32x16& n1) { const float d = mref - mref_init; if (__any(d != 0.f)) {
#pragma unroll
            for (int r = 0; r < 16; ++r) { n0[r] -= d; n1[r] -= d; } } },
        [&]() {
            if (jlast == 0) return true;
            const int slot = (NT - jlast) & 3;
            const float cedge = ((const LAS3 float*)(L + L_AUXR + slot * 256))[63];
            const bool gone = started && (qn + __builtin_fmaf(cedge, -L2E, cadd) - mref < -FOX_SKIP);
            return __any(!gone) == 0;
        });
    TBEG(5, L, c.wid);
    l = pair_sum(l);
    float f16[16];
    rows_to_o(f16, 1.f / l, wsf, c);
    store_gated(L, c, o, f16, (const bf16_t*)(ws + WS_ZC) + ((size_t)b * SEQ + tw0) * 256 + h * 64, 256, (bf16_t*)(ws + WS_CAT) + ((size_t)b * SEQ + tw0) * DM + 768 + h * 64);
    __syncthreads();
    TEND(5, L, c.wid);
}
}

__device__ void phase_fox(unsigned char* ws, unsigned char* ldsg, int wid0) {
    const int nunits = BATCH * 4 * 16;
    for (int u = blockIdx.x; u < nunits; u += gridDim.x) {
        const int k_ = (u % 256) / (BATCH * 4), bh = u % (BATCH * 4); const int qb = u < 256 ? 15 - k_ : k_;
        att::fox_unit(ws, ldsg, bh >> 2, bh & 3, qb, wid0);
    }
}

namespace att {
constexpr int L_BT4 = 140288;
constexpr int BT4_N = 260;
constexpr int L_BT4KEY = 156928;
constexpr int L_GATE = 137216;
constexpr int L_OTOT = 71680, L_IMPM = L_OTOT, L_IMPS = L_OTOT + 16384;
__device__ __forceinline__ f32x16 splat16(float v) { f32x16 r;
#pragma unroll
    for (int i = 0; i < 16; ++i) r[i] = v;
    return r; }
__device__ __forceinline__ void stats_step(const f32x16& p0, const f32x16& p1, float& m, float& l) {
    float mx = fmaxf(p0[0], p1[0]);
#pragma unroll
    for (int r = 1; r < 16; ++r) mx = fmaxf(mx, fmaxf(p0[r], p1[r]));
    mx = pair_max(mx);
    const float mnew = fmaxf(m, mx);
    const float msafe = (mnew == NEG_INF) ? 0.f : mnew;
    l *= __builtin_amdgcn_exp2f(m - msafe);
    float s = 0.f;
#pragma unroll
    for (int r = 0; r < 16; ++r) s += __builtin_amdgcn_exp2f(p0[r] - msafe) + __builtin_amdgcn_exp2f(p1[r] - msafe);
    l += s;
    m = mnew;
}
__device__ __forceinline__ void bias_mask(f32x16& p0, f32x16& p1, const LAS3 float* bt, int t, int kp0, int kstride, int lo) {
#pragma unroll
    for (int r = 0; r < 16; ++r) {
        const int kl = (r & 3) + 8 * (r >> 2);
        const int ka = kp0 + kstride * kl, kb = ka + 32 * kstride;
        const int da = t - ka, db = t - kb;
        const float ba = bt[min(max(da, 0), 127)], bb = bt[min(max(db, 0), 127)];
        p0[r] = (da < 0 || ka < lo) ? NEG_INF : p0[r] + ba;
        p1[r] = (db < 0 || kb < lo) ? NEG_INF : p1[r] + bb;
        if ((r & 3) == 3) asm volatile("" ::: "memory");
    }
}

__device__ __forceinline__ void bias4(f32x16& p0, f32x16& p1, const LAS3 float* bt4h, int t, int kp0) {
    const int x0 = 191 - (t - kp0);
#pragma unroll
    for (int i = 0; i < 4; ++i) {
        const int xa = x0 + 8 * i, xb = xa + 32;
        const f32x4 ba = *(const LAS3 f32x4*)(bt4h + (xa & 3) * (4 * BT4_N) + (xa & ~3));
        const f32x4 bb = *(const LAS3 f32x4*)(bt4h + (xb & 3) * (4 * BT4_N) + (xb & ~3));
#pragma unroll
        for (int e = 0; e < 4; ++e) { p0[4 * i + e] += ba[e]; p1[4 * i + e] += bb[e]; }
    }
}
__device__ void nsa_unit(const Params& p, unsigned char* ws, unsigned char* ldsg, int b, int g, int qt, int wid0) {
    ws = opq(ws); ldsg = opq(ldsg);
    const Ctx c = make_ctx(wid0);
    LAS3 unsigned char* L = (LAS3 unsigned char*)ldsg;
    LAS3 float* wsf = (LAS3 float*)(L + L_WSF) + c.wid * 64;
    LAS3 float* btab = (LAS3 float*)(L + L_BTAB);
    LAS3 float* impm = (LAS3 float*)(L + L_IMPM);
    LAS3 float* imps = (LAS3 float*)(L + L_IMPS);
    const float L2E = 1.4426950408889634f;
    TBEG(4, L, c.wid); TBEG(23, L, c.wid);
    const int t0 = qt * 64;
    const size_t gb = (size_t)(b * 2 + g);
    const bf16_t* KC = (const bf16_t*)(ws + WS_KCMP) + gb * 256 * 64;
    const bf16_t* VC = (const bf16_t*)(ws + WS_KCMP) + ((size_t)BATCH * 2 + gb) * 256 * 64;
    const int NTC = ((4 * qt + 2) >> 6) + 1;
    pipe_prefetch<false, false>(L, c, KC, VC, nullptr, NTC, [&](int i) { return i; });
    auto QL_ = [&]() { return 8 * c.wid + ((olane() & 31) >> 2); };
    auto HD_ = [&]() { return olane() & 3; };
    btab[c.tid] = p.rel_bias[bucket_of(c.tid & 127) * 8 + g * 4 + (c.tid >> 7)] * L2E;
    bf16x8 qf[4];
    {
        const bf16_t* Q = (const bf16_t*)(ws + WS_QB) + (size_t)(b * SEQ + t0 + QL_()) * 512 + g * 256 + HD_() * 64;
#pragma unroll
        for (int d0 = 0; d0 < 4; ++d0) qf[d0] = *(const bf16x8*)(Q + 16 * d0 + 8 * c.hi);
    }
    {
        const int ln = olane() & 31;
        const float* gp = (const float*)(ws + WS_GF) + (size_t)(b * SEQ + t0 + 8 * c.wid + (ln >> 2)) * 32 + (g * 4 + (ln & 3)) * 3;
        LAS3 float* gs = (LAS3 float*)(L + L_GATE) + c.wid * 96 + ln;
        gs[0] = 1.f / (1.f + __expf(-gp[0])); gs[32] = 1.f / (1.f + __expf(-gp[1])); gs[64] = 1.f / (1.f + __expf(-gp[2]));
    }
    auto gate_sig = [&](int k) { return ((const LAS3 float*)(L + L_GATE))[c.wid * 96 + k * 32 + (olane() & 31)]; };
    __syncthreads();
    if (*(const LAS3 unsigned*)(L + L_BT4KEY) != (unsigned)(g + 1)) {
        LAS3 float* bt4 = (LAS3 float*)(L + L_BT4);
        for (int e = c.tid; e < 16 * BT4_N; e += NTHREADS) {
            const int s = e / (4 * BT4_N), hh = (e / BT4_N) & 3, x = e % BT4_N;
            const int dist = 191 - (x + s);
            bt4[e] = dist < 0 ? NEG_INF : btab[hh * 128 + (dist < 127 ? dist : 127)];
        }
        __syncthreads();
        if (c.tid == 0) *(LAS3 unsigned*)(L + L_BT4KEY) = (unsigned)(g + 1);
    }
    TEND(4, L, c.wid);
    auto BT_ = [&]() { return btab + HD_() * 128; };
    const float b31 = BT_()[127];
    f32x16 o[2];
    float mc = NEG_INF, lc = 0.f;
    TEND(23, L, c.wid);
    TBEG(9, L, c.wid);
    tile_pipeline<false, false, false, true>(L, c, qf, KC, VC, nullptr, NTC,
        [&](int i) { return i; }, [&](int) { return true; },
        [&](int jc, f32x16& p0, f32x16& p1, int) { const float iv = (1024 * jc + 1039 + 128 <= t0) ? b31 : 0.f; p0 = splat16(iv); p1 = splat16(iv); },
        [&](int jc, f32x16& p0, f32x16& p1) {
            if (1024 * jc + 1039 + 128 > t0) bias_mask(p0, p1, BT_(), t0 + QL_(), 16 * (64 * jc + 4 * c.hi) + 31, 16, -(1 << 30));
            stats_step(p0, p1, mc, lc);
        },
        [&](const bf16x8 (&pa)[4], const LAS3 unsigned char* vb) { pv_tile(o, vb, c, pa); },
        [&](f32x16&, f32x16&) {},
        [&]() { return false; });
    lc = pair_sum(lc);
    const float mcs = (mc == NEG_INF) ? 0.f : mc;
    const float rlc = lc > 0.f ? 1.f / lc : 0.f;
    o[0] = f32x16{}; o[1] = f32x16{};
    tile_pipeline<false, false, true, false>(L, c, qf, KC, VC, nullptr, NTC,
        [&](int i) { return i; }, [&](int) { return true; },
        [&](int jc, f32x16& p0, f32x16& p1, int) { const float iv = ((1024 * jc + 1039 + 128 <= t0) ? b31 : 0.f) - mcs; p0 = splat16(iv); p1 = splat16(iv); },
        [&](int jc, f32x16& p0, f32x16& p1) {
            if (1024 * jc + 1039 + 128 > t0) bias_mask(p0, p1, BT_(), t0 + QL_(), 16 * (64 * jc + 4 * c.hi) + 31, 16, -(1 << 30));
#pragma unroll
            for (int r = 0; r < 16; ++r) { p0[r] = __builtin_amdgcn_exp2f(p0[r]) * rlc; p1[r] = __builtin_amdgcn_exp2f(p1[r]) * rlc; }
            if (qt > 15)
#pragma unroll
            for (int blk = 0; blk < 2; ++blk)
#pragma unroll
                for (int i = 0; i < 4; ++i) {
                    const float x0 = blk ? p1[4 * i] : p0[4 * i], x1 = blk ? p1[4 * i + 1] : p0[4 * i + 1], x2 = blk ? p1[4 * i + 2] : p0[4 * i + 2], x3 = blk ? p1[4 * i + 3] : p0[4 * i + 3];
                    float a = (x0 + x1) + (x2 + 0.5f * x3), sp = 0.5f * x3;
                    a += dppf<0xB1>(a); sp += dppf<0xB1>(sp);
                    a += dppf<0x4E>(a); sp += dppf<0x4E>(sp);
                    const int sidx = 16 * jc + 8 * blk + 2 * i + c.hi;
                    if (HD_() == 0) { const int qloc = QL_(); impm[qloc * 64 + sidx] = a; if (sidx + 1 < 64) imps[qloc * 64 + sidx + 1] = sp; }
                }
        },
        [&](const bf16x8 (&pa)[4], const LAS3 unsigned char* vb) { pv_tile(o, vb, c, pa); },
        [&](f32x16&, f32x16&) {},
        [&]() { return false; });
    TEND(9, L, c.wid);
    const bf16_t* KS = (const bf16_t*)(ws + WS_KSL) + gb * SEQ * 64;
    const bf16_t* VS = (const bf16_t*)(ws + WS_VSL) + gb * SEQ * 64;
    pipe_prefetch<false, true>(L, c, KS, VS, nullptr, qt + 1, [&](int i) { return i; });
    TBEG(3, L, c.wid);
    unsigned long long mymask = (2ull << qt) - 1ull;
    if (qt > 15) {
        mymask = 0ull;
        const int ln = olane(), q8 = ln >> 3, j8 = ln & 7;
        LAS3 float* irow = impm + (8 * c.wid + q8) * 64;
        const LAS3 float* srow = imps + (8 * c.wid + q8) * 64;
        float v[8];
#pragma unroll
        for (int k = 0; k < 8; ++k) {
            const int s = 8 * k + j8;
            float x = irow[s] + (s > 0 ? srow[s] : 0.f);
            if (s == 0 || s == qt || s == qt - 1) x = 1e4f;
            if (s > qt) x = -1e4f;
            v[k] = x;
        }
#pragma unroll
        for (int k = 0; k < 8; ++k) irow[8 * k + j8] = v[k];
        auto key_of = [](float x, int idx) { const unsigned u = __float_as_uint(x); const unsigned m = (u & 0x80000000u) ? ~u : (u | 0x80000000u); return ((unsigned long long)m << 32) | (unsigned)(63 - idx); };
        unsigned long long kv8[8];
#pragma unroll
        for (int k = 0; k < 8; ++k) kv8[k] = key_of(v[k], 8 * k + j8);
        int rank[8];
#pragma unroll
        for (int k = 0; k < 8; ++k) rank[k] = 0;
#pragma unroll 2
        for (int s4 = 0; s4 < 16; ++s4) {
            const f32x4 w = *(const LAS3 f32x4*)(irow + 4 * s4);
#pragma unroll
            for (int e = 0; e < 4; ++e) {
                const unsigned long long kw = key_of(w[e], 4 * s4 + e);
#pragma unroll
                for (int k = 0; k < 8; ++k) rank[k] += (int)(kw > kv8[k]);
            }
        }
        const int qrow = (ln & 31) >> 2;
#pragma unroll
        for (int k = 0; k < 8; ++k) {
            const unsigned long long bal = __ballot(rank[k] < 16);
            mymask |= ((bal >> (8 * qrow)) & 0xFFull) << (8 * k);
        }
    }
    TEND(3, L, c.wid);
    TBEG(20, L, c.wid);
    __syncthreads();
    {
        float f16[16];
        rows_to_o(f16, gate_sig(0), wsf, c);
        LAS3 float* otl = (LAS3 float*)(L + L_OTOT) + c.wid * 2048 + (olane() & 31);
#pragma unroll
        for (int r = 0; r < 16; ++r) { otl[crow(r, c.hi) * 64] = o[0][r] * f16[r]; otl[crow(r, c.hi) * 64 + 32] = o[1][r] * f16[r]; }
    }
    {
        const bf16_t* K = KS; const bf16_t* V = VS;
        float mref = 0.f, mref_init = 0.f, l = 0.f; bool started = false;
        o[0] = f32x16{}; o[1] = f32x16{};
        const int NT = qt + 1;
        TEND(20, L, c.wid);
        TBEG(7, L, c.wid);
        for (int rep_ = 0; rep_ < PROBE_SEL; ++rep_)
        tile_pipeline<false, false, true, true>(L, c, qf, K, V, nullptr, NT,
            [&](int i) { return i; },
            [&](int j) { return __any((mymask >> j) & 1ull) != 0; },
            [&](int j, f32x16& p0, f32x16& p1, int) {
                mref_init = mref;
                const bool sel = (mymask >> j) & 1ull;
                const float init = sel ? (j + 2 >= qt ? 0.f : b31) - mref : NEG_INF;
                p0 = splat16(init); p1 = splat16(init);
            },
            [&](int j, f32x16& p0, f32x16& p1) {
                if (j + 2 >= qt) bias4(p0, p1, (const LAS3 float*)(L + L_BT4) + HD_() * BT4_N, t0 + QL_(), 64 * j + 4 * c.hi);
                softmax_step(p0, p1, mref, started, l, o, wsf, c);
            },
            [&](const bf16x8 (&pa)[4], const LAS3 unsigned char* vb) { pv_tile(o, vb, c, pa); },
        [&](f32x16& n0, f32x16& n1) { const float d = mref - mref_init; if (__any(d != 0.f)) {
#pragma unroll
                for (int r = 0; r < 16; ++r) { n0[r] -= d; n1[r] -= d; } } },
        [&]() { return false; });
        TEND(7, L, c.wid);
        TBEG(21, L, c.wid);
        {
            const int jlo_ = qt - 8 > 0 ? qt - 8 : 0;
            pipe_prefetch<false, true>(L, c, (const bf16_t*)(ws + WS_KWN) + gb * SEQ * 64, (const bf16_t*)(ws + WS_VWN) + gb * SEQ * 64, nullptr, qt - jlo_ + 1, [&](int i) { return qt - i; });
        }
        l = pair_sum(l);
        float f16[16];
        rows_to_o(f16, l > 0.f ? gate_sig(1) / l : 0.f, wsf, c);
        LAS3 float* otl = (LAS3 float*)(L + L_OTOT) + c.wid * 2048 + (olane() & 31);
#pragma unroll
        for (int r = 0; r < 16; ++r) { otl[crow(r, c.hi) * 64] += o[0][r] * f16[r]; otl[crow(r, c.hi) * 64 + 32] += o[1][r] * f16[r]; }
    }
    {
        const bf16_t* K = (const bf16_t*)(ws + WS_KWN) + gb * SEQ * 64;
        const bf16_t* V = (const bf16_t*)(ws + WS_VWN) + gb * SEQ * 64;
        float mref = 0.f, mref_init = 0.f, l = 0.f; bool started = false;
        o[0] = f32x16{}; o[1] = f32x16{};
        const int jlo = qt - 8 > 0 ? qt - 8 : 0;
        const int NT = qt - jlo + 1;
        TEND(21, L, c.wid);
        TBEG(8, L, c.wid);
        for (int rep_ = 0; rep_ < PROBE_WIN; ++rep_)
        tile_pipeline<false, false, true, true>(L, c, qf, K, V, nullptr, NT,
            [&](int i) { return qt - i; }, [&](int) { return true; },
            [&](int j, f32x16& p0, f32x16& p1, int) { mref_init = mref; const float init = ((j + 2 >= qt) ? 0.f : b31) - mref; p0 = splat16(init); p1 = splat16(init); },
            [&](int j, f32x16& p0, f32x16& p1) {
                if (j + 2 >= qt) bias4(p0, p1, (const LAS3 float*)(L + L_BT4) + HD_() * BT4_N, t0 + QL_(), 64 * j + 4 * c.hi);
                else if (j == qt - 8) {
                    const int lo = t0 + QL_() - 511, kp0 = 64 * j + 4 * c.hi;
#pragma unroll
                    for (int r = 0; r < 16; ++r) {
                        const int ka = kp0 + (r & 3) + 8 * (r >> 2);
                        if (ka < lo) p0[r] = NEG_INF;
                        if (ka + 32 < lo) p1[r] = NEG_INF;
                    }
                }
                softmax_step(p0, p1, mref, started, l, o, wsf, c);
            },
            [&](const bf16x8 (&pa)[4], const LAS3 unsigned char* vb) { pv_tile(o, vb, c, pa); },
        [&](f32x16& n0, f32x16& n1) { const float d = mref - mref_init; if (__any(d != 0.f)) {
#pragma unroll
                for (int r = 0; r < 16; ++r) { n0[r] -= d; n1[r] -= d; } } },
        [&]() { return false; });
        TEND(8, L, c.wid);
        TBEG(22, L, c.wid);
        l = pair_sum(l);
        float f16[16];
        rows_to_o(f16, l > 0.f ? gate_sig(2) / l : 0.f, wsf, c);
        LAS3 float* otl = (LAS3 float*)(L + L_OTOT) + c.wid * 2048 + (olane() & 31);
#pragma unroll
        for (int r = 0; r < 16; ++r) { otl[crow(r, c.hi) * 64] += o[0][r] * f16[r]; otl[crow(r, c.hi) * 64 + 32] += o[1][r] * f16[r]; }
    }
    TEND(22, L, c.wid);
    TBEG(5, L, c.wid);
    {
        const bf16_t* Z = (const bf16_t*)(ws + WS_ZB);
        bf16_t* cat = (bf16_t*)(ws + WS_CAT);
        const int lnf = olane(), ch = lnf & 7;
        const LAS3 float* otw = (const LAS3 float*)(L + L_OTOT) + c.wid * 2048;
#pragma unroll
        for (int it = 0; it < 4; ++it) {
            const int row = it * 8 + (lnf >> 3);
            const size_t mr = (size_t)b * SEQ + t0 + 8 * c.wid + (row >> 2);
            const int h8 = g * 4 + (row & 3);
            const f32x4 o0 = *(const LAS3 f32x4*)(otw + row * 64 + ch * 8), o1 = *(const LAS3 f32x4*)(otw + row * 64 + ch * 8 + 4);
            const u32x4_t zz = *(const u32x4_t*)(Z + mr * 512 + h8 * 64 + ch * 8);
            float r[8];
#pragma unroll
            for (int e = 0; e < 8; ++e) {
                const float z = __uint_as_float((e & 1) ? (zz[e >> 1] & 0xffff0000u) : (zz[e >> 1] << 16));
                const float ov = e < 4 ? o0[e] : o1[e - 4];
                r[e] = ov * (z / (1.f + __expf(-z)));
            }
            u32x4_t w; w.x = cvtpk(r[0], r[1]); w.y = cvtpk(r[2], r[3]); w.z = cvtpk(r[4], r[5]); w.w = cvtpk(r[6], r[7]);
            *(u32x4_t*)(cat + mr * DM + 256 + h8 * 64 + ch * 8) = w;
        }
    }
    __syncthreads();
    TEND(5, L, c.wid);
}
}
__device__ void phase_nsa(const Params& p, unsigned char* ws, unsigned char* ldsg, int wid0) {
    const int nunits = BATCH * 2 * 64;
    for (int u = blockIdx.x; u < nunits; u += gridDim.x) {
        const int qt = 63 - u / (BATCH * 2), bg = u % (BATCH * 2);
        att::nsa_unit(p, ws, ldsg, bg >> 1, bg & 1, qt, wid0);
    }
}

namespace att {
constexpr float SB_EXIT = 64.f;
__device__ void sb_unit(unsigned char* ws, unsigned char* ldsg, int b, int h, int qb, int wid0) {
    ws = opq(ws); ldsg = opq(ldsg);
    const Ctx c = make_ctx(wid0);
    LAS3 unsigned char* L = (LAS3 unsigned char*)ldsg;
    const int t0 = qb * 256;
    const int tw0 = t0 + c.wid * 32;
    const int t = tw0 + c.r32;
    const size_t hb = ((size_t)(b * 4 + h) * SEQ);
    const bf16_t* Q = (const bf16_t*)(ws + WS_QA) + (hb + t) * 64;
    const bf16_t* K = (const bf16_t*)(ws + WS_KA) + hb * 64;
    const bf16_t* V = (const bf16_t*)(ws + WS_VA) + hb * 64;
    bf16x8 qf[4];
#pragma unroll
    for (int d0 = 0; d0 < 4; ++d0) qf[d0] = *(const bf16x8*)(Q + 16 * d0 + 8 * c.hi);
    float carry = 0.f;
    f32x16 o[2]; o[0] = f32x16{}; o[1] = f32x16{};
    const int NT = (t0 + 256) / 64;
    tile_pipeline<true, false, true, false>(L, c, qf, K, V, nullptr, NT,
        [&](int i) { return NT - 1 - i; },
        [&](int j) { return (j * 64 <= tw0 + 31) && __any(carry <= SB_EXIT); },
        [&](int, f32x16& p0, f32x16& p1, int) { p0 = f32x16{}; p1 = f32x16{}; },
        [&](int j, f32x16& z0, f32x16& z1) {
            const int kv0 = j * 64 + 4 * c.hi;
            const bool diag = j * 64 + 63 >= tw0;
            f32x16 e0, e1;
#pragma unroll
            for (int r = 0; r < 16; ++r) {
                const float a0 = z0[r], a1 = z1[r];
                e0[r] = fmaxf(a0, 0.f) + __builtin_amdgcn_logf(1.f + __builtin_amdgcn_exp2f(-fabsf(a0)));
                e1[r] = fmaxf(a1, 0.f) + __builtin_amdgcn_logf(1.f + __builtin_amdgcn_exp2f(-fabsf(a1)));
            }
            if (diag) {
#pragma unroll
                for (int r = 0; r < 16; ++r) {
                    const int kv = kv0 + (r & 3) + 8 * (r >> 2);
                    if (kv >= t) { e0[r] = 0.f; z0[r] = NEG_INF; }
                    if (kv + 32 >= t) { e1[r] = 0.f; z1[r] = NEG_INF; }
                }
            }
            float cs[2][4], pc[2][4], after[2][4];
#pragma unroll
            for (int i4 = 0; i4 < 4; ++i4) {
                cs[0][i4] = (e0[4 * i4] + e0[4 * i4 + 1]) + (e0[4 * i4 + 2] + e0[4 * i4 + 3]);
                cs[1][i4] = (e1[4 * i4] + e1[4 * i4 + 1]) + (e1[4 * i4 + 2] + e1[4 * i4 + 3]);
                pc[0][i4] = pair_other(cs[0][i4], c.hi);
                pc[1][i4] = pair_other(cs[1][i4], c.hi);
            }
            float run = 0.f;
#pragma unroll
            for (int blk = 1; blk >= 0; --blk)
#pragma unroll
                for (int i4 = 3; i4 >= 0; --i4) { after[blk][i4] = run + (c.hi == 0 ? pc[blk][i4] : 0.f); run += cs[blk][i4] + pc[blk][i4]; }
#pragma unroll
            for (int i4 = 0; i4 < 4; ++i4) {
                {
                    const float base = carry + after[0][i4];
                    const float s3 = base + e0[4 * i4 + 3], s2 = s3 + e0[4 * i4 + 2], s1 = s2 + e0[4 * i4 + 1], s0 = s1 + e0[4 * i4];
                    z0[4 * i4] = __builtin_amdgcn_exp2f(z0[4 * i4] - s0);
                    z0[4 * i4 + 1] = __builtin_amdgcn_exp2f(z0[4 * i4 + 1] - s1);
                    z0[4 * i4 + 2] = __builtin_amdgcn_exp2f(z0[4 * i4 + 2] - s2);
                    z0[4 * i4 + 3] = __builtin_amdgcn_exp2f(z0[4 * i4 + 3] - s3);
                }
                {
                    const float base = carry + after[1][i4];
                    const float s3 = base + e1[4 * i4 + 3], s2 = s3 + e1[4 * i4 + 2], s1 = s2 + e1[4 * i4 + 1], s0 = s1 + e1[4 * i4];
                    z1[4 * i4] = __builtin_amdgcn_exp2f(z1[4 * i4] - s0);
                    z1[4 * i4 + 1] = __builtin_amdgcn_exp2f(z1[4 * i4 + 1] - s1);
                    z1[4 * i4 + 2] = __builtin_amdgcn_exp2f(z1[4 * i4 + 2] - s2);
                    z1[4 * i4 + 3] = __builtin_amdgcn_exp2f(z1[4 * i4 + 3] - s3);
                }
            }
            carry += run;
        },
        [&](const bf16x8 (&pa)[4], const LAS3 unsigned char* vb) { pv_tile(o, vb, c, pa); },
        [&](f32x16&, f32x16&) {},
        [&]() { return __any(carry <= SB_EXIT) == 0; });
    float one16[16];
#pragma unroll
    for (int r = 0; r < 16; ++r) one16[r] = 1.f;
    store_gated(L, c, o, one16, (const bf16_t*)(ws + WS_ZA) + ((size_t)b * SEQ + tw0) * 256 + h * 64, 256, (bf16_t*)(ws + WS_CAT) + ((size_t)b * SEQ + tw0) * DM + h * 64);
    __syncthreads();
}
}

namespace pg8 {
struct EpiCompress {
    static constexpr bool PERM = false, AFTER_DRAIN = true;
    const float* bias1;
    const float* b1;
    const bf16_t* w2t;
    bf16_t* outp;
    __device__ __forceinline__ void fused(f32x4 (&acc)[2][2][4][2], const Unit& u, int wr, int wc, int fr, int fq, PG8_LAS unsigned char* lds, int wid, int lane) const {
        constexpr int PITCH = 528;
#pragma unroll
        for (int bj = 0; bj < 2; ++bj)
#pragma unroll
            for (int n = 0; n < 2; ++n) {
                const int col = bj * HALF + wc * 32 + n * 16 + 4 * fq;
                const f32x4 bv = *(const f32x4*)(bias1 + col) + *(const f32x4*)(b1 + col);
#pragma unroll
                for (int ai = 0; ai < 2; ++ai)
#pragma unroll
                    for (int m = 0; m < 4; ++m) {
                        const int row = ai * HALF + wr * 64 + m * 16 + fr;
                        f32x4 v = acc[ai][bj][m][n] + bv;
#pragma unroll
                        for (int e = 0; e < 4; ++e) v[e] = v[e] / (1.f + __expf(-v[e]));
                        typedef unsigned u32x2_t __attribute__((ext_vector_type(2)));
                        u32x2_t w; w.x = pk2(v[0], v[1]); w.y = pk2(v[2], v[3]);
                        *(PG8_LAS u32x2_t*)(lds + row * PITCH + col * 2) = w;
                    }
            }
        asm volatile("s_waitcnt lgkmcnt(0)" ::: "memory"); __builtin_amdgcn_s_barrier(); asm volatile("" ::: "memory");
        typedef float f32x16 __attribute__((ext_vector_type(16)));
        const int r32 = lane & 31, hi = lane >> 5;
        f32x16 o0 = f32x16{}, o1 = f32x16{};
#pragma unroll
        for (int s = 0; s < 16; ++s) {
            const bf16x8 a = *(const PG8_LAS bf16x8*)(lds + (wid * 32 + r32) * PITCH + (16 * s + 8 * hi) * 2);
            const bf16x8 b0 = *(const bf16x8*)(w2t + (size_t)r32 * 256 + 16 * s + 8 * hi);
            const bf16x8 b1 = *(const bf16x8*)(w2t + (size_t)(32 + r32) * 256 + 16 * s + 8 * hi);
            o0 = __builtin_amdgcn_mfma_f32_32x32x16_bf16(a, b0, o0, 0, 0, 0);
            o1 = __builtin_amdgcn_mfma_f32_32x32x16_bf16(a, b1, o1, 0, 0, 0);
        }
        bf16_t* op = outp + ((size_t)u.pm * 256 + wid * 32) * 64;
#pragma unroll
        for (int r = 0; r < 16; ++r) {
            const int row = (r & 3) + 8 * (r >> 2) + 4 * hi;
            const bool pad = (wid * 32 + row) == 255;
            op[(size_t)row * 64 + r32] = pad ? (bf16_t)0 : (bf16_t)f2bf(o0[r]);
            op[(size_t)row * 64 + 32 + r32] = pad ? (bf16_t)0 : (bf16_t)f2bf(o1[r]);
        }
        asm volatile("s_waitcnt lgkmcnt(0)" ::: "memory"); __builtin_amdgcn_s_barrier(); asm volatile("" ::: "memory");
    }
};
}
__device__ __forceinline__ void flag_publish(unsigned* flag) {
    asm volatile("s_waitcnt vmcnt(0)" ::: "memory");
    __syncthreads();
    if (threadIdx.x == 0) { __threadfence(); __hip_atomic_store(flag, 1u, __ATOMIC_RELAXED, __HIP_MEMORY_SCOPE_AGENT); }
}
__device__ __forceinline__ void flag_wait2(unsigned* f0, unsigned* f1) {
    if (threadIdx.x == 0) {
        unsigned sp = 0;
        while (__hip_atomic_load(f0, __ATOMIC_RELAXED, __HIP_MEMORY_SCOPE_AGENT) == 0u || __hip_atomic_load(f1, __ATOMIC_RELAXED, __HIP_MEMORY_SCOPE_AGENT) == 0u) { __builtin_amdgcn_s_sleep(8); if (++sp > (1u << 22)) break; }
        __builtin_amdgcn_fence(__ATOMIC_ACQUIRE, "agent");
        asm volatile("s_waitcnt vmcnt(0)" ::: "memory");
    }
    __syncthreads();
}
__device__ void phase_work(const Params& p, int layer, unsigned char* ws, unsigned char* ldsg, PG8_LAS unsigned char* lds3, int wid0, int rep) {
    ws = opq(ws);
    unsigned* ctr = (unsigned*)(ws + WS_CTR) + layer * 64 + rep * 16;
    unsigned* flg = (unsigned*)(ws + WS_CTR) + 128 + layer * 64 + rep * 256;
    if (threadIdx.x == 0) *(volatile unsigned*)(ldsg + att::L_BT4KEY) = 0u;
    if (layer == 0) { float* ss = (float*)(ws + WS_SS); for (int i = blockIdx.x * NTHREADS + otid(wid0); i < MTOK; i += gridDim.x * NTHREADS) ss[i] = 0.f; }
    for (;;) {
        TBEG(6, lds3, wid0);
        __syncthreads();
        if (threadIdx.x == 0) *(volatile unsigned*)(ldsg + att::L_UNIT) = atomicAdd(ctr, 1u);
        __syncthreads();
        const unsigned it = *(volatile unsigned*)(ldsg + att::L_UNIT);
        if (it >= (unsigned)N_ATT_UNITS) break;
        const unsigned code = c_unit_order[it];
        const int type = (int)(code >> 11), q = (code >> 5) & 63, x = code & 31;
        if (type == 2) {
            const int which = x >> 4;
            const int lw = layer * 2 + which;
            pg8::Gemm g{(const bf16_t*)(ws + (which ? WS_VC : WS_KC)), (const bf16_t*)(ws + WS_W1T) + (size_t)lw * 256 * 2048, BATCH * 2 * 256, 256, 2048, 1024, 2048};
            pg8::StaticOrder S; S.init(BATCH * 2 * 256, 256, 1 << 20, x & 15);
            pg8::Unit uu; S.next(0, uu);
            pg8::EpiCompress E{(const float*)(ws + WS_BIAS1) + lw * 256, p.cmp_b1 + lw * 256, (const bf16_t*)(ws + WS_W2T) + (size_t)lw * 64 * 256, (bf16_t*)(ws + WS_KCMP) + (size_t)which * BATCH * 2 * 256 * 64};
            TBEG(12, lds3, wid0);
            pg8::gemm_phase<pg8::EpiCompress, pg8::StaticOrder, false, true>(lds3, g, S, E, wid0);
            flag_publish(flg + which * 16 + uu.pm);
            TEND(12, lds3, wid0);
        } else if (type == 3) {
            const int tid_ = otid(wid0);
            const int b = x >> 2, h = x & 3;
            const float* gf = (const float*)(ws + WS_GF);
            float* cfox = (float*)(ws + WS_CFOX) + ((size_t)(b * 4 + h)) * SEQ;
            const float fb = p.forget_b[layer * 4 + h];
            float lf[8]; double s = 0.0;
#pragma unroll
            for (int i = 0; i < 8; ++i) {
                const float v = gf[((size_t)b * SEQ + 8 * tid_ + i) * 32 + 24 + h] + fb;
                lf[i] = fminf(v, 0.f) - LN2 * __builtin_amdgcn_logf(1.f + __builtin_amdgcn_exp2f(-fabsf(v) * 1.4426950408889634f));
                s += (double)lf[i];
            }
            double* tsum = (double*)(ldsg + 100000);
            tsum[tid_] = s;
            __syncthreads();
            double run = 0.0;
            for (int k = 0; k < tid_; ++k) run += tsum[k];
#pragma unroll
            for (int i = 0; i < 8; ++i) { run += (double)lf[i]; cfox[8 * tid_ + i] = (float)run; }
            {
                const bf16_t* Kp = (const bf16_t*)(ws + WS_KCF) + ((size_t)(b * 4 + h) * SEQ + 8 * tid_) * 64;
                float mx2 = 0.f;
                for (int i = 0; i < 8; ++i) {
                    float s2 = 0.f;
#pragma unroll
                    for (int d8 = 0; d8 < 8; ++d8) {
                        const uint4 w = *(const uint4*)(Kp + i * 64 + d8 * 8);
                        const unsigned ww[4] = {w.x, w.y, w.z, w.w};
#pragma unroll
                        for (int e = 0; e < 4; ++e) { const float lo = __uint_as_float(ww[e] << 16), hi = __uint_as_float(ww[e] & 0xffff0000u); s2 += lo * lo + hi * hi; }
                    }
                    mx2 = fmaxf(mx2, s2);
                }
                __syncthreads();
                float* tmx = (float*)(ldsg + 100000);
                tmx[tid_] = mx2;
                __syncthreads();
                if (tid_ < 64) { float m8 = 0.f; for (int k = 0; k < 8; ++k) m8 = fmaxf(m8, tmx[tid_ * 8 + k]); m8 = wave_max(m8); if (tid_ == 0) ((float*)(ws + WS_KMAX))[b * 4 + h] = sqrtf(m8) * 1.01f; }
            }
            flag_publish(flg + 32 + x);
        } else if (type == 4) {
            TBEG(11, lds3, wid0);
            att::sb_unit(ws, ldsg, x >> 2, x & 3, q, wid0);
            TEND(11, lds3, wid0);
        } else if (type == 1) {
            flag_wait2(flg + (x), flg + 16 + (x));
            TEND(6, lds3, wid0);
            TBEG(14, lds3, wid0);
            att::nsa_unit(p, ws, ldsg, x >> 1, x & 1, q, wid0);
            TEND(14, lds3, wid0);
        } else {
            flag_wait2(flg + 32 + x, flg + 32 + x);
            TEND(6, lds3, wid0);
            TBEG(10, lds3, wid0);
            att::fox_unit(ws, ldsg, x >> 2, x & 3, q, wid0);
            TEND(10, lds3, wid0);
        }
    }
}

__global__ void __launch_bounds__(NTHREADS, 2) mega(Params p) {
    cg::grid_group grid = cg::this_grid();
    extern __shared__ __attribute__((aligned(16))) unsigned char lds[];
    PG8_LAS unsigned char* lds3 = (PG8_LAS unsigned char*)lds;
    const int wid0 = __builtin_amdgcn_readfirstlane((int)(threadIdx.x >> 6));
#if PROBE_TIME
    if (threadIdx.x == 0) *(volatile long long*)(lds + (157184 + 16)) = 0;
#endif
    if (threadIdx.x < 2) ((volatile LAS unsigned*)(lds3 + LDS_BAR_OFF))[threadIdx.x] = 0u;
    __syncthreads();
    const XcdBarrier xbar = xcd_barrier_post((unsigned*)(p.ws + WS_BAR), (volatile LAS unsigned*)(lds3 + LDS_BAR_OFF));

    if (blockIdx.x == 0) for (int i = threadIdx.x; i < 1024; i += NTHREADS) ((unsigned*)(p.ws + WS_CTR))[i] = 0u;
    TBEG(16, lds3, wid0);
    for (int rep_ = 0; rep_ < PROBE_P0; ++rep_) p0_weights(p, lds, wid0);
    TEND(16, lds3, wid0);
    TBEG(17, lds3, wid0);
    for (int rep_ = 0; rep_ < PROBE_CVT; ++rep_) phase_convert_x(p.x, (bf16_t*)(p.ws + WS_XB), (float*)(p.ws + WS_SS), wid0);
    TEND(17, lds3, wid0);
    if (p.out == nullptr) grid.sync();
    xcd_barrier(xbar);
    for (int layer = 0; layer < DEPTH; ++layer) {
        const float* xin = layer == 0 ? p.x : p.out;
        unsigned char* ws = opq(p.ws);
        bf16_t* xb = (bf16_t*)(ws + WS_XB); bf16_t* cat = (bf16_t*)(ws + WS_CAT); float* ss = (float*)(ws + WS_SS);
        {
            pg8::Gemm g{xb, (const bf16_t*)(ws + WS_WTIN) + (size_t)layer * NPAD * DM, MTOK, NPAD, DM, DM, DM};
            pg8::StaticOrder S; S.init(MTOK, NPAD, (int)gridDim.x, (int)blockIdx.x);
            pg8::EpiInProj E{ws, ss};
            for (int rep_ = 0; rep_ < PROBE_INP; ++rep_) pg8::gemm_phase<pg8::EpiInProj, pg8::StaticOrder, true, true>(lds3, g, S, E, wid0);
        }
        xcd_barrier(xbar);
        TBEG(15, lds3, wid0);
        for (int rep_ = 0; rep_ < PROBE_ATT; ++rep_) { phase_work(p, layer, ws, lds, lds3, wid0, rep_); if (rep_ + 1 < PROBE_ATT) xcd_barrier(xbar); }
        TEND(15, lds3, wid0);
        TBEG(13, lds3, wid0);
        xcd_barrier(xbar);
        TEND(13, lds3, wid0);
        {
            pg8::Gemm g{cat, (const bf16_t*)(ws + WS_WTOUT) + (size_t)layer * DM * DM, MTOK, DM, DM, DM, DM};
            pg8::StaticOrder S; S.init(MTOK, DM, (int)gridDim.x, (int)blockIdx.x);
            if (layer == 0) { pg8::EpiOutProj<true> E{xin, p.out, xb, ss}; for (int rep_ = 0; rep_ < PROBE_OUT; ++rep_) pg8::gemm_phase<pg8::EpiOutProj<true>, pg8::StaticOrder, true, true>(lds3, g, S, E, wid0); }
            else { pg8::EpiOutProj<false> E{xin, p.out, nullptr, nullptr}; pg8::gemm_phase<pg8::EpiOutProj<false>, pg8::StaticOrder, true, true>(lds3, g, S, E, wid0); }
        }
        xcd_barrier(xbar);
    }
    for (int rep_ = 0; rep_ < PROBE_SYNC; ++rep_) xcd_barrier(xbar);
#if PROBE_TIME
    if (blockIdx.x == 0 && wid0 == 0) { const long long w_ = __builtin_amdgcn_readfirstlane((int)(*(volatile long long*)(lds + (157184 + 16)) >> 8)); const long long s_ = clock64(); while (((clock64() - s_) >> 8) < w_) __builtin_amdgcn_s_sleep(8); }
    __syncthreads();
#endif
    phase_final_norm(p.out, p.final_g, wid0);
}

extern "C" void kernel_launch(void* const* d_in, const int* in_sizes, int n_in, void* d_out, int out_size, void* d_ws, size_t ws_size, hipStream_t stream) {
    static int grid_blocks = 0;
    if (!grid_blocks) {
        if (ws_size < WS_END) { fprintf(stderr, "kernel_launch: workspace too small (%zu < %zu)\n", ws_size, (size_t)WS_END); grid_blocks = -1; return; }
        int dev = 0, cus = 0, per_cu = 0;
        (void)hipGetDevice(&dev);
        (void)hipDeviceGetAttribute(&cus, hipDeviceAttributeMultiprocessorCount, dev);
        (void)hipFuncSetAttribute((const void*)mega, hipFuncAttributeMaxDynamicSharedMemorySize, LDS_BYTES);
        (void)hipOccupancyMaxActiveBlocksPerMultiprocessor(&per_cu, mega, NTHREADS, LDS_BYTES);
        if (per_cu < 1) { fprintf(stderr, "kernel_launch: occupancy query says %d blocks/CU\n", per_cu); per_cu = 1; }
        grid_blocks = cus;
    }
    if (grid_blocks < 0) return;
    Params p{};
    p.x = (const float*)d_in[0]; p.norm_g = (const float*)d_in[1]; p.w_in = (const float*)d_in[2]; p.w_out = (const float*)d_in[3];
    p.forget_b = (const float*)d_in[4]; p.cmp_w1 = (const float*)d_in[5]; p.cmp_b1 = (const float*)d_in[6]; p.cmp_w2 = (const float*)d_in[7];
    p.cmp_pe = (const float*)d_in[8]; p.rel_bias = (const float*)d_in[9]; p.final_g = (const float*)d_in[10];
    p.out = (float*)d_out; p.ws = (unsigned char*)d_ws;
    (void)hipMemsetAsync((char*)d_ws + WS_BAR, 0, XCD_BAR_WORDS * sizeof(unsigned), stream);
    (void)hipMemsetAsync((char*)d_ws + WS_BIAS1, 0, 4 * 256 * sizeof(float), stream);
    void* args[] = {&p};
    hipError_t e = hipLaunchCooperativeKernel((void*)mega, dim3(grid_blocks), dim3(NTHREADS), args, LDS_BYTES, stream);
    if (e != hipSuccess) fprintf(stderr, "cooperative launch failed: %s (grid %d)\n", hipGetErrorString(e), grid_blocks);
}
```

```cpp
#include <hip/hip_runtime.h>
#include <hip/hip_cooperative_groups.h>
#include <cstdio>
#include <cstdint>
namespace cg = cooperative_groups;
#define PROBE_FOX 1
#define PROBE_NSA 1
#define PROBE_MID 1
#define PROBE_INP 1
#define PROBE_P0 1
#define PROBE_CVT 1
#define PROBE_TIME 0
#define PROBE_SYNC 0
#define PROBE_ATT 1
#define PROBE_OUT 1
#define PROBE_TOPK 1
#define PROBE_SEL 1
#define PROBE_WIN 1

constexpr int DM = 1024, BATCH = 8, SEQ = 4096, DEPTH = 2, HD = 64, MTOK = BATCH * SEQ;
constexpr int INW = 3868, NPAD = 4096;
constexpr int C_QA = 0, C_KA = 256, C_VA = 512, C_ZA = 768, C_QB = 1024, C_KC = 1536, C_VC = 1664, C_KSL = 1792, C_VSL = 1920,
              C_KWN = 2048, C_VWN = 2176, C_GB = 2304, C_ZB = 2328, C_QC = 2840, C_KCF = 3096, C_VCF = 3352, C_FC = 3608, C_ZC = 3612;
constexpr int NCMP = 255;
constexpr float QSCALE = 0.125f * 1.4426950408889634f;
constexpr float LN2 = 0.6931471805599453f;
constexpr size_t MiB = 1u << 20;
constexpr size_t WS_WTIN = 0, WS_WTOUT = 16 * MiB, WS_W1T = 20 * MiB, WS_W2T = 24 * MiB, WS_BIAS1 = 25 * MiB, WS_SS = 25 * MiB + 512 * 1024, WS_CTR = 25 * MiB + 768 * 1024, WS_BAR = 25 * MiB + 4096  , WS_KMAX = 25 * MiB + 900 * 1024,
                 WS_CFOX = 26 * MiB, WS_SEL = 27 * MiB, WS_KCMP = 28 * MiB, WS_GF = 30 * MiB, WS_XB = 36 * MiB, WS_CAT = 100 * MiB,
                 WS_QA = 164 * MiB, WS_KA = 180 * MiB, WS_VA = 196 * MiB, WS_ZA = 212 * MiB, WS_QB = 228 * MiB, WS_KC = 260 * MiB, WS_VC = 268 * MiB,
                 WS_KSL = 276 * MiB, WS_VSL = 284 * MiB, WS_KWN = 292 * MiB, WS_VWN = 300 * MiB, WS_ZB = 308 * MiB, WS_QC = 340 * MiB, WS_KCF = 356 * MiB,
                 WS_VCF = 372 * MiB, WS_ZC = 388 * MiB, WS_DBG_PROJF = 404 * MiB, WS_DBG_OCMP = 466 * MiB, WS_DBG_KCMPF = 475 * MiB, WS_END = 480 * MiB;
constexpr int LDS_BAR_OFF = 157184;
constexpr int LDS_BYTES = 157184 + 64;
constexpr int NTHREADS = 512, NWAVES = 8;

typedef unsigned short bf16_t;
__device__ __forceinline__ float bf2f(bf16_t v) { return __uint_as_float((unsigned)v << 16); }
__device__ __forceinline__ unsigned f2bf(float f) { unsigned u = __float_as_uint(f); return (u + 0x7fffu + ((u >> 16) & 1u)) >> 16; }
typedef float f32x2_hw_t __attribute__((ext_vector_type(2))); typedef __bf16 bf16x2_hw_t __attribute__((ext_vector_type(2)));
__device__ __forceinline__ unsigned pk2(float lo, float hi) { f32x2_hw_t v = {lo, hi}; bf16x2_hw_t b = __builtin_convertvector(v, bf16x2_hw_t); return __builtin_bit_cast(unsigned, b); }

__constant__ unsigned char c_bucket[128] = {0, 1, 2, 3, 4, 5, 6, 7, 8, 9, 10, 11, 12, 13, 14, 15, 16, 16, 16, 17, 17, 18, 18, 18, 19, 19, 19, 20, 20, 20, 20, 21, 21, 21, 21, 22, 22, 22, 22, 22, 23, 23, 23, 23, 23, 23, 24, 24, 24, 24, 24, 24, 25, 25, 25, 25, 25, 25, 25, 26, 26, 26, 26, 26, 26, 26, 26, 27, 27, 27, 27, 27, 27, 27, 27, 27, 27, 28, 28, 28, 28, 28, 28, 28, 28, 28, 28, 29, 29, 29, 29, 29, 29, 29, 29, 29, 29, 29, 29, 30, 30, 30, 30, 30, 30, 30, 30, 30, 30, 30, 30, 30, 30, 31, 31, 31, 31, 31, 31, 31, 31, 31, 31, 31, 31, 31, 31, 31};

struct Params {
    const float *x, *norm_g, *w_in, *w_out, *forget_b, *cmp_w1, *cmp_b1, *cmp_w2, *cmp_pe, *rel_bias, *final_g;
    float* out;
    unsigned char* ws;
};

template <int CTRL> __device__ __forceinline__ float dppf(float v) { return __int_as_float(__builtin_amdgcn_update_dpp(0, __float_as_int(v), CTRL, 0xF, 0xF, true)); }
__device__ __forceinline__ float rdlane(float v, int l) { return __int_as_float(__builtin_amdgcn_readlane(__float_as_int(v), l)); }
__device__ __forceinline__ float wave_sum(float v) {
    v += dppf<0xB1>(v); v += dppf<0x4E>(v); v += dppf<0x141>(v); v += dppf<0x140>(v);
    return (rdlane(v, 0) + rdlane(v, 16)) + (rdlane(v, 32) + rdlane(v, 48));
}
__device__ __forceinline__ float wave_max(float v) {
    v = fmaxf(v, dppf<0xB1>(v)); v = fmaxf(v, dppf<0x4E>(v)); v = fmaxf(v, dppf<0x141>(v)); v = fmaxf(v, dppf<0x140>(v));
    return fmaxf(fmaxf(rdlane(v, 0), rdlane(v, 16)), fmaxf(rdlane(v, 32), rdlane(v, 48)));
}
__device__ __forceinline__ void pair32(float v, float& lo, float& hi) { auto rr = __builtin_amdgcn_permlane32_swap(__float_as_uint(v), __float_as_uint(v), false, false); lo = __uint_as_float(rr[0]); hi = __uint_as_float(rr[1]); }
__device__ __forceinline__ float pair_max(float v) { float a, b; pair32(v, a, b); return fmaxf(a, b); }
__device__ __forceinline__ float pair_sum(float v) { float a, b; pair32(v, a, b); return a + b; }
__device__ __forceinline__ float pair_other(float v, int hi) { float a, b; pair32(v, a, b); return hi ? a : b; }
__device__ __forceinline__ float sigmoidf_(float v) { return 1.f / (1.f + expf(-v)); }
__device__ __forceinline__ float siluf_(float v) { return v / (1.f + expf(-v)); }
__device__ __forceinline__ float softplusf_(float z) { return fmaxf(z, 0.f) + log1pf(expf(-fabsf(z))); }
__device__ __forceinline__ int bucket_of(int dist) { return dist >= 128 ? 31 : (int)c_bucket[dist < 0 ? 0 : dist]; }
__device__ __forceinline__ int otid(int wid0) { unsigned z = 0u; asm volatile("" : "+v"(z)); int t = wid0 * 64 + (int)__builtin_amdgcn_mbcnt_hi(~0u, __builtin_amdgcn_mbcnt_lo(~0u, z)); asm volatile("" : "+v"(t)); return t; }
template <class T> __device__ __forceinline__ T* opq(T* p) { asm volatile("" : "+s"(p)); return p; }
__device__ __forceinline__ int opqi(int v) { asm volatile("" : "+v"(v)); return v; }
__device__ __forceinline__ int olane() { unsigned z = 0u; asm volatile("" : "+v"(z)); return (int)__builtin_amdgcn_mbcnt_hi(~0u, __builtin_amdgcn_mbcnt_lo(~0u, z)); }
constexpr int N_ATT_UNITS = 2112;
__constant__ unsigned short c_unit_order[N_ATT_UNITS] = {4096, 4097, 4098, 4099, 4100, 4101, 4102, 4103, 4104, 4105, 4106, 4107, 4108, 4109, 4110, 4111, 4112, 4113, 4114, 4115, 4116, 4117, 4118, 4119, 4120, 4121, 4122, 4123, 4124, 4125, 4126, 4127, 6144, 6145, 6146, 6147, 6148, 6149, 6150, 6151, 6152, 6153, 6154, 6155, 6156, 6157, 6158, 6159, 6160, 6161, 6162, 6163, 6164, 6165, 6166, 6167, 6168, 6169, 6170, 6171, 6172, 6173, 6174, 6175, 8672, 8673, 8674, 8675, 8676, 8677, 8678, 8679, 8680, 8681, 8682, 8683, 8684, 8685, 8686, 8687, 8688, 8689, 8690, 8691, 8692, 8693, 8694, 8695, 8696, 8697, 8698, 8699, 8700, 8701, 8702, 8703, 8640, 8641, 8642, 8643, 8644, 8645, 8646, 8647, 8648, 8649, 8650, 8651, 8652, 8653, 8654, 8655, 8656, 8657, 8658, 8659, 8660, 8661, 8662, 8663, 8664, 8665, 8666, 8667, 8668, 8669, 8670, 8671, 8608, 8609, 8610, 8611, 8612, 8613, 8614, 8615, 8616, 8617, 8618, 8619, 8620, 8621, 8622, 8623, 8624, 8625, 8626, 8627, 8628, 8629, 8630, 8631, 8632, 8633, 8634, 8635, 8636, 8637, 8638, 8639, 8576, 8577, 8578, 8579, 8580, 8581, 8582, 8583, 8584, 8585, 8586, 8587, 8588, 8589, 8590, 8591, 8592, 8593, 8594, 8595, 8596, 8597, 8598, 8599, 8600, 8601, 8602, 8603, 8604, 8605, 8606, 8607, 8544, 8545, 8546, 8547, 8548, 8549, 8550, 8551, 8552, 8553, 8554, 8555, 8556, 8557, 8558, 8559, 8560, 8561, 8562, 8563, 8564, 8565, 8566, 8567, 8568, 8569, 8570, 8571, 8572, 8573, 8574, 8575, 8512, 8513, 8514, 8515, 8516, 8517, 8518, 8519, 8520, 8521, 8522, 8523, 8524, 8525, 8526, 8527, 8528, 8529, 8530, 8531, 8532, 8533, 8534, 8535, 8536, 8537, 8538, 8539, 8540, 8541, 8542, 8543, 8480, 8481, 8482, 8483, 8484, 8485, 8486, 8487, 8488, 8489, 8490, 8491, 8492, 8493, 8494, 8495, 8496, 8497, 8498, 8499, 8500, 8501, 8502, 8503, 8504, 8505, 8506, 8507, 8508, 8509, 8510, 8511, 8448, 8449, 8450, 8451, 8452, 8453, 8454, 8455, 8456, 8457, 8458, 8459, 8460, 8461, 8462, 8463, 8464, 8465, 8466, 8467, 8468, 8469, 8470, 8471, 8472, 8473, 8474, 8475, 8476, 8477, 8478, 8479, 480, 481, 482, 483, 484, 485, 486, 487, 488, 489, 490, 491, 492, 493, 494, 495, 496, 497, 498, 499, 500, 501, 502, 503, 504, 505, 506, 507, 508, 509, 510, 511, 448, 449, 450, 451, 452, 453, 454, 455, 456, 457, 458, 459, 460, 461, 462, 463, 464, 465, 466, 467, 468, 469, 470, 471, 472, 473, 474, 475, 476, 477, 478, 479, 416, 417, 418, 419, 420, 421, 422, 423, 424, 425, 426, 427, 428, 429, 430, 431, 432, 433, 434, 435, 436, 437, 438, 439, 440, 441, 442, 443, 444, 445, 446, 447, 384, 385, 386, 387, 388, 389, 390, 391, 392, 393, 394, 395, 396, 397, 398, 399, 400, 401, 402, 403, 404, 405, 406, 407, 408, 409, 410, 411, 412, 413, 414, 415, 352, 353, 354, 355, 356, 357, 358, 359, 360, 361, 362, 363, 364, 365, 366, 367, 368, 369, 370, 371, 372, 373, 374, 375, 376, 377, 378, 379, 380, 381, 382, 383, 320, 321, 322, 323, 324, 325, 326, 327, 328, 329, 330, 331, 332, 333, 334, 335, 336, 337, 338, 339, 340, 341, 342, 343, 344, 345, 346, 347, 348, 349, 350, 351, 288, 289, 290, 291, 292, 293, 294, 295, 296, 297, 298, 299, 300, 301, 302, 303, 304, 305, 306, 307, 308, 309, 310, 311, 312, 313, 314, 315, 316, 317, 318, 319, 256, 257, 258, 259, 260, 261, 262, 263, 264, 265, 266, 267, 268, 269, 270, 271, 272, 273, 274, 275, 276, 277, 278, 279, 280, 281, 282, 283, 284, 285, 286, 287, 224, 225, 226, 227, 228, 229, 230, 231, 232, 233, 234, 235, 236, 237, 238, 239, 240, 241, 242, 243, 244, 245, 246, 247, 248, 249, 250, 251, 252, 253, 254, 255, 192, 193, 194, 195, 196, 197, 198, 199, 200, 201, 202, 203, 204, 205, 206, 207, 208, 209, 210, 211, 212, 213, 214, 215, 216, 217, 218, 219, 220, 221, 222, 223, 160, 161, 162, 163, 164, 165, 166, 167, 168, 169, 170, 171, 172, 173, 174, 175, 176, 177, 178, 179, 180, 181, 182, 183, 184, 185, 186, 187, 188, 189, 190, 191, 128, 129, 130, 131, 132, 133, 134, 135, 136, 137, 138, 139, 140, 141, 142, 143, 144, 145, 146, 147, 148, 149, 150, 151, 152, 153, 154, 155, 156, 157, 158, 159, 96, 97, 98, 99, 100, 101, 102, 103, 104, 105, 106, 107, 108, 109, 110, 111, 112, 113, 114, 115, 116, 117, 118, 119, 120, 121, 122, 123, 124, 125, 126, 127, 64, 65, 66, 67, 68, 69, 70, 71, 72, 73, 74, 75, 76, 77, 78, 79, 80, 81, 82, 83, 84, 85, 86, 87, 88, 89, 90, 91, 92, 93, 94, 95, 32, 33, 34, 35, 36, 37, 38, 39, 40, 41, 42, 43, 44, 45, 46, 47, 48, 49, 50, 51, 52, 53, 54, 55, 56, 57, 58, 59, 60, 61, 62, 63, 0, 1, 2, 3, 4, 5, 6, 7, 8, 9, 10, 11, 12, 13, 14, 15, 16, 17, 18, 19, 20, 21, 22, 23, 24, 25, 26, 27, 28, 29, 30, 31, 4064, 4065, 4066, 4067, 4068, 4069, 4070, 4071, 4072, 4073, 4074, 4075, 4076, 4077, 4078, 4079, 4032, 4033, 4034, 4035, 4036, 4037, 4038, 4039, 4040, 4041, 4042, 4043, 4044, 4045, 4046, 4047, 4000, 4001, 4002, 4003, 4004, 4005, 4006, 4007, 4008, 4009, 4010, 4011, 4012, 4013, 4014, 4015, 3968, 3969, 3970, 3971, 3972, 3973, 3974, 3975, 3976, 3977, 3978, 3979, 3980, 3981, 3982, 3983, 3936, 3937, 3938, 3939, 3940, 3941, 3942, 3943, 3944, 3945, 3946, 3947, 3948, 3949, 3950, 3951, 3904, 3905, 3906, 3907, 3908, 3909, 3910, 3911, 3912, 3913, 3914, 3915, 3916, 3917, 3918, 3919, 3872, 3873, 3874, 3875, 3876, 3877, 3878, 3879, 3880, 3881, 3882, 3883, 3884, 3885, 3886, 3887, 3840, 3841, 3842, 3843, 3844, 3845, 3846, 3847, 3848, 3849, 3850, 3851, 3852, 3853, 3854, 3855, 3808, 3809, 3810, 3811, 3812, 3813, 3814, 3815, 3816, 3817, 3818, 3819, 3820, 3821, 3822, 3823, 3776, 3777, 3778, 3779, 3780, 3781, 3782, 3783, 3784, 3785, 3786, 3787, 3788, 3789, 3790, 3791, 3744, 3745, 3746, 3747, 3748, 3749, 3750, 3751, 3752, 3753, 3754, 3755, 3756, 3757, 3758, 3759, 3712, 3713, 3714, 3715, 3716, 3717, 3718, 3719, 3720, 3721, 3722, 3723, 3724, 3725, 3726, 3727, 3680, 3681, 3682, 3683, 3684, 3685, 3686, 3687, 3688, 3689, 3690, 3691, 3692, 3693, 3694, 3695, 3648, 3649, 3650, 3651, 3652, 3653, 3654, 3655, 3656, 3657, 3658, 3659, 3660, 3661, 3662, 3663, 3616, 3617, 3618, 3619, 3620, 3621, 3622, 3623, 3624, 3625, 3626, 3627, 3628, 3629, 3630, 3631, 3584, 3585, 3586, 3587, 3588, 3589, 3590, 3591, 3592, 3593, 3594, 3595, 3596, 3597, 3598, 3599, 3552, 3553, 3554, 3555, 3556, 3557, 3558, 3559, 3560, 3561, 3562, 3563, 3564, 3565, 3566, 3567, 3520, 3521, 3522, 3523, 3524, 3525, 3526, 3527, 3528, 3529, 3530, 3531, 3532, 3533, 3534, 3535, 3488, 3489, 3490, 3491, 3492, 3493, 3494, 3495, 3496, 3497, 3498, 3499, 3500, 3501, 3502, 3503, 3456, 3457, 3458, 3459, 3460, 3461, 3462, 3463, 3464, 3465, 3466, 3467, 3468, 3469, 3470, 3471, 3424, 3425, 3426, 3427, 3428, 3429, 3430, 3431, 3432, 3433, 3434, 3435, 3436, 3437, 3438, 3439, 3392, 3393, 3394, 3395, 3396, 3397, 3398, 3399, 3400, 3401, 3402, 3403, 3404, 3405, 3406, 3407, 3360, 3361, 3362, 3363, 3364, 3365, 3366, 3367, 3368, 3369, 3370, 3371, 3372, 3373, 3374, 3375, 3328, 3329, 3330, 3331, 3332, 3333, 3334, 3335, 3336, 3337, 3338, 3339, 3340, 3341, 3342, 3343, 3296, 3297, 3298, 3299, 3300, 3301, 3302, 3303, 3304, 3305, 3306, 3307, 3308, 3309, 3310, 3311, 3264, 3265, 3266, 3267, 3268, 3269, 3270, 3271, 3272, 3273, 3274, 3275, 3276, 3277, 3278, 3279, 3232, 3233, 3234, 3235, 3236, 3237, 3238, 3239, 3240, 3241, 3242, 3243, 3244, 3245, 3246, 3247, 3200, 3201, 3202, 3203, 3204, 3205, 3206, 3207, 3208, 3209, 3210, 3211, 3212, 3213, 3214, 3215, 3168, 3169, 3170, 3171, 3172, 3173, 3174, 3175, 3176, 3177, 3178, 3179, 3180, 3181, 3182, 3183, 3136, 3137, 3138, 3139, 3140, 3141, 3142, 3143, 3144, 3145, 3146, 3147, 3148, 3149, 3150, 3151, 3104, 3105, 3106, 3107, 3108, 3109, 3110, 3111, 3112, 3113, 3114, 3115, 3116, 3117, 3118, 3119, 3072, 3073, 3074, 3075, 3076, 3077, 3078, 3079, 3080, 3081, 3082, 3083, 3084, 3085, 3086, 3087, 3040, 3041, 3042, 3043, 3044, 3045, 3046, 3047, 3048, 3049, 3050, 3051, 3052, 3053, 3054, 3055, 3008, 3009, 3010, 3011, 3012, 3013, 3014, 3015, 3016, 3017, 3018, 3019, 3020, 3021, 3022, 3023, 2976, 2977, 2978, 2979, 2980, 2981, 2982, 2983, 2984, 2985, 2986, 2987, 2988, 2989, 2990, 2991, 2944, 2945, 2946, 2947, 2948, 2949, 2950, 2951, 2952, 2953, 2954, 2955, 2956, 2957, 2958, 2959, 2912, 2913, 2914, 2915, 2916, 2917, 2918, 2919, 2920, 2921, 2922, 2923, 2924, 2925, 2926, 2927, 2880, 2881, 2882, 2883, 2884, 2885, 2886, 2887, 2888, 2889, 2890, 2891, 2892, 2893, 2894, 2895, 2848, 2849, 2850, 2851, 2852, 2853, 2854, 2855, 2856, 2857, 2858, 2859, 2860, 2861, 2862, 2863, 2816, 2817, 2818, 2819, 2820, 2821, 2822, 2823, 2824, 2825, 2826, 2827, 2828, 2829, 2830, 2831, 2784, 2785, 2786, 2787, 2788, 2789, 2790, 2791, 2792, 2793, 2794, 2795, 2796, 2797, 2798, 2799, 2752, 2753, 2754, 2755, 2756, 2757, 2758, 2759, 2760, 2761, 2762, 2763, 2764, 2765, 2766, 2767, 2720, 2721, 2722, 2723, 2724, 2725, 2726, 2727, 2728, 2729, 2730, 2731, 2732, 2733, 2734, 2735, 2688, 2689, 2690, 2691, 2692, 2693, 2694, 2695, 2696, 2697, 2698, 2699, 2700, 2701, 2702, 2703, 2656, 2657, 2658, 2659, 2660, 2661, 2662, 2663, 2664, 2665, 2666, 2667, 2668, 2669, 2670, 2671, 2624, 2625, 2626, 2627, 2628, 2629, 2630, 2631, 2632, 2633, 2634, 2635, 2636, 2637, 2638, 2639, 2592, 2593, 2594, 2595, 2596, 2597, 2598, 2599, 2600, 2601, 2602, 2603, 2604, 2605, 2606, 2607, 2560, 2561, 2562, 2563, 2564, 2565, 2566, 2567, 2568, 2569, 2570, 2571, 2572, 2573, 2574, 2575, 2528, 2529, 2530, 2531, 2532, 2533, 2534, 2535, 2536, 2537, 2538, 2539, 2540, 2541, 2542, 2543, 2496, 2497, 2498, 2499, 2500, 2501, 2502, 2503, 2504, 2505, 2506, 2507, 2508, 2509, 2510, 2511, 2464, 2465, 2466, 2467, 2468, 2469, 2470, 2471, 2472, 2473, 2474, 2475, 2476, 2477, 2478, 2479, 2432, 2433, 2434, 2435, 2436, 2437, 2438, 2439, 2440, 2441, 2442, 2443, 2444, 2445, 2446, 2447, 2400, 2401, 2402, 2403, 2404, 2405, 2406, 2407, 2408, 2409, 2410, 2411, 2412, 2413, 2414, 2415, 2368, 2369, 2370, 2371, 2372, 2373, 2374, 2375, 2376, 2377, 2378, 2379, 2380, 2381, 2382, 2383, 2336, 2337, 2338, 2339, 2340, 2341, 2342, 2343, 2344, 2345, 2346, 2347, 2348, 2349, 2350, 2351, 2304, 2305, 2306, 2307, 2308, 2309, 2310, 2311, 2312, 2313, 2314, 2315, 2316, 2317, 2318, 2319, 2272, 2273, 2274, 2275, 2276, 2277, 2278, 2279, 2280, 2281, 2282, 2283, 2284, 2285, 2286, 2287, 2240, 2241, 2242, 2243, 2244, 2245, 2246, 2247, 2248, 2249, 2250, 2251, 2252, 2253, 2254, 2255, 2208, 2209, 2210, 2211, 2212, 2213, 2214, 2215, 2216, 2217, 2218, 2219, 2220, 2221, 2222, 2223, 2176, 2177, 2178, 2179, 2180, 2181, 2182, 2183, 2184, 2185, 2186, 2187, 2188, 2189, 2190, 2191, 2144, 2145, 2146, 2147, 2148, 2149, 2150, 2151, 2152, 2153, 2154, 2155, 2156, 2157, 2158, 2159, 2112, 2113, 2114, 2115, 2116, 2117, 2118, 2119, 2120, 2121, 2122, 2123, 2124, 2125, 2126, 2127, 2080, 2081, 2082, 2083, 2084, 2085, 2086, 2087, 2088, 2089, 2090, 2091, 2092, 2093, 2094, 2095, 2048, 2049, 2050, 2051, 2052, 2053, 2054, 2055, 2056, 2057, 2058, 2059, 2060, 2061, 2062, 2063, 8416, 8417, 8418, 8419, 8420, 8421, 8422, 8423, 8424, 8425, 8426, 8427, 8428, 8429, 8430, 8431, 8432, 8433, 8434, 8435, 8436, 8437, 8438, 8439, 8440, 8441, 8442, 8443, 8444, 8445, 8446, 8447, 8384, 8385, 8386, 8387, 8388, 8389, 8390, 8391, 8392, 8393, 8394, 8395, 8396, 8397, 8398, 8399, 8400, 8401, 8402, 8403, 8404, 8405, 8406, 8407, 8408, 8409, 8410, 8411, 8412, 8413, 8414, 8415, 8352, 8353, 8354, 8355, 8356, 8357, 8358, 8359, 8360, 8361, 8362, 8363, 8364, 8365, 8366, 8367, 8368, 8369, 8370, 8371, 8372, 8373, 8374, 8375, 8376, 8377, 8378, 8379, 8380, 8381, 8382, 8383, 8320, 8321, 8322, 8323, 8324, 8325, 8326, 8327, 8328, 8329, 8330, 8331, 8332, 8333, 8334, 8335, 8336, 8337, 8338, 8339, 8340, 8341, 8342, 8343, 8344, 8345, 8346, 8347, 8348, 8349, 8350, 8351, 8288, 8289, 8290, 8291, 8292, 8293, 8294, 8295, 8296, 8297, 8298, 8299, 8300, 8301, 8302, 8303, 8304, 8305, 8306, 8307, 8308, 8309, 8310, 8311, 8312, 8313, 8314, 8315, 8316, 8317, 8318, 8319, 8256, 8257, 8258, 8259, 8260, 8261, 8262, 8263, 8264, 8265, 8266, 8267, 8268, 8269, 8270, 8271, 8272, 8273, 8274, 8275, 8276, 8277, 8278, 8279, 8280, 8281, 8282, 8283, 8284, 8285, 8286, 8287, 8224, 8225, 8226, 8227, 8228, 8229, 8230, 8231, 8232, 8233, 8234, 8235, 8236, 8237, 8238, 8239, 8240, 8241, 8242, 8243, 8244, 8245, 8246, 8247, 8248, 8249, 8250, 8251, 8252, 8253, 8254, 8255, 8192, 8193, 8194, 8195, 8196, 8197, 8198, 8199, 8200, 8201, 8202, 8203, 8204, 8205, 8206, 8207, 8208, 8209, 8210, 8211, 8212, 8213, 8214, 8215, 8216, 8217, 8218, 8219, 8220, 8221, 8222, 8223};
#if PROBE_TIME
#define TBEG(K, Lp, widv) do { if (PROBE_TIME == (K) && (widv) == 0) *(__attribute__((address_space(3))) long long*)((Lp) + 157184 + 24) = clock64(); } while (0)
#define TEND(K, Lp, widv) do { if (PROBE_TIME == (K) && (widv) == 0) { const long long d_ = clock64() - *(__attribute__((address_space(3))) long long*)((Lp) + 157184 + 24); if (olane() == 0) *(__attribute__((address_space(3))) long long*)((Lp) + 157184 + 16) += d_; } } while (0)
#else
#define TBEG(K, Lp, widv) do {} while (0)
#define TEND(K, Lp, widv) do {} while (0)
#endif
#define LAS __attribute__((address_space(3)))
#define XB_TMO      128
#define XB_XCNT(j)  (256  + 64 * (j))
#define XB_XSUB(j)  (1280 + 64 * (j))
#define XB_XGEN(j)  (2304 + 64 * (j))
#define XB_TOP      3328
#define XB_TOPGEN   3392
#define XCD_BAR_WORDS 3456
#define XB_SPIN_CAP (1u << 18)

__device__ __forceinline__ unsigned xb_ld(unsigned* p)              { return __hip_atomic_load(p, __ATOMIC_RELAXED, __HIP_MEMORY_SCOPE_AGENT); }
__device__ __forceinline__ unsigned xb_add(unsigned* p, unsigned v) { return __hip_atomic_fetch_add(p, v, __ATOMIC_RELAXED, __HIP_MEMORY_SCOPE_AGENT); }
__device__ __forceinline__ unsigned xb_xcc_id() { return (unsigned)__builtin_amdgcn_s_getreg((3 << 11) | 20) & 0xFu; }
#define XB_SPIN(cond, bar) do { unsigned _sp = 0; while (cond) { __builtin_amdgcn_s_sleep(1); \
    if ((++_sp & 255u) == 0u) { if (xb_ld(&(bar)[XB_TMO])) break; if (_sp > XB_SPIN_CAP) { atomicAdd(&(bar)[XB_TMO], 1u); break; } } } } while (0)

struct XcdBarrier {
    unsigned* bar; unsigned x;
    volatile LAS unsigned* st;
};

__device__ __forceinline__ XcdBarrier xcd_barrier_post(unsigned* bar, volatile LAS unsigned* st) {
    XcdBarrier b; b.bar = bar; b.x = xb_xcc_id(); b.st = st;
    if (threadIdx.x == 0) (void)xb_add(&bar[XB_XCNT(b.x)], 1u);
    return b;
}
__device__ __forceinline__ void xcd_barrier_complete(unsigned* bar, unsigned x, unsigned& nloc, unsigned& nx) {
    const unsigned G = gridDim.x * gridDim.y * gridDim.z;
    unsigned sum, cnt, mine, sp = 0u;
    for (;;) {
        sum = 0u; cnt = 0u; mine = 0u;
#pragma unroll
        for (unsigned j = 0; j < 16; ++j) { const unsigned c = xb_ld(&bar[XB_XCNT(j)]); sum += c; cnt += (c > 0u) ? 1u : 0u; mine = (j == x) ? c : mine; }
        if (sum == G) break;
        __builtin_amdgcn_s_sleep(1);
        if ((++sp & 255u) == 0u) { if (xb_ld(&bar[XB_TMO])) break; if (sp > XB_SPIN_CAP) { atomicAdd(&bar[XB_TMO], 1u); break; } }
    }
    nloc = mine > 0u ? mine : 1u; nx = cnt > 0u ? cnt : 1u;
}

__device__ __forceinline__ void xcd_barrier(const XcdBarrier& b) {
    asm volatile("s_waitcnt vmcnt(0)" ::: "memory");
    __syncthreads();
    if (threadIdx.x == 0) {
        unsigned* bar = b.bar; asm volatile("" : "+s"(bar));
        const unsigned bx = xb_xcc_id();
        __builtin_amdgcn_s_waitcnt(0);
        unsigned nloc = b.st[0], nx = b.st[1];
        if (nloc == 0u) { xcd_barrier_complete(bar, bx, nloc, nx); b.st[0] = nloc; b.st[1] = nx; }
        const unsigned old = xb_add(&bar[XB_XSUB(bx)], 1u);
        const unsigned gen = old / nloc;
        if (old + 1u == (gen + 1u) * nloc) {
            __builtin_amdgcn_fence(__ATOMIC_RELEASE, "agent");
            asm volatile("s_waitcnt vmcnt(0)" ::: "memory");
            const unsigned og = xb_add(&bar[XB_TOP], 1u);
            const unsigned tg = og / nx;
            if (og + 1u == (tg + 1u) * nx) xb_add(&bar[XB_TOPGEN], 1u);
            else XB_SPIN(xb_ld(&bar[XB_TOPGEN]) == tg, bar);
            __builtin_amdgcn_fence(__ATOMIC_ACQUIRE, "agent");
            xb_add(&bar[XB_XGEN(bx)], 1u);
            asm volatile("s_waitcnt vmcnt(0)" ::: "memory");
        } else {
            XB_SPIN(xb_ld(&bar[XB_XGEN(bx)]) == gen, bar);
            __builtin_amdgcn_fence(__ATOMIC_ACQUIRE, "agent");
            asm volatile("s_waitcnt vmcnt(0)" ::: "memory");
        }
    }
    __syncthreads();
}


namespace pg8 {
#define PG8_LAS __attribute__((address_space(3)))
typedef unsigned short bf16_t;
typedef short bf16x8 __attribute__((ext_vector_type(8)));
typedef float f32x4 __attribute__((ext_vector_type(4)));
typedef unsigned u32x4 __attribute__((ext_vector_type(4)));
constexpr int BM = 256, BK = 64, HALF = 128, HTB = HALF * BK * 2  , STAGE_BYTES = 8 * HTB, NXCD = 8, WGM = 8;

__host__ __device__ __forceinline__ int lds_byte(int r, int c) { const int st = (r >> 4) * 2 + (c >> 5), rr = r & 15, cc = c & 31, ob = rr * 64 + cc * 2; return st * 1024 + (ob ^ (((ob >> 9) & 1) << 5)); }
__host__ __device__ __forceinline__ void stage_rc(int b, int& R, int& C) { const int st = b / 1024, sb = b % 1024, swz = sb ^ (((sb >> 9) & 1) << 5); R = (st >> 1) * 16 + swz / 64; C = (st & 1) * 32 + (swz % 64) / 2; }
__host__ __device__ __forceinline__ int perm32(int rho) { const int n = rho >> 4, i = rho & 15; return 8 * (i >> 2) + 4 * n + (i & 3); }

struct Unit { int pm, pn; };
struct Gemm { const bf16_t* A; const bf16_t* Bt; int M, N, K, lda, ldb; };

struct StaticOrder {
    int nM, nN, nwg, G, c;
    __host__ __device__ void init(int M, int N, int G_, int c_) { nM = M / BM; nN = N / BM; nwg = nM * nN; G = G_; c = c_; }
    __host__ __device__ bool next(int i, Unit& u) const {
        const long L = (long)i * G + c; if (L >= nwg) return false;
        int wgid = (int)L; { const int q = nwg / NXCD, r = nwg % NXCD, xcd = wgid % NXCD, off = wgid / NXCD; wgid = (xcd < r ? xcd * (q + 1) : r * (q + 1) + (xcd - r) * q) + off; }
        const int nig = WGM * nN, gid = wgid / nig, fm = gid * WGM, gsz = (nM - fm) < WGM ? (nM - fm) : WGM;
        u.pm = fm + ((wgid % nig) % gsz); u.pn = (wgid % nig) / gsz; return true;
    }
    __device__ __forceinline__ void a_ready(const Unit&) const {}
    __device__ __forceinline__ void done(const Unit&) const {}
};


template <class Epi, class Sched, bool ALIGN_EPI = false, bool SP2 = false>
__device__ __forceinline__ void gemm_phase(PG8_LAS unsigned char* lds, const Gemm g, const Sched& S, const Epi& E, int wid0) {
    const int tid = otid(wid0), wid = __builtin_amdgcn_readfirstlane(tid >> 6), lane = tid & 63, wr = wid >> 2, wc = wid & 3, fr = lane & 15, fq = lane >> 4;
    const int K = g.K, nt = K / BK;
    unsigned voffA[2], voffB[2];
#pragma unroll
    for (int i = 0; i < 2; ++i) { int R, C; stage_rc(tid * 16 + i * 8192, R, C); const int Rb = Epi::PERM ? ((R & ~31) + perm32(R & 31)) : R;
        voffA[i] = (unsigned)(R * g.lda + C) * 2u; voffB[i] = (unsigned)(Rb * g.ldb + C) * 2u; }
    const size_t kstep = (size_t)(BK * 2);
    const size_t hstepA = (size_t)HALF * g.lda * 2, hstepB = (size_t)HALF * g.ldb * 2;
    const size_t tstepA = 2 * hstepA, tstepB = 2 * hstepB;
    const unsigned ldsw = (unsigned)wid * 1024u;
    const int aoff = lds_byte(wr * 64 + fr, fq * 8), boff = lds_byte(wc * 32 + fr, fq * 8);
#define PG8_SA(b, h) (((b) * 2 + (h)) * HTB)
#define PG8_SB(b, h) ((4 + (b) * 2 + (h)) * HTB)
#define PG8_STAGE(bufoff, gbase, voff) do { _Pragma("unroll") for (int _i = 0; _i < 2; ++_i) \
        __builtin_amdgcn_global_load_lds((const unsigned*)((const char*)(gbase) + (voff)[_i]), (PG8_LAS unsigned*)(lds + (bufoff) + ldsw + _i * 8192), 16, 0, 0); } while (0)
#define PG8_LDA(dst, b, h) do { _Pragma("unroll") for (int m = 0; m < 4; ++m) _Pragma("unroll") for (int k = 0; k < 2; ++k) dst[m][k] = *(const PG8_LAS bf16x8*)(lds + PG8_SA(b, h) + aoff + m * 2048 + k * 1024); } while (0)
#define PG8_LDB(dst, b, h) do { _Pragma("unroll") for (int n = 0; n < 2; ++n) _Pragma("unroll") for (int k = 0; k < 2; ++k) dst[n][k] = *(const PG8_LAS bf16x8*)(lds + PG8_SB(b, h) + boff + n * 2048 + k * 1024); } while (0)
#define PG8_MMA(ai, bj, At, Bt) do { __builtin_amdgcn_s_setprio(1); _Pragma("unroll") for (int m = 0; m < 4; ++m) _Pragma("unroll") for (int n = 0; n < 2; ++n) _Pragma("unroll") for (int k = 0; k < 2; ++k) \
        acc[ai][bj][m][n] = __builtin_amdgcn_mfma_f32_16x16x32_bf16(Bt[n][k], At[m][k], acc[ai][bj][m][n], 0, 0, 0); __builtin_amdgcn_s_setprio(0); } while (0)
#define PG8_WAIT_V(n) asm volatile("s_waitcnt vmcnt(" #n ")" ::: "memory")
#define PG8_WAIT_L(n) asm volatile("s_waitcnt lgkmcnt(" #n ")" ::: "memory")
#define PG8_BAR __builtin_amdgcn_s_barrier()
#define PG8_SCHED __builtin_amdgcn_sched_barrier(0)
    Unit cur, nxt; int ui = 0;
    if (!S.next(0, cur)) return;
    f32x4 acc[2][2][4][2];
#pragma unroll
    for (int a = 0; a < 2; ++a)
#pragma unroll
        for (int b = 0; b < 2; ++b)
#pragma unroll
            for (int m = 0; m < 4; ++m)
#pragma unroll
                for (int n = 0; n < 2; ++n) acc[a][b][m][n] = (f32x4){0.f, 0.f, 0.f, 0.f};
    bf16x8 At[4][2], B0[2][2], B1[2][2];
    float pre[Epi::NPRE > 0 ? Epi::NPRE : 1];
    const char* cA = (const char*)g.A + (size_t)cur.pm * tstepA; const char* cB = (const char*)g.Bt + (size_t)cur.pn * tstepB;
    S.a_ready(cur);
    if constexpr (Epi::NPRE > 0) E.preload(cur, wr, fr, pre);
    if constexpr (SP2) {
        PG8_STAGE(PG8_SB(0, 0), cB, voffB); PG8_STAGE(PG8_SB(0, 1), cB + hstepB, voffB); PG8_STAGE(PG8_SA(0, 0), cA, voffA); PG8_STAGE(PG8_SA(0, 1), cA + hstepA, voffA);
        if (wr == 1) PG8_BAR;
        PG8_WAIT_V(2); PG8_BAR;
        PG8_STAGE(PG8_SB(1, 0), cB + kstep, voffB); PG8_STAGE(PG8_SA(1, 0), cA + kstep, voffA); PG8_STAGE(PG8_SB(1, 1), cB + hstepB + kstep, voffB);
        PG8_WAIT_V(6); PG8_BAR;
    } else {
        PG8_STAGE(PG8_SB(0, 0), cB, voffB); PG8_STAGE(PG8_SA(0, 0), cA, voffA); PG8_STAGE(PG8_SB(0, 1), cB + hstepB, voffB); PG8_STAGE(PG8_SA(0, 1), cA + hstepA, voffA);
        if (wr == 1) PG8_BAR;
        PG8_WAIT_V(4); PG8_BAR;
        PG8_STAGE(PG8_SB(1, 0), cB + kstep, voffB); PG8_STAGE(PG8_SA(1, 0), cA + kstep, voffA); PG8_STAGE(PG8_SB(1, 1), cB + hstepB + kstep, voffB);
        PG8_WAIT_V(6); PG8_BAR;
    }
    for (;;) {
        const bool has_next = S.next(ui + 1, nxt);
        const char* nA = has_next ? (const char*)g.A + (size_t)nxt.pm * tstepA : cA; const char* nB = has_next ? (const char*)g.Bt + (size_t)nxt.pn * tstepB : cB;
        for (int t = 0; t < nt; t += 2) {
            const bool last = (t == nt - 2);
            const char* a1 = cA + (size_t)(t + 1) * kstep;
            const char* a2 = last ? nA : cA + (size_t)(t + 2) * kstep; const char* b2 = last ? nB : cB + (size_t)(t + 2) * kstep;
            const char* a3 = a2 + kstep; const char* b3 = b2 + kstep;
            if (last && has_next) S.a_ready(nxt);
            if constexpr (SP2) {
            PG8_LDB(B0, 0, 0); PG8_LDB(B1, 0, 1); PG8_SCHED; PG8_LDA(At, 0, 0); PG8_STAGE(PG8_SA(1, 1), a1 + hstepA, voffA);
            PG8_WAIT_V(8); PG8_WAIT_L(0); PG8_BAR; PG8_MMA(0, 0, At, B0); PG8_MMA(0, 1, At, B1); PG8_BAR; PG8_SCHED;
            PG8_LDA(At, 0, 1); PG8_STAGE(PG8_SB(0, 0), b2, voffB); PG8_STAGE(PG8_SB(0, 1), b2 + hstepB, voffB); PG8_STAGE(PG8_SA(0, 0), a2, voffA);
            PG8_WAIT_V(8); PG8_WAIT_L(0); PG8_BAR; PG8_MMA(1, 0, At, B0); PG8_MMA(1, 1, At, B1); PG8_BAR; PG8_SCHED;
            PG8_LDB(B0, 1, 0); PG8_LDB(B1, 1, 1); PG8_SCHED; PG8_LDA(At, 1, 0); PG8_STAGE(PG8_SA(0, 1), a2 + hstepA, voffA);
            PG8_WAIT_V(8); PG8_WAIT_L(0); PG8_BAR; PG8_MMA(0, 0, At, B0); PG8_MMA(0, 1, At, B1); PG8_BAR; PG8_SCHED;
            PG8_LDA(At, 1, 1); PG8_STAGE(PG8_SB(1, 0), b3, voffB); PG8_STAGE(PG8_SB(1, 1), b3 + hstepB, voffB); PG8_STAGE(PG8_SA(1, 0), a3, voffA);
            PG8_WAIT_V(8); PG8_WAIT_L(0); PG8_BAR; PG8_MMA(1, 0, At, B0); PG8_MMA(1, 1, At, B1); PG8_BAR; PG8_SCHED;
            } else {
            PG8_LDB(B0, 0, 0); PG8_SCHED; PG8_LDA(At, 0, 0); PG8_STAGE(PG8_SA(1, 1), a1 + hstepA, voffA);
            PG8_WAIT_L(8); PG8_BAR; PG8_WAIT_L(0); PG8_MMA(0, 0, At, B0); PG8_BAR; PG8_SCHED;
            PG8_LDB(B1, 0, 1); PG8_STAGE(PG8_SB(0, 0), b2, voffB);
            PG8_BAR; PG8_WAIT_L(0); PG8_MMA(0, 1, At, B1); PG8_BAR;
            PG8_LDA(At, 0, 1); PG8_STAGE(PG8_SA(0, 0), a2, voffA);
            PG8_BAR; PG8_WAIT_L(0); PG8_MMA(1, 0, At, B0); PG8_BAR; PG8_SCHED;
            PG8_STAGE(PG8_SB(0, 1), b2 + hstepB, voffB);
            PG8_WAIT_V(6); PG8_BAR; PG8_MMA(1, 1, At, B1); PG8_BAR;
            PG8_LDB(B0, 1, 0); PG8_SCHED; PG8_LDA(At, 1, 0); PG8_STAGE(PG8_SA(0, 1), a2 + hstepA, voffA);
            PG8_WAIT_L(8); PG8_BAR; PG8_WAIT_L(0); PG8_MMA(0, 0, At, B0); PG8_BAR; PG8_SCHED;
            PG8_LDB(B1, 1, 1); PG8_STAGE(PG8_SB(1, 0), b3, voffB);
            PG8_BAR; PG8_WAIT_L(0); PG8_MMA(0, 1, At, B1); PG8_BAR;
            PG8_LDA(At, 1, 1); PG8_STAGE(PG8_SA(1, 0), a3, voffA);
            PG8_BAR; PG8_WAIT_L(0); PG8_MMA(1, 0, At, B0); PG8_BAR; PG8_SCHED;
            PG8_STAGE(PG8_SB(1, 1), b3 + hstepB, voffB);
            PG8_WAIT_V(6); PG8_BAR; PG8_MMA(1, 1, At, B1); PG8_BAR;
            }
        }
        if constexpr (ALIGN_EPI) { if (wr == 0) PG8_BAR; }
        if constexpr (Epi::NPRE > 0) { E(acc, cur, wr, wc, fr, fq, pre); S.done(cur); }
        else if constexpr (!Epi::AFTER_DRAIN) { E(acc, cur, wr, wc, fr, fq); S.done(cur); }
        if (!has_next) break;
#pragma unroll
        for (int a = 0; a < 2; ++a)
#pragma unroll
            for (int b = 0; b < 2; ++b)
#pragma unroll
                for (int m = 0; m < 4; ++m)
#pragma unroll
                    for (int n = 0; n < 2; ++n) acc[a][b][m][n] = (f32x4){0.f, 0.f, 0.f, 0.f};
        cur = nxt; cA = nA; cB = nB; ++ui;
        if constexpr (Epi::NPRE > 0) E.preload(cur, wr, fr, pre);
        if constexpr (ALIGN_EPI) { if (wr == 1) PG8_BAR; }
    }
    PG8_WAIT_V(0);
    if constexpr (!ALIGN_EPI) { if (wr == 0) PG8_BAR; }
    PG8_BAR;
    if constexpr (Epi::AFTER_DRAIN) { E.fused(acc, cur, wr, wc, fr, fq, lds, wid, lane); S.done(cur); }
#undef PG8_SA
#undef PG8_SB
#undef PG8_STAGE
#undef PG8_LDA
#undef PG8_LDB
#undef PG8_MMA
#undef PG8_WAIT_V
#undef PG8_WAIT_L
#undef PG8_BAR
#undef PG8_SCHED
}
}

namespace pg8 {
#define PG8_G1(T, p) ((__attribute__((address_space(1))) T*)(p))
struct EpiInProj {
    static constexpr bool PERM = true, AFTER_DRAIN = false; static constexpr int NPRE = 8;
    unsigned char* ws; const float* ss;
    __device__ __forceinline__ void preload(const Unit& u, int wr, int fr, float (&pre)[8]) const {
        const float* s = ss + (size_t)u.pm * 256 + wr * 64 + fr;
#pragma unroll
        for (int ai = 0; ai < 2; ++ai)
#pragma unroll
            for (int m = 0; m < 4; ++m) pre[ai * 4 + m] = s[ai * HALF + m * 16];
    }
    __device__ __forceinline__ void operator()(const f32x4 (&acc)[2][2][4][2], const Unit& u, int wr, int wc, int fr, int fq, const float (&pre)[8]) const {
        const int pn = u.pn;
        const int b = u.pm >> 4, t0 = (u.pm & 15) * 256 + wr * 64 + fr;
        size_t base0 = 0, base1 = 0; int mul = 64, H = 4; float sc = 1.f; int kind = 0;
        int W = 0, coff = 0;
        switch (pn) {
            case 0: base0 = base1 = WS_QA; sc = QSCALE; break;
            case 1: base0 = base1 = WS_KA; break;
            case 2: base0 = base1 = WS_VA; break;
            case 3: kind = 1; base0 = base1 = WS_ZA; W = 256; break;
            case 4: kind = 1; base0 = base1 = WS_QB; W = 512; sc = QSCALE; break;
            case 5: kind = 1; base0 = base1 = WS_QB; W = 512; coff = 256; sc = QSCALE; break;
            case 6: H = 2; base0 = WS_KC; base1 = WS_VC; break;
            case 7: H = 2; base0 = WS_KSL; base1 = WS_VSL; break;
            case 8: H = 2; base0 = WS_KWN; base1 = WS_VWN; break;
            case 9: kind = 1; base0 = base1 = WS_ZB; W = 512; break;
            case 10: kind = 1; base0 = base1 = WS_ZB; W = 512; coff = 256; break;
            case 11: base0 = base1 = WS_QC; sc = QSCALE; break;
            case 12: base0 = base1 = WS_KCF; break;
            case 13: base0 = base1 = WS_VCF; break;
            case 14: kind = 1; base0 = base1 = WS_ZC; W = 256; break;
            default: kind = 2; break;
        }
        const int chl = 32 * wc + 8 * fq;
        if (kind == 2) {
            if (wc == 0) {
                float* gf = (float*)(ws + WS_GF) + (size_t)(b * SEQ + t0) * 32 + chl;
#pragma unroll
                for (int ai = 0; ai < 2; ++ai)
#pragma unroll
                    for (int m = 0; m < 4; ++m) {
                        const int tl = ai * HALF + m * 16;
                        const float r = rsqrtf(pre[ai * 4 + m] * (1.f / DM) + 1e-6f);
                        *PG8_G1(f32x4, gf + (size_t)tl * 32) = acc[ai][0][m][0] * r;
                        *PG8_G1(f32x4, gf + (size_t)tl * 32 + 4) = acc[ai][0][m][1] * r;
                    }
            }
            return;
        }
        unsigned cst0, cst1;
        if (kind == 0) {
            mul = 64;
            if (H == 4) { cst0 = (unsigned)(((b * 4 + (chl >> 6)) * SEQ) * 64 + (chl & 63)); cst1 = (unsigned)(((b * 4 + 2 + (chl >> 6)) * SEQ) * 64 + (chl & 63)); }
            else { cst0 = cst1 = (unsigned)(((b * 2 + (chl >> 6)) * SEQ) * 64 + (chl & 63)); }
        } else {
            mul = W;
            cst0 = (unsigned)(b * SEQ) * (unsigned)W + coff + chl; cst1 = cst0 + 128;
        }
        bf16_t* d0 = (bf16_t*)(ws + base0) + cst0 + (size_t)t0 * mul;
        bf16_t* d1 = (bf16_t*)(ws + base1) + cst1 + (size_t)t0 * mul;
#pragma unroll
        for (int ai = 0; ai < 2; ++ai)
#pragma unroll
            for (int m = 0; m < 4; ++m) {
                const int tl = ai * HALF + m * 16;
                const float r = rsqrtf(pre[ai * 4 + m] * (1.f / DM) + 1e-6f) * sc;
#pragma unroll
                for (int bj = 0; bj < 2; ++bj) {
                    const f32x4 v0 = acc[ai][bj][m][0] * r, v1 = acc[ai][bj][m][1] * r;
                    u32x4 w; w.x = pk2(v0[0], v0[1]); w.y = pk2(v0[2], v0[3]); w.z = pk2(v1[0], v1[1]); w.w = pk2(v1[2], v1[3]);
                    *PG8_G1(u32x4, (bj ? d1 : d0) + (size_t)tl * mul) = w;
                }
            }
    }
};
template <bool NEXT, bool F32RES = false> struct EpiOutProj {
    static constexpr bool PERM = true, AFTER_DRAIN = false; static constexpr int NPRE = 0;
    const float* xin; bf16_t* xb; float* ss;
    __device__ __forceinline__ void operator()(f32x4 (&acc)[2][2][4][2], const Unit& u, int wr, int wc, int fr, int fq) const {
        const size_t base = (size_t)(u.pm * BM + wr * 64 + fr) * DM + (u.pn * BM + wc * 32 + 8 * fq);
        if (NEXT && F32RES) {
#pragma unroll
            for (int am = 0; am < 4; ++am) {
                const int ai = am >> 1, m0 = (am & 1) * 2;
                f32x4 r[2][2][2];
#pragma unroll
                for (int m = 0; m < 2; ++m)
#pragma unroll
                    for (int bj = 0; bj < 2; ++bj)
#pragma unroll
                        for (int n = 0; n < 2; ++n) r[m][bj][n] = __builtin_nontemporal_load(PG8_G1(const f32x4, xin + base + (size_t)(ai * HALF + (m0 + m) * 16) * DM + bj * HALF + n * 4));
#pragma unroll
                for (int m = 0; m < 2; ++m)
#pragma unroll
                    for (int bj = 0; bj < 2; ++bj)
#pragma unroll
                        for (int n = 0; n < 2; ++n) { acc[ai][bj][m0 + m][n] += r[m][bj][n]; asm volatile("" : "+v"(acc[ai][bj][m0 + m][n])); }
            }
        } else {
            u32x4 q[2][4][2];
#pragma unroll
            for (int ai = 0; ai < 2; ++ai)
#pragma unroll
                for (int m = 0; m < 4; ++m)
#pragma unroll
                    for (int bj = 0; bj < 2; ++bj) q[ai][m][bj] = __builtin_nontemporal_load(PG8_G1(const u32x4, xb + base + (size_t)(ai * HALF + m * 16) * DM + bj * HALF));
#pragma unroll
            for (int ai = 0; ai < 2; ++ai)
#pragma unroll
                for (int m = 0; m < 4; ++m)
#pragma unroll
                    for (int bj = 0; bj < 2; ++bj) {
                        const u32x4 w = q[ai][m][bj]; f32x4 r0, r1;
                        r0[0] = __uint_as_float(w.x << 16); r0[1] = __uint_as_float(w.x & 0xffff0000u); r0[2] = __uint_as_float(w.y << 16); r0[3] = __uint_as_float(w.y & 0xffff0000u);
                        r1[0] = __uint_as_float(w.z << 16); r1[1] = __uint_as_float(w.z & 0xffff0000u); r1[2] = __uint_as_float(w.w << 16); r1[3] = __uint_as_float(w.w & 0xffff0000u);
                        acc[ai][bj][m][0] += r0; acc[ai][bj][m][1] += r1;
                        asm volatile("" : "+v"(acc[ai][bj][m][0]), "+v"(acc[ai][bj][m][1]));
                    }
        }
#pragma unroll
        for (int ai = 0; ai < 2; ++ai)
#pragma unroll
            for (int m = 0; m < 4; ++m) {
                float sq = 0.f;
#pragma unroll
                for (int bj = 0; bj < 2; ++bj) {
                    const f32x4 v0 = acc[ai][bj][m][0], v1 = acc[ai][bj][m][1];
                    u32x4 w; w.x = pk2(v0[0], v0[1]); w.y = pk2(v0[2], v0[3]); w.z = pk2(v1[0], v1[1]); w.w = pk2(v1[2], v1[3]);
                    *PG8_G1(u32x4, xb + base + (size_t)(ai * HALF + m * 16) * DM + bj * HALF) = w;
                    if (NEXT) sq += ((v0[0] * v0[0] + v0[1] * v0[1]) + (v0[2] * v0[2] + v0[3] * v0[3])) + ((v1[0] * v1[0] + v1[1] * v1[1]) + (v1[2] * v1[2] + v1[3] * v1[3]));
                }
                if (NEXT) {
                    const int ln = olane();
                    sq += __int_as_float(__builtin_amdgcn_ds_bpermute((ln ^ 16) << 2, __float_as_int(sq)));
                    sq += __int_as_float(__builtin_amdgcn_ds_bpermute((ln ^ 32) << 2, __float_as_int(sq)));
                    if (fq == 0) atomicAdd(ss + (u.pm * BM + ai * HALF + wr * 64 + m * 16 + fr), sq);
                }
            }
    }
};
}

__device__ __forceinline__ int in_src_col(int n) {
    if (n < 2304) return n;
    if (n < 3584) return n + 24;
    if (n < 3840) return n + 28;
    if (n < 3864) return C_GB + (n - 3840);
    if (n < 3868) return C_FC + (n - 3864);
    return -1;
}
template <bool INMAP> __device__ __forceinline__ void transpose_item(const float* W, int ldsrc, int K, const float* scale, bf16_t* WT, int nblk, int item, float* scr, int lane) {
    const int kb = item / nblk, nb = item % nblk, k0 = 64 * kb, n0 = 32 * nb;
    const int n = n0 + (lane & 31);
    const int col = INMAP ? in_src_col(n) : n;
    float vv[32];
#pragma unroll
    for (int i = 0; i < 32; ++i) { const int kk = 2 * i + (lane >> 5); vv[i] = col >= 0 ? __builtin_nontemporal_load(W + (size_t)(k0 + kk) * ldsrc + col) : 0.f; }
    if (scale) {
#pragma unroll
        for (int i = 0; i < 32; ++i) vv[i] *= scale[k0 + 2 * i + (lane >> 5)];
    }
#pragma unroll
    for (int i = 0; i < 32; ++i) scr[(2 * i + (lane >> 5)) * 33 + (lane & 31)] = vv[i];
    asm volatile("s_waitcnt lgkmcnt(0)" ::: "memory");
    const int c8 = lane & 7;
#pragma unroll
    for (int j = 0; j < 4; ++j) {
        const int nn = (lane >> 3) + 8 * j;
        const float* s = scr + (8 * c8) * 33 + nn;
        uint4 o; o.x = pk2(s[0 * 33], s[1 * 33]); o.y = pk2(s[2 * 33], s[3 * 33]); o.z = pk2(s[4 * 33], s[5 * 33]); o.w = pk2(s[6 * 33], s[7 * 33]);
        *(uint4*)(WT + (size_t)(n0 + nn) * K + k0 + 8 * c8) = o;
    }
    asm volatile("s_waitcnt lgkmcnt(0)" ::: "memory");
}
__device__ void p0_weights(const Params& p, unsigned char* ldsg, int wid0) {
    const int tid_ = otid(wid0); const int lane = tid_ & 63, wv = tid_ >> 6;
    float* scr = (float*)ldsg + wv * (64 * 33);
    const int gw = blockIdx.x * NWAVES + wv, ngw = gridDim.x * NWAVES;
    constexpr int I_IN = (DM / 64) * (NPAD / 32), I_OUT = (DM / 64) * (DM / 32), I_W1 = (2048 / 64) * (256 / 32), I_W2 = (256 / 64) * (64 / 32);
    constexpr int TOTAL = 2 * I_IN + 2 * I_OUT + 4 * I_W1 + 4 * I_W2;
    for (int it = gw; it < TOTAL; it += ngw) {
        int r = it;
        if (r < 2 * I_IN) { const int l = r / I_IN; r %= I_IN;
            transpose_item<true>(p.w_in + (size_t)l * DM * INW, INW, DM, p.norm_g + l * DM, (bf16_t*)(p.ws + WS_WTIN) + (size_t)l * NPAD * DM, NPAD / 32, r, scr, lane); continue; }
        r -= 2 * I_IN;
        if (r < 2 * I_OUT) { const int l = r / I_OUT; r %= I_OUT;
            transpose_item<false>(p.w_out + (size_t)l * DM * DM, DM, DM, nullptr, (bf16_t*)(p.ws + WS_WTOUT) + (size_t)l * DM * DM, DM / 32, r, scr, lane); continue; }
        r -= 2 * I_OUT;
        if (r < 4 * I_W1) { const int lw = r / I_W1; r %= I_W1;
            transpose_item<false>(p.cmp_w1 + (size_t)lw * 2048 * 256, 256, 2048, nullptr, (bf16_t*)(p.ws + WS_W1T) + (size_t)lw * 256 * 2048, 256 / 32, r, scr, lane); continue; }
        r -= 4 * I_W1;
        { const int lw = r / I_W2; r %= I_W2;
            transpose_item<false>(p.cmp_w2 + (size_t)lw * 256 * 64, 64, 256, nullptr, (bf16_t*)(p.ws + WS_W2T) + (size_t)lw * 64 * 256, 64 / 32, r, scr, lane); }
    }
    for (int it = gw; it < 4 * 64; it += ngw) {
        const int lw = it >> 6, i0 = (it & 63) * 32;
        const float* w1 = p.cmp_w1 + (size_t)lw * 2048 * 256; const float* pe = p.cmp_pe + (size_t)lw * 2048;
        float a0 = 0.f, a1 = 0.f, a2 = 0.f, a3 = 0.f;
#pragma unroll 4
        for (int i = i0; i < i0 + 32; ++i) {
            const float pv = pe[i]; const float* wr_ = w1 + (size_t)i * 256 + lane;
            a0 += pv * wr_[0]; a1 += pv * wr_[64]; a2 += pv * wr_[128]; a3 += pv * wr_[192];
        }
        float* bo = (float*)(p.ws + WS_BIAS1) + lw * 256 + lane;
        atomicAdd(bo, a0); atomicAdd(bo + 64, a1); atomicAdd(bo + 128, a2); atomicAdd(bo + 192, a3);
    }
}
__device__ void phase_convert_x(const float* xin, bf16_t* xb, float* ss, int wid0) {
    xin = opq(xin); xb = opq(xb); ss = opq(ss);
    typedef unsigned u32x4_t __attribute__((ext_vector_type(4)));
    const int tid_ = otid(wid0); const int lane = tid_ & 63, wv = tid_ >> 6;
    const int gw = blockIdx.x * NWAVES + wv, ngw = gridDim.x * NWAVES;
    for (int r0 = gw * 4; r0 < MTOK; r0 += ngw * 4) {
        typedef float f32x4_t __attribute__((ext_vector_type(4)));
        f32x4_t v[4][4];
#pragma unroll
        for (int q = 0; q < 4; ++q)
#pragma unroll
            for (int j = 0; j < 4; ++j) v[q][j] = __builtin_nontemporal_load((const f32x4_t*)(xin + (size_t)(r0 + q) * DM + 512 * (j >> 1) + 8 * lane + 4 * (j & 1)));
#pragma unroll
        for (int q = 0; q < 4; ++q) {
            float s = 0.f;
#pragma unroll
            for (int j = 0; j < 4; ++j) { const f32x4_t t = v[q][j]; s += t.x * t.x + t.y * t.y + t.z * t.z + t.w * t.w; }
#pragma unroll
            for (int h = 0; h < 2; ++h) {
                const f32x4_t a = v[q][2 * h], c = v[q][2 * h + 1];
                u32x4_t w; w.x = pk2(a.x, a.y); w.y = pk2(a.z, a.w); w.z = pk2(c.x, c.y); w.w = pk2(c.z, c.w);
                *(u32x4_t*)(xb + (size_t)(r0 + q) * DM + 512 * h + 8 * lane) = w;
            }
            s = wave_sum(s);
            if (lane == 0) ss[r0 + q] = s;
        }
    }
}
__device__ void phase_final_norm(const bf16_t* y, float* x, const float* g, int wid0) {
    y = opq(y); x = opq(x); g = opq(g);
    typedef unsigned u32x4_t __attribute__((ext_vector_type(4)));
    const int tid_ = otid(wid0); const int lane = tid_ & 63, wv = tid_ >> 6;
    const int gw = blockIdx.x * NWAVES + wv, ngw = gridDim.x * NWAVES;
    float4 gg[4];
#pragma unroll
    for (int j = 0; j < 2; ++j) { gg[2 * j] = ((const float4*)(g + 512 * j + lane * 8))[0]; gg[2 * j + 1] = ((const float4*)(g + 512 * j + lane * 8))[1]; }
    for (int r0 = gw * 4; r0 < MTOK; r0 += ngw * 4) {
        u32x4_t v[4][2];
#pragma unroll
        for (int q = 0; q < 4; ++q)
#pragma unroll
            for (int j = 0; j < 2; ++j) v[q][j] = __builtin_nontemporal_load((const u32x4_t*)(y + (size_t)(r0 + q) * DM + 512 * j + lane * 8));
#pragma unroll
        for (int q = 0; q < 4; ++q) {
            float f[16];
#pragma unroll
            for (int j = 0; j < 2; ++j)
#pragma unroll
                for (int e = 0; e < 4; ++e) { const unsigned w = v[q][j][e]; f[j * 8 + 2 * e] = __uint_as_float(w << 16); f[j * 8 + 2 * e + 1] = __uint_as_float(w & 0xffff0000u); }
            float s = 0.f;
#pragma unroll
            for (int e = 0; e < 16; ++e) s += f[e] * f[e];
            s = wave_sum(s);
            const float rs = rsqrtf(s * (1.f / DM) + 1e-6f);
#pragma unroll
            for (int j = 0; j < 2; ++j) {
                typedef float f32x4_t __attribute__((ext_vector_type(4)));
                f32x4_t o0, o1;
                o0.x = f[j * 8 + 0] * rs * gg[2 * j].x; o0.y = f[j * 8 + 1] * rs * gg[2 * j].y; o0.z = f[j * 8 + 2] * rs * gg[2 * j].z; o0.w = f[j * 8 + 3] * rs * gg[2 * j].w;
                o1.x = f[j * 8 + 4] * rs * gg[2 * j + 1].x; o1.y = f[j * 8 + 5] * rs * gg[2 * j + 1].y; o1.z = f[j * 8 + 6] * rs * gg[2 * j + 1].z; o1.w = f[j * 8 + 7] * rs * gg[2 * j + 1].w;
                f32x4_t* d = (f32x4_t*)(x + (size_t)(r0 + q) * DM + 512 * j + lane * 8);
                __builtin_nontemporal_store(o0, d); __builtin_nontemporal_store(o1, d + 1);
            }
        }
    }
}

namespace att {
#define LAS3 __attribute__((address_space(3)))
typedef short bf16x8 __attribute__((ext_vector_type(8)));
typedef float f32x16 __attribute__((ext_vector_type(16)));
typedef float f32x4 __attribute__((ext_vector_type(4)));
typedef short v4i16_t __attribute__((ext_vector_type(4)));
typedef float f32x2_t __attribute__((ext_vector_type(2)));
typedef __bf16 bf16x2_t __attribute__((ext_vector_type(2)));
constexpr int L_KV = 0;
constexpr int L_WSF = 67584;
constexpr int L_BTAB = 69632;
constexpr int L_IMP = 40960;
constexpr int L_SELM = 57344;
constexpr float NEG_INF = -INFINITY;

__device__ __forceinline__ unsigned cvtpk(float lo, float hi) { f32x2_t v = {lo, hi}; bf16x2_t b = __builtin_convertvector(v, bf16x2_t); return __builtin_bit_cast(unsigned, b); }
__device__ __forceinline__ int crow(int r, int hi) { return (r & 3) + 8 * (r >> 2) + 4 * hi; }

struct Ctx {
    int tid, lane, r32, hi, wid;
    unsigned kofs[4];
    unsigned vofs0;
    unsigned stK, stV;
};
__device__ __forceinline__ Ctx make_ctx(int wid0) {
    Ctx c; c.tid = otid(wid0); c.lane = c.tid & 63; c.r32 = c.lane & 31; c.hi = c.lane >> 5; c.wid = __builtin_amdgcn_readfirstlane(c.tid >> 6);
#pragma unroll
    for (int d0 = 0; d0 < 4; ++d0) c.kofs[d0] = (unsigned)(c.r32 * 128 + (((2 * d0 + c.hi) ^ ((c.r32 >> 1) & 7)) << 4));
    const int q = (c.lane & 15) >> 2, p = c.lane & 3, g = (c.lane >> 4) & 1;
    c.vofs0 = (unsigned)((4 * c.hi + q) * 128 + (((2 * g + (p >> 1)) ^ ((q >> 1) << 2)) << 4) + 8 * (p & 1));
    const int kv = c.tid >> 3, ch = c.tid & 7;
    c.stK = (unsigned)(kv * 128 + ((ch ^ (kv & 7)) << 4));
    c.stV = (unsigned)(kv * 128 + ((ch ^ (((kv >> 1) & 1) << 2)) << 4));
    return c;
}
__device__ __forceinline__ void qk_tile(f32x16& p0, f32x16& p1, const LAS3 unsigned char* kb, const Ctx& c, const bf16x8 (&qf)[4]) {
    bf16x8 a0[4], a1[4];
#pragma unroll
    for (int d0 = 0; d0 < 4; ++d0) { a0[d0] = *(const LAS3 bf16x8*)(kb + c.kofs[d0]); a1[d0] = *(const LAS3 bf16x8*)(kb + 4096 + c.kofs[d0]); }
    __builtin_amdgcn_s_setprio(1);
#pragma unroll
    for (int d0 = 0; d0 < 4; ++d0) {
        p0 = __builtin_amdgcn_mfma_f32_32x32x16_bf16(a0[d0], qf[d0], p0, 0, 0, 0);
        p1 = __builtin_amdgcn_mfma_f32_32x32x16_bf16(a1[d0], qf[d0], p1, 0, 0, 0);
    }
    __builtin_amdgcn_s_setprio(0);
}
__device__ __forceinline__ bf16x8 pack8(const f32x16& p, int b) {
    typedef unsigned u32x4p_t __attribute__((ext_vector_type(4)));
    u32x4p_t w; w.x = cvtpk(p[b], p[b + 1]); w.y = cvtpk(p[b + 2], p[b + 3]); w.z = cvtpk(p[b + 4], p[b + 5]); w.w = cvtpk(p[b + 6], p[b + 7]);
    return __builtin_bit_cast(bf16x8, w);
}
__device__ __forceinline__ void pack_p(bf16x8 (&pa)[4], const f32x16& p0, const f32x16& p1) { pa[0] = pack8(p0, 0); pa[1] = pack8(p0, 8); pa[2] = pack8(p1, 0); pa[3] = pack8(p1, 8); }
__device__ __forceinline__ void pv_tile(f32x16 (&o)[2], const LAS3 unsigned char* vb, const Ctx& c, const bf16x8 (&pa)[4]) {
#pragma unroll
    for (int dblk = 0; dblk < 2; ++dblk) {
        const LAS3 unsigned char* vp = vb + (c.vofs0 ^ (unsigned)(dblk * 64));
        bf16x8 bfr[4];
#pragma unroll
        for (int s = 0; s < 4; ++s) {
            const v4i16_t lo = __builtin_amdgcn_ds_read_tr16_b64_v4i16((LAS3 v4i16_t*)(vp + s * 2048));
            const v4i16_t hi = __builtin_amdgcn_ds_read_tr16_b64_v4i16((LAS3 v4i16_t*)(vp + s * 2048 + 1024));
            bfr[s] = (bf16x8){lo[0], lo[1], lo[2], lo[3], hi[0], hi[1], hi[2], hi[3]};
        }
        __builtin_amdgcn_s_setprio(1);
#pragma unroll
        for (int s = 0; s < 4; ++s) o[dblk] = __builtin_amdgcn_mfma_f32_32x32x16_bf16(pa[s], bfr[s], o[dblk], 0, 0, 0);
        __builtin_amdgcn_s_setprio(0);
    }
}
__device__ __forceinline__ void rows_to_o(float (&out)[16], float v, LAS3 float* wsf, const Ctx& c) {
    if (c.hi == 0) wsf[c.r32] = v;
    asm volatile("" ::: "memory");
#pragma unroll
    for (int i = 0; i < 4; ++i) {
        const f32x4 t = *(const LAS3 f32x4*)(wsf + 8 * i + 4 * c.hi);
        out[4 * i] = t[0]; out[4 * i + 1] = t[1]; out[4 * i + 2] = t[2]; out[4 * i + 3] = t[3];
    }
    asm volatile("" ::: "memory");
}
constexpr float SM_THR = 8.f;
constexpr float FOX_SKIP = 48.f;
__device__ __forceinline__ float max3f(float x, float y, float z) { float r; asm("v_max3_f32 %0, %1, %2, %3" : "=v"(r) : "v"(x), "v"(y), "v"(z)); return r; }
__device__ __forceinline__ float max2f(float x, float y) { float r; asm("v_max_f32_e32 %0, %1, %2" : "=v"(r) : "v"(x), "v"(y)); return r; }
__device__ __forceinline__ float fadd_s(float x, float y) { float r; asm("v_add_f32_e32 %0, %1, %2" : "=v"(r) : "v"(x), "v"(y)); return r; }
__device__ __forceinline__ void softmax_step(f32x16& p0, f32x16& p1, float& mref, bool& started, float& l, f32x16 (&o)[2], LAS3 float* wsf, const Ctx& c) {
    asm volatile("s_nop 15\n\ts_nop 7" : "+v"(p0), "+v"(p1));
    float ma = max3f(p0[0], p0[1], p1[0]), mb = max3f(p0[2], p0[3], p1[1]);
    ma = max3f(ma, p1[2], p1[3]);
#pragma unroll
    for (int r = 4; r < 16; r += 4) { ma = max3f(ma, p0[r], p0[r + 1]); mb = max3f(mb, p0[r + 2], p0[r + 3]); ma = max3f(ma, p1[r], p1[r + 1]); mb = max3f(mb, p1[r + 2], p1[r + 3]); }
    float mx = pair_max(max2f(ma, mb));
    const bool fin = mx > NEG_INF;
    const bool rc = fin && (!started || mx > SM_THR);
    if (__any(rc)) {
        const float delta = rc ? mx : 0.f;
        const float alpha = (rc && started) ? __builtin_amdgcn_exp2f(-delta) : 1.f;
        mref += delta;
        l *= alpha;
        float a16[16];
        rows_to_o(a16, alpha, wsf, c);
#pragma unroll
        for (int r = 0; r < 16; ++r) { o[0][r] *= a16[r]; o[1][r] *= a16[r]; p0[r] -= delta; p1[r] -= delta; }
    }
    started = started || fin;
    float s = 0.f;
#pragma unroll
    for (int r = 0; r < 16; ++r) { p0[r] = __builtin_amdgcn_exp2f(p0[r]); p1[r] = __builtin_amdgcn_exp2f(p1[r]); }
#pragma unroll
    for (int r = 0; r < 16; ++r) { s += p0[r]; s += p1[r]; }
    l += s;
}
constexpr float FAST_THR = 24.f;
__device__ __forceinline__ void softmax_fast(f32x16& p0, f32x16& p1, float& l) {
#pragma unroll
    for (int r = 0; r < 16; ++r) { p0[r] = __builtin_amdgcn_exp2f(p0[r]); p1[r] = __builtin_amdgcn_exp2f(p1[r]); }
    float s = 0.f;
#pragma unroll
    for (int r = 0; r < 16; ++r) { s += p0[r]; s += p1[r]; }
    l += s;
}
typedef unsigned u32x4_t __attribute__((ext_vector_type(4)));
constexpr int L_KR = 0, L_VR = 32768, L_AUXR = 65536, L_FLAG = 65536 + 1024, L_UNIT = 65536 + 1056, L_TACC = 157184 + 16, L_NEXT = 157184 + 32  ;
#define ATT_WAITBAR0() asm volatile("s_waitcnt vmcnt(0) lgkmcnt(0)\n\ts_barrier" ::: "memory")
#define ATT_WAITBAR(N) asm volatile("s_waitcnt vmcnt(" #N ") lgkmcnt(0)\n\ts_barrier" ::: "memory")
__device__ __forceinline__ void dma16(const void* g, LAS3 unsigned char* ldst) {
    const unsigned la = (unsigned)__builtin_amdgcn_readfirstlane((int)(unsigned)(size_t)ldst);
    unsigned keep;
    asm volatile("s_mov_b32 %0, m0\n\ts_mov_b32 m0, %2\n\ts_nop 0\n\tglobal_load_lds_dwordx4 %1, off\n\ts_mov_b32 m0, %0" : "=&s"(keep) : "v"(g), "s"(la) : "memory");
}
__device__ __forceinline__ void dma4(const void* g, LAS3 unsigned char* ldst) {
    const unsigned la = (unsigned)__builtin_amdgcn_readfirstlane((int)(unsigned)(size_t)ldst);
    unsigned keep;
    asm volatile("s_mov_b32 %0, m0\n\ts_mov_b32 m0, %2\n\ts_nop 0\n\tglobal_load_lds_dword %1, off\n\ts_mov_b32 m0, %0" : "=&s"(keep) : "v"(g), "s"(la) : "memory");
}
template <bool AUX, bool HASV, class TileOf>
__device__ __forceinline__ void pipe_prefetch(LAS3 unsigned char* L, const Ctx& c, const bf16_t* K, const bf16_t* V, const float* aux, int count, TileOf tile_of) {
    const int row = c.tid >> 3, chs = c.tid & 7;
    const unsigned gk = (unsigned)(row * 128 + ((chs ^ ((row >> 1) & 7)) << 4));
    const unsigned gv = (unsigned)(row * 128 + ((chs ^ (((row >> 1) & 1) << 2)) << 4));
    const unsigned wl = (unsigned)c.wid * 1024u;
    for (int i = 0; i < 3 && i < count; ++i) {
        const int j = tile_of(i);
        dma16((const unsigned char*)(K + (size_t)j * 4096) + gk, L + L_KR + i * 8192 + wl);
        if (AUX) dma4((const unsigned char*)(aux + j * 64) + c.lane * 4, L + L_AUXR + i * 256);
        if (HASV && i < 2) dma16((const unsigned char*)(V + (size_t)j * 4096) + gv, L + L_VR + i * 8192 + wl);
    }
}
template <bool EXIT, bool AUX, bool HASV, bool PRE, class TileOf, class Need, class Init, class ProcA, class PV, class Adj, class Done>
__device__ __forceinline__ void tile_pipeline(LAS3 unsigned char* L, const Ctx& c, const bf16x8 (&qf)[4], const bf16_t* K, const bf16_t* V, const float* aux,
                                              int count, TileOf tile_of, Need need, Init init, ProcA procA, PV pvf, Adj adj, Done done) {
    TBEG(1, L, c.wid);
    const int row = c.tid >> 3, chs = c.tid & 7;
    const unsigned gk = (unsigned)(row * 128 + ((chs ^ ((row >> 1) & 7)) << 4));
    const unsigned gv = (unsigned)(row * 128 + ((chs ^ (((row >> 1) & 1) << 2)) << 4));
    const unsigned wl = (unsigned)c.wid * 1024u;
    auto issue_k = [&](int i) { const int j = tile_of(i); const int s = i & 3;
        dma16((const unsigned char*)(K + (size_t)j * 4096) + gk, L + L_KR + s * 8192 + wl);
        if (AUX) dma4((const unsigned char*)(aux + j * 64) + c.lane * 4, L + L_AUXR + s * 256); };
    auto issue_v = [&](int i) { if (HASV) { const int j = tile_of(i); const int s = i & 3; dma16((const unsigned char*)(V + (size_t)j * 4096) + gv, L + L_VR + s * 8192 + wl); } };
    const bool ph1 = c.wid >= 4;
    if (!PRE) { issue_k(0); issue_v(0); if (count > 1) { issue_k(1); issue_v(1); } if (count > 2) issue_k(2); }
    if (EXIT && c.tid < 3) *(LAS3 unsigned*)(L + L_FLAG + c.tid * 4) = 0u;
    ATT_WAITBAR0();
    TBEG(2, L, c.wid);
    auto end_step = [&](int i) -> bool {
        if (EXIT) { if (!done() && c.lane == 0) *(LAS3 unsigned*)(L + L_FLAG + (i % 3) * 4) = 1u; }
        if (i + 3 < count && (!HASV || i + 2 < count)) { if (AUX) ATT_WAITBAR(3); else if (HASV) ATT_WAITBAR(2); else ATT_WAITBAR(1); } else ATT_WAITBAR0();
        if (EXIT) {
            const unsigned f = *(LAS3 unsigned*)(L + L_FLAG + (i % 3) * 4);
            if (c.tid == 0) *(LAS3 unsigned*)(L + L_FLAG + ((i + 2) % 3) * 4) = 0u;
            if (f == 0u) return false;
        }
        return true;
    };
    if (!ph1) {
        f32x16 a0, a1, b0, b1; bool haveA = false, haveB = false;
        { const int j0 = tile_of(0); if (need(j0)) { init(j0, a0, a1, 0); qk_tile(a0, a1, L + L_KR, c, qf); haveA = true; } }
        auto step0 = [&](int i, f32x16& c0, f32x16& c1, bool& haveC, f32x16& n0, f32x16& n1, bool& haveN) -> bool {
            if (i + 3 < count) issue_k(i + 3);
            if (i + 2 < count) issue_v(i + 2);
            haveN = false;
            if (i + 1 < count) { const int j1 = tile_of(i + 1); if (need(j1)) { const int sl = (i + 1) & 3; init(j1, n0, n1, sl); qk_tile(n0, n1, L + L_KR + sl * 8192, c, qf); haveN = true; } }
            if (i < count && haveC) {
                const int j = tile_of(i);
                procA(j, c0, c1);
                if (haveN) adj(n0, n1);
                if (HASV) { bf16x8 pq[4]; pack_p(pq, c0, c1); pvf(pq, L + L_VR + (i & 3) * 8192); }
            }
            haveC = false;
            return end_step(i);
        };
        const int nsteps = count + (HASV ? 1 : 0);
        for (int i = 0; i < nsteps; i += 2) {
            if (!step0(i, a0, a1, haveA, b0, b1, haveB)) break;
            if (i + 1 >= nsteps) break;
            if (!step0(i + 1, b0, b1, haveB, a0, a1, haveA)) break;
        }
    } else {
        bf16x8 pa[4]; bool have = false; int i = 0;
        const int nsteps = count + (HASV ? 1 : 0);
        for (; i < nsteps; ++i) {
            if (i + 3 < count) issue_k(i + 3);
            if (i + 2 < count) issue_v(i + 2);
            f32x16 s0, s1; bool nj = false; int j = 0;
            if (i < count) { j = tile_of(i); nj = need(j); if (nj) { const int sl = i & 3; init(j, s0, s1, sl); qk_tile(s0, s1, L + L_KR + sl * 8192, c, qf); } }
            if (HASV && have) pvf(pa, L + L_VR + ((i + 3) & 3) * 8192);
            have = false;
            if (nj) { procA(j, s0, s1); if (HASV) pack_p(pa, s0, s1); have = true; }
            if (!end_step(i)) break;
        }
        if (EXIT && HASV && have && i < count) pvf(pa, L + L_VR + (i & 3) * 8192);
    }
    if (EXIT) ATT_WAITBAR0();
    TEND(1, L, c.wid); TEND(2, L, c.wid);
}

constexpr int L_OSTG = 71680;
__device__ __forceinline__ void store_gated(LAS3 unsigned char* L, const Ctx& c, const f32x16 (&o)[2], const float (&f16)[16], const bf16_t* Zrow0, int zpitch, bf16_t* Crow0) {
    LAS3 float* st = (LAS3 float*)(L + L_OSTG) + c.wid * 2048;
#pragma unroll
    for (int r = 0; r < 16; ++r) { st[crow(r, c.hi) * 64 + c.r32] = o[0][r] * f16[r]; st[crow(r, c.hi) * 64 + 32 + c.r32] = o[1][r] * f16[r]; }
    asm volatile("" ::: "memory");
    const int ch = c.lane & 7;
    u32x4_t zq[4];
#pragma unroll
    for (int it = 0; it < 4; ++it) zq[it] = __builtin_nontemporal_load((const u32x4_t*)(Zrow0 + (size_t)(it * 8 + (c.lane >> 3)) * zpitch + ch * 8));
#pragma unroll
    for (int it = 0; it < 4; ++it) {
        const int row = it * 8 + (c.lane >> 3);
        const f32x4 o0 = *(const LAS3 f32x4*)(st + row * 64 + ch * 8), o1 = *(const LAS3 f32x4*)(st + row * 64 + ch * 8 + 4);
        const u32x4_t zz = zq[it];
        float rr[8];
#pragma unroll
        for (int e = 0; e < 8; ++e) {
            const float z = __uint_as_float((e & 1) ? (zz[e >> 1] & 0xffff0000u) : (zz[e >> 1] << 16));
            const float ov = e < 4 ? o0[e] : o1[e - 4];
            rr[e] = ov * (z / (1.f + __expf(-z)));
        }
        u32x4_t w; w.x = cvtpk(rr[0], rr[1]); w.y = cvtpk(rr[2], rr[3]); w.z = cvtpk(rr[4], rr[5]); w.w = cvtpk(rr[6], rr[7]);
        __builtin_nontemporal_store(w, (u32x4_t*)(Crow0 + (size_t)row * DM + ch * 8));
    }
}

__device__ void fox_unit(unsigned char* ws, unsigned char* ldsg, int b, int h, int qb, int wid0, unsigned* qctr, int qslot) {
    ws = opq(ws); ldsg = opq(ldsg);
    const Ctx c = make_ctx(wid0);
    LAS3 unsigned char* L = (LAS3 unsigned char*)ldsg;
    unsigned nx = 0u;
    if (c.tid == 0) nx = __hip_atomic_fetch_add(qctr, 1u, __ATOMIC_RELAXED, __HIP_MEMORY_SCOPE_AGENT);
    LAS3 float* wsf = (LAS3 float*)(L + L_WSF) + c.wid * 64;
    const int t0 = qb * 256;
    const int tw0 = t0 + c.wid * 32;
    const int t = tw0 + c.r32;
    const size_t hb = ((size_t)(b * 4 + h) * SEQ);
    const bf16_t* Q = (const bf16_t*)(ws + WS_QC) + (hb + t) * 64;
    const bf16_t* K = (const bf16_t*)(ws + WS_KCF) + hb * 64;
    const bf16_t* V = (const bf16_t*)(ws + WS_VCF) + hb * 64;
    const float* cf = (const float*)(ws + WS_CFOX) + hb;
    bf16x8 qf[4];
#pragma unroll
    for (int d0 = 0; d0 < 4; ++d0) qf[d0] = __builtin_nontemporal_load((const bf16x8*)(Q + 16 * d0 + 8 * c.hi));
    { const int NT0 = (t0 + 256) / 64; pipe_prefetch<true, true>(L, c, K, V, cf, NT0, [&](int i) { return NT0 - 1 - i; }); }
    const float cref = cf[t0 + 255];
    const float kmax = ((const float*)(ws + WS_KMAX))[b * 4 + h];
    float qn;
    {
        float s2 = 0.f;
#pragma unroll
        for (int d0 = 0; d0 < 4; ++d0)
#pragma unroll
            for (int e = 0; e < 8; ++e) { const float x = bf2f((bf16_t)qf[d0][e]); s2 += x * x; }
        qn = sqrtf(pair_sum(s2)) * kmax;
    }
    if (c.tid == 0) *(volatile LAS3 unsigned*)(L + L_NEXT + 4 * qslot) = nx;
    int jlast = (t0 + 256) / 64;
    const float L2E = 1.4426950408889634f;
    float mref = 0.f, mref_init = 0.f, l = 0.f; bool started = false;
    f32x16 o[2]; o[0] = f32x16{}; o[1] = f32x16{};
    const int NT = (t0 + 256) / 64;
    const float cadd = cref * L2E;
    tile_pipeline<true, true, true, true>(L, c, qf, K, V, cf, NT,
        [&](int i) { return NT - 1 - i; },
        [&](int j) { return j * 64 <= tw0 + 31; },
        [&](int j, f32x16& p0, f32x16& p1, int abuf) {
            mref_init = mref;
            const LAS3 float* ax = (const LAS3 float*)(L + L_AUXR + abuf * 256);
#pragma unroll
            for (int i4 = 0; i4 < 4; ++i4) {
                const f32x4 a = *(const LAS3 f32x4*)(ax + 8 * i4 + 4 * c.hi);
                const f32x4 bq = *(const LAS3 f32x4*)(ax + 32 + 8 * i4 + 4 * c.hi);
#pragma unroll
                for (int e = 0; e < 4; ++e) { p0[4 * i4 + e] = __builtin_fmaf(a[e], -L2E, cadd - mref); p1[4 * i4 + e] = __builtin_fmaf(bq[e], -L2E, cadd - mref); }
            }
        },
        [&](int j, f32x16& p0, f32x16& p1) {
            jlast = j;
            if (j * 64 + 63 > tw0) {
                const int kv0 = j * 64 + 4 * c.hi;
#pragma unroll
                for (int r = 0; r < 16; ++r) {
                    const int kv = kv0 + (r & 3) + 8 * (r >> 2);
                    if (kv > t) p0[r] = NEG_INF;
                    if (kv + 32 > t) p1[r] = NEG_INF;
                }
            }
            softmax_step(p0, p1, mref, started, l, o, wsf, c);
        },
        [&](const bf16x8 (&pa)[4], const LAS3 unsigned char* vb) { pv_tile(o, vb, c, pa); },
        [&](f32x16& n0, f32x16& n1) { const float d = mref - mref_init; if (__any(d != 0.f)) {
#pragma unroll
            for (int r = 0; r < 16; ++r) { n0[r] -= d; n1[r] -= d; } } },
        [&]() {
            if (jlast == 0) return true;
            const int slot = (NT - jlast) & 3;
            const float cedge = ((const LAS3 float*)(L + L_AUXR + slot * 256))[63];
            const bool gone = started && (qn + __builtin_fmaf(cedge, -L2E, cadd) - mref < -FOX_SKIP);
            return __any(!gone) == 0;
        });
    TBEG(5, L, c.wid);
    l = pair_sum(l);
    float f16[16];
    rows_to_o(f16, 1.f / l, wsf, c);
    store_gated(L, c, o, f16, (const bf16_t*)(ws + WS_ZC) + ((size_t)b * SEQ + tw0) * 256 + h * 64, 256, (bf16_t*)(ws + WS_CAT) + ((size_t)b * SEQ + tw0) * DM + 768 + h * 64);
    __syncthreads();
    TEND(5, L, c.wid);
}
}

__device__ void phase_fox(unsigned char* ws, unsigned char* ldsg, int wid0) {
    const int nunits = BATCH * 4 * 16;
    for (int u = blockIdx.x; u < nunits; u += gridDim.x) {
        const int k_ = (u % 256) / (BATCH * 4), bh = u % (BATCH * 4); const int qb = u < 256 ? 15 - k_ : k_;
        att::fox_unit(ws, ldsg, bh >> 2, bh & 3, qb, wid0, (unsigned*)(ws + WS_CTR) + 900, 0);
    }
}

namespace att {
constexpr int L_BT4 = 140288;
constexpr int BT4_N = 260;
constexpr int L_BT4KEY = 156928;
constexpr int L_GATE = 137216;
constexpr int L_OTOT = 71680, L_IMPM = L_OTOT, L_IMPS = L_OTOT + 16384;
__device__ __forceinline__ f32x16 splat16(float v) { f32x16 r;
#pragma unroll
    for (int i = 0; i < 16; ++i) r[i] = v;
    return r; }
__device__ __forceinline__ void stats_step(const f32x16& p0, const f32x16& p1, float& m, float& l) {
    float mx = fmaxf(p0[0], p1[0]);
#pragma unroll
    for (int r = 1; r < 16; ++r) mx = fmaxf(mx, fmaxf(p0[r], p1[r]));
    mx = pair_max(mx);
    const float mnew = fmaxf(m, mx);
    const float msafe = (mnew == NEG_INF) ? 0.f : mnew;
    l *= __builtin_amdgcn_exp2f(m - msafe);
    float s = 0.f;
#pragma unroll
    for (int r = 0; r < 16; ++r) s += __builtin_amdgcn_exp2f(p0[r] - msafe) + __builtin_amdgcn_exp2f(p1[r] - msafe);
    l += s;
    m = mnew;
}
__device__ __forceinline__ void bias_mask(f32x16& p0, f32x16& p1, const LAS3 float* bt, int t, int kp0, int kstride, int lo) {
#pragma unroll
    for (int r = 0; r < 16; ++r) {
        const int kl = (r & 3) + 8 * (r >> 2);
        const int ka = kp0 + kstride * kl, kb = ka + 32 * kstride;
        const int da = t - ka, db = t - kb;
        const float ba = bt[min(max(da, 0), 127)], bb = bt[min(max(db, 0), 127)];
        p0[r] = (da < 0 || ka < lo) ? NEG_INF : p0[r] + ba;
        p1[r] = (db < 0 || kb < lo) ? NEG_INF : p1[r] + bb;
        if ((r & 3) == 3) asm volatile("" ::: "memory");
    }
}

__device__ __forceinline__ void bias4(f32x16& p0, f32x16& p1, const LAS3 float* bt4h, int t, int kp0) {
    const int x0 = 191 - (t - kp0);
#pragma unroll
    for (int i = 0; i < 4; ++i) {
        const int xa = x0 + 8 * i, xb = xa + 32;
        const f32x4 ba = *(const LAS3 f32x4*)(bt4h + (xa & 3) * (4 * BT4_N) + (xa & ~3));
        const f32x4 bb = *(const LAS3 f32x4*)(bt4h + (xb & 3) * (4 * BT4_N) + (xb & ~3));
#pragma unroll
        for (int e = 0; e < 4; ++e) { p0[4 * i + e] += ba[e]; p1[4 * i + e] += bb[e]; }
    }
}
__device__ void nsa_unit(const Params& p, unsigned char* ws, unsigned char* ldsg, int b, int g, int qt, int wid0, unsigned* qctr, int qslot) {
    ws = opq(ws); ldsg = opq(ldsg);
    const Ctx c = make_ctx(wid0);
    LAS3 unsigned char* L = (LAS3 unsigned char*)ldsg;
    unsigned nx = 0u;
    if (c.tid == 0) nx = __hip_atomic_fetch_add(qctr, 1u, __ATOMIC_RELAXED, __HIP_MEMORY_SCOPE_AGENT);
    LAS3 float* wsf = (LAS3 float*)(L + L_WSF) + c.wid * 64;
    LAS3 float* btab = (LAS3 float*)(L + L_BTAB);
    LAS3 float* impm = (LAS3 float*)(L + L_IMPM);
    LAS3 float* imps = (LAS3 float*)(L + L_IMPS);
    const float L2E = 1.4426950408889634f;
    TBEG(4, L, c.wid); TBEG(23, L, c.wid);
    const int t0 = qt * 64;
    const size_t gb = (size_t)(b * 2 + g);
    const bf16_t* KC = (const bf16_t*)(ws + WS_KCMP) + gb * 256 * 64;
    const bf16_t* VC = (const bf16_t*)(ws + WS_KCMP) + ((size_t)BATCH * 2 + gb) * 256 * 64;
    const int NTC = ((4 * qt + 2) >> 6) + 1;
    pipe_prefetch<false, false>(L, c, KC, VC, nullptr, NTC, [&](int i) { return i; });
    auto QL_ = [&]() { return 8 * c.wid + ((olane() & 31) >> 2); };
    auto HD_ = [&]() { return olane() & 3; };
    btab[c.tid] = p.rel_bias[bucket_of(c.tid & 127) * 8 + g * 4 + (c.tid >> 7)] * L2E;
    bf16x8 qf[4];
    {
        const bf16_t* Q = (const bf16_t*)(ws + WS_QB) + (size_t)(b * SEQ + t0 + QL_()) * 512 + g * 256 + HD_() * 64;
#pragma unroll
        for (int d0 = 0; d0 < 4; ++d0) qf[d0] = __builtin_nontemporal_load((const bf16x8*)(Q + 16 * d0 + 8 * c.hi));
    }
    {
        const int ln = olane() & 31;
        const float* gp = (const float*)(ws + WS_GF) + (size_t)(b * SEQ + t0 + 8 * c.wid + (ln >> 2)) * 32 + (g * 4 + (ln & 3)) * 3;
        LAS3 float* gs = (LAS3 float*)(L + L_GATE) + c.wid * 96 + ln;
        gs[0] = 1.f / (1.f + __expf(-gp[0])); gs[32] = 1.f / (1.f + __expf(-gp[1])); gs[64] = 1.f / (1.f + __expf(-gp[2]));
    }
    if (c.tid == 0) *(volatile LAS3 unsigned*)(L + L_NEXT + 4 * qslot) = nx;
    auto gate_sig = [&](int k) { return ((const LAS3 float*)(L + L_GATE))[c.wid * 96 + k * 32 + (olane() & 31)]; };
    __syncthreads();
    if (*(const LAS3 unsigned*)(L + L_BT4KEY) != (unsigned)(g + 1)) {
        LAS3 float* bt4 = (LAS3 float*)(L + L_BT4);
        for (int e = c.tid; e < 16 * BT4_N; e += NTHREADS) {
            const int s = e / (4 * BT4_N), hh = (e / BT4_N) & 3, x = e % BT4_N;
            const int dist = 191 - (x + s);
            bt4[e] = dist < 0 ? NEG_INF : btab[hh * 128 + (dist < 127 ? dist : 127)];
        }
        __syncthreads();
        if (c.tid == 0) *(LAS3 unsigned*)(L + L_BT4KEY) = (unsigned)(g + 1);
    }
    TEND(4, L, c.wid);
    auto BT_ = [&]() { return btab + HD_() * 128; };
    const float b31 = BT_()[127];
    float qn;
    {
        float s2 = 0.f;
#pragma unroll
        for (int d0 = 0; d0 < 4; ++d0)
#pragma unroll
            for (int e = 0; e < 8; ++e) { const float x = bf2f((bf16_t)qf[d0][e]); s2 += x * x; }
        qn = sqrtf(pair_sum(s2));
    }
    float bmax;
    {
        const int ln = olane();
        float bm = btab[ln];
#pragma unroll
        for (int k = 1; k < 8; ++k) bm = fmaxf(bm, btab[ln + 64 * k]);
        bmax = fmaxf(wave_max(bm), 0.f);
    }
    const float ubS = qn * ((const float*)(ws + WS_KMAX))[32 + b * 2 + g] + bmax;
    const float ubW = qn * ((const float*)(ws + WS_KMAX))[48 + b * 2 + g] + bmax;
    f32x16 o[2];
    float mc = NEG_INF, lc = 0.f;
    TEND(23, L, c.wid);
    TBEG(9, L, c.wid);
    tile_pipeline<false, false, false, true>(L, c, qf, KC, VC, nullptr, NTC,
        [&](int i) { return i; }, [&](int) { return true; },
        [&](int jc, f32x16& p0, f32x16& p1, int) { const float iv = (1024 * jc + 1039 + 128 <= t0) ? b31 : 0.f; p0 = splat16(iv); p1 = splat16(iv); },
        [&](int jc, f32x16& p0, f32x16& p1) {
            if (1024 * jc + 1039 + 128 > t0) bias_mask(p0, p1, BT_(), t0 + QL_(), 16 * (64 * jc + 4 * c.hi) + 31, 16, -(1 << 30));
            stats_step(p0, p1, mc, lc);
        },
        [&](const bf16x8 (&pa)[4], const LAS3 unsigned char* vb) { pv_tile(o, vb, c, pa); },
        [&](f32x16&, f32x16&) {},
        [&]() { return false; });
    pipe_prefetch<false, true>(L, c, KC, VC, nullptr, NTC, [&](int i) { return i; });
    lc = pair_sum(lc);
    const float mcs = (mc == NEG_INF) ? 0.f : mc;
    const float rlc = lc > 0.f ? 1.f / lc : 0.f;
    o[0] = f32x16{}; o[1] = f32x16{};
    tile_pipeline<false, false, true, true>(L, c, qf, KC, VC, nullptr, NTC,
        [&](int i) { return i; }, [&](int) { return true; },
        [&](int jc, f32x16& p0, f32x16& p1, int) { const float iv = ((1024 * jc + 1039 + 128 <= t0) ? b31 : 0.f) - mcs; p0 = splat16(iv); p1 = splat16(iv); },
        [&](int jc, f32x16& p0, f32x16& p1) {
            if (1024 * jc + 1039 + 128 > t0) bias_mask(p0, p1, BT_(), t0 + QL_(), 16 * (64 * jc + 4 * c.hi) + 31, 16, -(1 << 30));
#pragma unroll
            for (int r = 0; r < 16; ++r) { p0[r] = __builtin_amdgcn_exp2f(p0[r]) * rlc; p1[r] = __builtin_amdgcn_exp2f(p1[r]) * rlc; }
            if (qt > 15)
#pragma unroll
            for (int blk = 0; blk < 2; ++blk)
#pragma unroll
                for (int i = 0; i < 4; ++i) {
                    const float x0 = blk ? p1[4 * i] : p0[4 * i], x1 = blk ? p1[4 * i + 1] : p0[4 * i + 1], x2 = blk ? p1[4 * i + 2] : p0[4 * i + 2], x3 = blk ? p1[4 * i + 3] : p0[4 * i + 3];
                    float a = (x0 + x1) + (x2 + 0.5f * x3), sp = 0.5f * x3;
                    a += dppf<0xB1>(a); sp += dppf<0xB1>(sp);
                    a += dppf<0x4E>(a); sp += dppf<0x4E>(sp);
                    const int sidx = 16 * jc + 8 * blk + 2 * i + c.hi;
                    if (HD_() == 0) { const int qloc = QL_(); impm[qloc * 64 + sidx] = a; if (sidx + 1 < 64) imps[qloc * 64 + sidx + 1] = sp; }
                }
        },
        [&](const bf16x8 (&pa)[4], const LAS3 unsigned char* vb) { pv_tile(o, vb, c, pa); },
        [&](f32x16&, f32x16&) {},
        [&]() { return false; });
    TEND(9, L, c.wid);
    const bf16_t* KS = (const bf16_t*)(ws + WS_KSL) + gb * SEQ * 64;
    const bf16_t* VS = (const bf16_t*)(ws + WS_VSL) + gb * SEQ * 64;
    pipe_prefetch<false, true>(L, c, KS, VS, nullptr, qt + 1, [&](int i) { return i; });
    TBEG(3, L, c.wid);
    unsigned long long mymask = (2ull << qt) - 1ull;
    if (qt > 15) {
        mymask = 0ull;
        const int ln = olane(), q8 = ln >> 3, j8 = ln & 7;
        LAS3 float* irow = impm + (8 * c.wid + q8) * 64;
        const LAS3 float* srow = imps + (8 * c.wid + q8) * 64;
        float v[8];
#pragma unroll
        for (int k = 0; k < 8; ++k) {
            const int s = 8 * k + j8;
            float x = irow[s] + (s > 0 ? srow[s] : 0.f);
            if (s == 0 || s == qt || s == qt - 1) x = 1e4f;
            if (s > qt) x = -1e4f;
            v[k] = x;
        }
#pragma unroll
        for (int k = 0; k < 8; ++k) irow[8 * k + j8] = v[k];
        auto key_of = [](float x, int idx) { const unsigned u = __float_as_uint(x); const unsigned m = (u & 0x80000000u) ? ~u : (u | 0x80000000u); return ((unsigned long long)m << 32) | (unsigned)(63 - idx); };
        unsigned long long kv8[8];
#pragma unroll
        for (int k = 0; k < 8; ++k) kv8[k] = key_of(v[k], 8 * k + j8);
        int rank[8];
#pragma unroll
        for (int k = 0; k < 8; ++k) rank[k] = 0;
#pragma unroll 2
        for (int s4 = 0; s4 < 16; ++s4) {
            const f32x4 w = *(const LAS3 f32x4*)(irow + 4 * s4);
#pragma unroll
            for (int e = 0; e < 4; ++e) {
                const unsigned long long kw = key_of(w[e], 4 * s4 + e);
#pragma unroll
                for (int k = 0; k < 8; ++k) rank[k] += (int)(kw > kv8[k]);
            }
        }
        const int qrow = (ln & 31) >> 2;
#pragma unroll
        for (int k = 0; k < 8; ++k) {
            const unsigned long long bal = __ballot(rank[k] < 16);
            mymask |= ((bal >> (8 * qrow)) & 0xFFull) << (8 * k);
        }
    }
    TEND(3, L, c.wid);
    TBEG(20, L, c.wid);
    __syncthreads();
    {
        float f16[16];
        rows_to_o(f16, gate_sig(0), wsf, c);
        LAS3 float* otl = (LAS3 float*)(L + L_OTOT) + c.wid * 2048 + (olane() & 31);
#pragma unroll
        for (int r = 0; r < 16; ++r) { otl[crow(r, c.hi) * 64] = o[0][r] * f16[r]; otl[crow(r, c.hi) * 64 + 32] = o[1][r] * f16[r]; }
    }
    {
        const bf16_t* K = KS; const bf16_t* V = VS;
        const bool fixS = !__any(ubS > 64.f);
        float mref = fixS ? ubS - FAST_THR : 0.f, mref_init = mref, l = 0.f; bool started = fixS;
        o[0] = f32x16{}; o[1] = f32x16{};
        const int NT = qt + 1;
        TEND(20, L, c.wid);
        TBEG(7, L, c.wid);
        for (int rep_ = 0; rep_ < PROBE_SEL; ++rep_)
        tile_pipeline<false, false, true, true>(L, c, qf, K, V, nullptr, NT,
            [&](int i) { return i; },
            [&](int j) { return __any((mymask >> j) & 1ull) != 0; },
            [&](int j, f32x16& p0, f32x16& p1, int) {
                mref_init = mref;
                const bool sel = (mymask >> j) & 1ull;
                const float init = sel ? (j + 2 >= qt ? 0.f : b31) - mref : NEG_INF;
                p0 = splat16(init); p1 = splat16(init);
            },
            [&](int j, f32x16& p0, f32x16& p1) {
                if (j + 2 >= qt) bias4(p0, p1, (const LAS3 float*)(L + L_BT4) + HD_() * BT4_N, t0 + QL_(), 64 * j + 4 * c.hi);
                if (!__any(!started || (ubS - mref > FAST_THR))) softmax_fast(p0, p1, l);
                else softmax_step(p0, p1, mref, started, l, o, wsf, c);
            },
            [&](const bf16x8 (&pa)[4], const LAS3 unsigned char* vb) { pv_tile(o, vb, c, pa); },
        [&](f32x16& n0, f32x16& n1) { const float d = mref - mref_init; if (__any(d != 0.f)) {
#pragma unroll
                for (int r = 0; r < 16; ++r) { n0[r] -= d; n1[r] -= d; } } },
        [&]() { return false; });
        TEND(7, L, c.wid);
        TBEG(21, L, c.wid);
        {
            const int jlo_ = qt - 8 > 0 ? qt - 8 : 0;
            pipe_prefetch<false, true>(L, c, (const bf16_t*)(ws + WS_KWN) + gb * SEQ * 64, (const bf16_t*)(ws + WS_VWN) + gb * SEQ * 64, nullptr, qt - jlo_ + 1, [&](int i) { return qt - i; });
        }
        l = pair_sum(l);
        float f16[16];
        rows_to_o(f16, l > 0.f ? gate_sig(1) / l : 0.f, wsf, c);
        LAS3 float* otl = (LAS3 float*)(L + L_OTOT) + c.wid * 2048 + (olane() & 31);
#pragma unroll
        for (int r = 0; r < 16; ++r) { otl[crow(r, c.hi) * 64] += o[0][r] * f16[r]; otl[crow(r, c.hi) * 64 + 32] += o[1][r] * f16[r]; }
    }
    {
        const bf16_t* K = (const bf16_t*)(ws + WS_KWN) + gb * SEQ * 64;
        const bf16_t* V = (const bf16_t*)(ws + WS_VWN) + gb * SEQ * 64;
        const bool fixW = !__any(ubW > 64.f);
        float mref = fixW ? ubW - FAST_THR : 0.f, mref_init = mref, l = 0.f; bool started = fixW;
        o[0] = f32x16{}; o[1] = f32x16{};
        const int jlo = qt - 8 > 0 ? qt - 8 : 0;
        const int NT = qt - jlo + 1;
        TEND(21, L, c.wid);
        TBEG(8, L, c.wid);
        for (int rep_ = 0; rep_ < PROBE_WIN; ++rep_)
        tile_pipeline<false, false, true, true>(L, c, qf, K, V, nullptr, NT,
            [&](int i) { return qt - i; }, [&](int) { return true; },
            [&](int j, f32x16& p0, f32x16& p1, int) { mref_init = mref; const float init = ((j + 2 >= qt) ? 0.f : b31) - mref; p0 = splat16(init); p1 = splat16(init); },
            [&](int j, f32x16& p0, f32x16& p1) {
                if (j + 2 >= qt) bias4(p0, p1, (const LAS3 float*)(L + L_BT4) + HD_() * BT4_N, t0 + QL_(), 64 * j + 4 * c.hi);
                else if (j == qt - 8) {
                    const int lo = t0 + QL_() - 511, kp0 = 64 * j + 4 * c.hi;
#pragma unroll
                    for (int r = 0; r < 16; ++r) {
                        const int ka = kp0 + (r & 3) + 8 * (r >> 2);
                        if (ka < lo) p0[r] = NEG_INF;
                        if (ka + 32 < lo) p1[r] = NEG_INF;
                    }
                }
                if (!__any(!started || (ubW - mref > FAST_THR))) softmax_fast(p0, p1, l);
                else softmax_step(p0, p1, mref, started, l, o, wsf, c);
            },
            [&](const bf16x8 (&pa)[4], const LAS3 unsigned char* vb) { pv_tile(o, vb, c, pa); },
        [&](f32x16& n0, f32x16& n1) { const float d = mref - mref_init; if (__any(d != 0.f)) {
#pragma unroll
                for (int r = 0; r < 16; ++r) { n0[r] -= d; n1[r] -= d; } } },
        [&]() { return false; });
        TEND(8, L, c.wid);
        TBEG(22, L, c.wid);
        l = pair_sum(l);
        float f16[16];
        rows_to_o(f16, l > 0.f ? gate_sig(2) / l : 0.f, wsf, c);
        LAS3 float* otl = (LAS3 float*)(L + L_OTOT) + c.wid * 2048 + (olane() & 31);
#pragma unroll
        for (int r = 0; r < 16; ++r) { otl[crow(r, c.hi) * 64] += o[0][r] * f16[r]; otl[crow(r, c.hi) * 64 + 32] += o[1][r] * f16[r]; }
    }
    TEND(22, L, c.wid);
    TBEG(5, L, c.wid);
    {
        const bf16_t* Z = (const bf16_t*)(ws + WS_ZB);
        bf16_t* cat = (bf16_t*)(ws + WS_CAT);
        const int lnf = olane(), ch = lnf & 7;
        const LAS3 float* otw = (const LAS3 float*)(L + L_OTOT) + c.wid * 2048;
        u32x4_t zq[4];
#pragma unroll
        for (int it = 0; it < 4; ++it) { const int row = it * 8 + (lnf >> 3); zq[it] = __builtin_nontemporal_load((const u32x4_t*)(Z + ((size_t)b * SEQ + t0 + 8 * c.wid + (row >> 2)) * 512 + (g * 4 + (row & 3)) * 64 + ch * 8)); }
#pragma unroll
        for (int it = 0; it < 4; ++it) {
            const int row = it * 8 + (lnf >> 3);
            const size_t mr = (size_t)b * SEQ + t0 + 8 * c.wid + (row >> 2);
            const int h8 = g * 4 + (row & 3);
            const f32x4 o0 = *(const LAS3 f32x4*)(otw + row * 64 + ch * 8), o1 = *(const LAS3 f32x4*)(otw + row * 64 + ch * 8 + 4);
            const u32x4_t zz = zq[it];
            float r[8];
#pragma unroll
            for (int e = 0; e < 8; ++e) {
                const float z = __uint_as_float((e & 1) ? (zz[e >> 1] & 0xffff0000u) : (zz[e >> 1] << 16));
                const float ov = e < 4 ? o0[e] : o1[e - 4];
                r[e] = ov * (z / (1.f + __expf(-z)));
            }
            u32x4_t w; w.x = cvtpk(r[0], r[1]); w.y = cvtpk(r[2], r[3]); w.z = cvtpk(r[4], r[5]); w.w = cvtpk(r[6], r[7]);
            __builtin_nontemporal_store(w, (u32x4_t*)(cat + mr * DM + 256 + h8 * 64 + ch * 8));
        }
    }
    __syncthreads();
    TEND(5, L, c.wid);
}
}
__device__ void phase_nsa(const Params& p, unsigned char* ws, unsigned char* ldsg, int wid0) {
    const int nunits = BATCH * 2 * 64;
    for (int u = blockIdx.x; u < nunits; u += gridDim.x) {
        const int qt = 63 - u / (BATCH * 2), bg = u % (BATCH * 2);
        att::nsa_unit(p, ws, ldsg, bg >> 1, bg & 1, qt, wid0, (unsigned*)(ws + WS_CTR) + 900, 0);
    }
}

namespace att {
constexpr float SB_EXIT = 64.f;
__device__ void sb_unit(unsigned char* ws, unsigned char* ldsg, int b, int h, int qb, int wid0, unsigned* qctr, int qslot) {
    ws = opq(ws); ldsg = opq(ldsg);
    const Ctx c = make_ctx(wid0);
    LAS3 unsigned char* L = (LAS3 unsigned char*)ldsg;
    unsigned nx = 0u;
    if (c.tid == 0) nx = __hip_atomic_fetch_add(qctr, 1u, __ATOMIC_RELAXED, __HIP_MEMORY_SCOPE_AGENT);
    const int t0 = qb * 256;
    const int tw0 = t0 + c.wid * 32;
    const int t = tw0 + c.r32;
    const size_t hb = ((size_t)(b * 4 + h) * SEQ);
    const bf16_t* Q = (const bf16_t*)(ws + WS_QA) + (hb + t) * 64;
    const bf16_t* K = (const bf16_t*)(ws + WS_KA) + hb * 64;
    const bf16_t* V = (const bf16_t*)(ws + WS_VA) + hb * 64;
    bf16x8 qf[4];
#pragma unroll
    for (int d0 = 0; d0 < 4; ++d0) qf[d0] = __builtin_nontemporal_load((const bf16x8*)(Q + 16 * d0 + 8 * c.hi));
    float carry = 0.f;
    f32x16 o[2]; o[0] = f32x16{}; o[1] = f32x16{};
    const int NT = (t0 + 256) / 64;
    pipe_prefetch<false, true>(L, c, K, V, nullptr, NT, [&](int i) { return NT - 1 - i; });
    if (c.tid == 0) *(volatile LAS3 unsigned*)(L + L_NEXT + 4 * qslot) = nx;
    tile_pipeline<true, false, true, true>(L, c, qf, K, V, nullptr, NT,
        [&](int i) { return NT - 1 - i; },
        [&](int j) { return (j * 64 <= tw0 + 31) && __any(carry <= SB_EXIT); },
        [&](int, f32x16& p0, f32x16& p1, int) { p0 = f32x16{}; p1 = f32x16{}; },
        [&](int j, f32x16& z0, f32x16& z1) {
            const int kv0 = j * 64 + 4 * c.hi;
            const bool diag = j * 64 + 63 >= tw0;
            f32x16 e0, e1;
#pragma unroll
            for (int r = 0; r < 16; ++r) {
                const float a0 = z0[r], a1 = z1[r];
                e0[r] = fmaxf(a0, 0.f) + __builtin_amdgcn_logf(1.f + __builtin_amdgcn_exp2f(-fabsf(a0)));
                e1[r] = fmaxf(a1, 0.f) + __builtin_amdgcn_logf(1.f + __builtin_amdgcn_exp2f(-fabsf(a1)));
            }
            if (diag) {
#pragma unroll
                for (int r = 0; r < 16; ++r) {
                    const int kv = kv0 + (r & 3) + 8 * (r >> 2);
                    if (kv >= t) { e0[r] = 0.f; z0[r] = NEG_INF; }
                    if (kv + 32 >= t) { e1[r] = 0.f; z1[r] = NEG_INF; }
                }
            }
            float cs[2][4], pc[2][4], after[2][4];
#pragma unroll
            for (int i4 = 0; i4 < 4; ++i4) {
                cs[0][i4] = (e0[4 * i4] + e0[4 * i4 + 1]) + (e0[4 * i4 + 2] + e0[4 * i4 + 3]);
                cs[1][i4] = (e1[4 * i4] + e1[4 * i4 + 1]) + (e1[4 * i4 + 2] + e1[4 * i4 + 3]);
                pc[0][i4] = pair_other(cs[0][i4], c.hi);
                pc[1][i4] = pair_other(cs[1][i4], c.hi);
            }
            float run = 0.f;
#pragma unroll
            for (int blk = 1; blk >= 0; --blk)
#pragma unroll
                for (int i4 = 3; i4 >= 0; --i4) { after[blk][i4] = run + (c.hi == 0 ? pc[blk][i4] : 0.f); run += cs[blk][i4] + pc[blk][i4]; }
#pragma unroll
            for (int i4 = 0; i4 < 4; ++i4) {
                {
                    const float base = carry + after[0][i4];
                    const float s3 = base + e0[4 * i4 + 3], s2 = s3 + e0[4 * i4 + 2], s1 = s2 + e0[4 * i4 + 1], s0 = s1 + e0[4 * i4];
                    z0[4 * i4] = __builtin_amdgcn_exp2f(z0[4 * i4] - s0);
                    z0[4 * i4 + 1] = __builtin_amdgcn_exp2f(z0[4 * i4 + 1] - s1);
                    z0[4 * i4 + 2] = __builtin_amdgcn_exp2f(z0[4 * i4 + 2] - s2);
                    z0[4 * i4 + 3] = __builtin_amdgcn_exp2f(z0[4 * i4 + 3] - s3);
                }
                {
                    const float base = carry + after[1][i4];
                    const float s3 = base + e1[4 * i4 + 3], s2 = s3 + e1[4 * i4 + 2], s1 = s2 + e1[4 * i4 + 1], s0 = s1 + e1[4 * i4];
                    z1[4 * i4] = __builtin_amdgcn_exp2f(z1[4 * i4] - s0);
                    z1[4 * i4 + 1] = __builtin_amdgcn_exp2f(z1[4 * i4 + 1] - s1);
                    z1[4 * i4 + 2] = __builtin_amdgcn_exp2f(z1[4 * i4 + 2] - s2);
                    z1[4 * i4 + 3] = __builtin_amdgcn_exp2f(z1[4 * i4 + 3] - s3);
                }
            }
            carry += run;
        },
        [&](const bf16x8 (&pa)[4], const LAS3 unsigned char* vb) { pv_tile(o, vb, c, pa); },
        [&](f32x16&, f32x16&) {},
        [&]() { return __any(carry <= SB_EXIT) == 0; });
    float one16[16];
#pragma unroll
    for (int r = 0; r < 16; ++r) one16[r] = 1.f;
    store_gated(L, c, o, one16, (const bf16_t*)(ws + WS_ZA) + ((size_t)b * SEQ + tw0) * 256 + h * 64, 256, (bf16_t*)(ws + WS_CAT) + ((size_t)b * SEQ + tw0) * DM + h * 64);
    __syncthreads();
}
}

namespace pg8 {
struct EpiCompress {
    static constexpr bool PERM = false, AFTER_DRAIN = true; static constexpr int NPRE = 0;
    const float* bias1;
    const float* b1;
    const bf16_t* w2t;
    bf16_t* outp;
    __device__ __forceinline__ void fused(f32x4 (&acc)[2][2][4][2], const Unit& u, int wr, int wc, int fr, int fq, PG8_LAS unsigned char* lds, int wid, int lane) const {
        constexpr int PITCH = 528;
#pragma unroll
        for (int bj = 0; bj < 2; ++bj)
#pragma unroll
            for (int n = 0; n < 2; ++n) {
                const int col = bj * HALF + wc * 32 + n * 16 + 4 * fq;
                const f32x4 bv = *(const f32x4*)(bias1 + col) + *(const f32x4*)(b1 + col);
#pragma unroll
                for (int ai = 0; ai < 2; ++ai)
#pragma unroll
                    for (int m = 0; m < 4; ++m) {
                        const int row = ai * HALF + wr * 64 + m * 16 + fr;
                        f32x4 v = acc[ai][bj][m][n] + bv;
#pragma unroll
                        for (int e = 0; e < 4; ++e) v[e] = v[e] / (1.f + __expf(-v[e]));
                        typedef unsigned u32x2_t __attribute__((ext_vector_type(2)));
                        u32x2_t w; w.x = pk2(v[0], v[1]); w.y = pk2(v[2], v[3]);
                        *(PG8_LAS u32x2_t*)(lds + row * PITCH + col * 2) = w;
                    }
            }
        asm volatile("s_waitcnt lgkmcnt(0)" ::: "memory"); __builtin_amdgcn_s_barrier(); asm volatile("" ::: "memory");
        typedef float f32x16 __attribute__((ext_vector_type(16)));
        const int r32 = lane & 31, hi = lane >> 5;
        f32x16 o0 = f32x16{}, o1 = f32x16{};
        bf16x8 wb0[16], wb1[16];
#pragma unroll
        for (int s = 0; s < 16; ++s) {
            wb0[s] = *(const bf16x8*)(w2t + (size_t)r32 * 256 + 16 * s + 8 * hi);
            wb1[s] = *(const bf16x8*)(w2t + (size_t)(32 + r32) * 256 + 16 * s + 8 * hi);
        }
#pragma unroll
        for (int s = 0; s < 16; ++s) {
            const bf16x8 a = *(const PG8_LAS bf16x8*)(lds + (wid * 32 + r32) * PITCH + (16 * s + 8 * hi) * 2);
            o0 = __builtin_amdgcn_mfma_f32_32x32x16_bf16(a, wb0[s], o0, 0, 0, 0);
            o1 = __builtin_amdgcn_mfma_f32_32x32x16_bf16(a, wb1[s], o1, 0, 0, 0);
        }
        asm volatile("s_waitcnt lgkmcnt(0)" ::: "memory");
#pragma unroll
        for (int r = 0; r < 16; ++r) {
            const int row = (r & 3) + 8 * (r >> 2) + 4 * hi;
            const bool pad = (wid * 32 + row) == 255;
            PG8_LAS bf16_t* sp = (PG8_LAS bf16_t*)(lds + (wid * 32 + row) * PITCH);
            sp[r32] = pad ? (bf16_t)0 : (bf16_t)f2bf(o0[r]);
            sp[32 + r32] = pad ? (bf16_t)0 : (bf16_t)f2bf(o1[r]);
        }
        asm volatile("s_waitcnt lgkmcnt(0)" ::: "memory");
        bf16_t* op = outp + ((size_t)u.pm * 256 + wid * 32) * 64;
#pragma unroll
        for (int it = 0; it < 4; ++it) {
            const int row = it * 8 + (lane >> 3), ch = lane & 7;
            const u32x4 v = *(const PG8_LAS u32x4*)(lds + (wid * 32 + row) * PITCH + ch * 16);
            *(u32x4*)(op + (size_t)row * 64 + ch * 8) = v;
        }
        asm volatile("s_waitcnt lgkmcnt(0)" ::: "memory"); __builtin_amdgcn_s_barrier(); asm volatile("" ::: "memory");
    }
};
}
__device__ __forceinline__ void flag_publish(unsigned* flag) {
    asm volatile("s_waitcnt vmcnt(0)" ::: "memory");
    __syncthreads();
    if (threadIdx.x == 0) { __threadfence(); __hip_atomic_store(flag, 1u, __ATOMIC_RELAXED, __HIP_MEMORY_SCOPE_AGENT); }
}
__device__ __forceinline__ void flag_wait2(unsigned* f0, unsigned* f1) {
    if (threadIdx.x == 0) {
        unsigned sp = 0;
        for (;;) {
            const unsigned a0 = __hip_atomic_load(f0, __ATOMIC_RELAXED, __HIP_MEMORY_SCOPE_AGENT), a1 = __hip_atomic_load(f1, __ATOMIC_RELAXED, __HIP_MEMORY_SCOPE_AGENT);
            if ((a0 != 0u) & (a1 != 0u)) break;
            __builtin_amdgcn_s_sleep(8); if (++sp > (1u << 22)) break;
        }
        __builtin_amdgcn_fence(__ATOMIC_ACQUIRE, "agent");
        asm volatile("s_waitcnt vmcnt(0)" ::: "memory");
    }
    __syncthreads();
}
__device__ void phase_work(const Params& p, int layer, unsigned char* ws, unsigned char* ldsg, PG8_LAS unsigned char* lds3, int wid0, int rep) {
    ws = opq(ws);
    unsigned* ctr = (unsigned*)(ws + WS_CTR) + layer * 64 + rep * 16;
    unsigned* flg = (unsigned*)(ws + WS_CTR) + 128 + layer * 64 + rep * 256;
    if (threadIdx.x == 0) *(volatile unsigned*)(ldsg + att::L_BT4KEY) = 0u;
    if (layer == 0) { float* ss = (float*)(ws + WS_SS); for (int i = blockIdx.x * NTHREADS + otid(wid0); i < MTOK; i += gridDim.x * NTHREADS) ss[i] = 0.f; }
    bool have_next = false; int k = 0;
    for (;; ++k) {
        TBEG(6, lds3, wid0);
        __syncthreads();
        if (!have_next) {
            if (threadIdx.x == 0) *(volatile unsigned*)(ldsg + att::L_NEXT + 4 * (k & 1)) = atomicAdd(ctr, 1u);
            __syncthreads();
        }
        const unsigned it = *(volatile unsigned*)(ldsg + att::L_NEXT + 4 * (k & 1));
        if (it >= (unsigned)N_ATT_UNITS) break;
        const int qslot = (k + 1) & 1;
        const unsigned code = c_unit_order[it];
        const int type = (int)(code >> 11), q = (code >> 5) & 63, x = code & 31;
        if (type == 2) {
            const int which = x >> 4;
            const int lw = layer * 2 + which;
            pg8::Gemm g{(const bf16_t*)(ws + (which ? WS_VC : WS_KC)), (const bf16_t*)(ws + WS_W1T) + (size_t)lw * 256 * 2048, BATCH * 2 * 256, 256, 2048, 1024, 2048};
            pg8::StaticOrder S; S.init(BATCH * 2 * 256, 256, 1 << 20, x & 15);
            pg8::Unit uu; S.next(0, uu);
            pg8::EpiCompress E{(const float*)(ws + WS_BIAS1) + lw * 256, p.cmp_b1 + lw * 256, (const bf16_t*)(ws + WS_W2T) + (size_t)lw * 64 * 256, (bf16_t*)(ws + WS_KCMP) + (size_t)which * BATCH * 2 * 256 * 64};
            TBEG(12, lds3, wid0);
            {
                const int tid_ = otid(wid0);
                const bf16_t* Kp = (const bf16_t*)(ws + (which ? WS_KWN : WS_KSL)) + ((size_t)uu.pm * SEQ + 8 * tid_) * 64;
                float mx2 = 0.f;
                for (int i = 0; i < 8; ++i) {
                    float s2 = 0.f;
#pragma unroll
                    for (int d8 = 0; d8 < 8; ++d8) {
                        const uint4 w = *(const uint4*)(Kp + i * 64 + d8 * 8);
                        const unsigned ww[4] = {w.x, w.y, w.z, w.w};
#pragma unroll
                        for (int e = 0; e < 4; ++e) { const float lo = __uint_as_float(ww[e] << 16), hi = __uint_as_float(ww[e] & 0xffff0000u); s2 += lo * lo + hi * hi; }
                    }
                    mx2 = fmaxf(mx2, s2);
                }
                float* tmx = (float*)(ldsg + 100000);
                tmx[tid_] = mx2;
                __syncthreads();
                if (tid_ < 64) { float m8 = 0.f; for (int k = 0; k < 8; ++k) m8 = fmaxf(m8, tmx[tid_ * 8 + k]); m8 = wave_max(m8); if (tid_ == 0) ((float*)(ws + WS_KMAX))[32 + which * 16 + uu.pm] = sqrtf(m8) * 1.01f; }
                __syncthreads();
            }
            pg8::gemm_phase<pg8::EpiCompress, pg8::StaticOrder, false, true>(lds3, g, S, E, wid0);
            flag_publish(flg + which * 16 + uu.pm); have_next = false;
            TEND(12, lds3, wid0);
        } else if (type == 3) {
            const int tid_ = otid(wid0);
            const int b = x >> 2, h = x & 3;
            const float* gf = (const float*)(ws + WS_GF);
            float* cfox = (float*)(ws + WS_CFOX) + ((size_t)(b * 4 + h)) * SEQ;
            const float fb = p.forget_b[layer * 4 + h];
            float lf[8]; double s = 0.0;
#pragma unroll
            for (int i = 0; i < 8; ++i) {
                const float v = gf[((size_t)b * SEQ + 8 * tid_ + i) * 32 + 24 + h] + fb;
                lf[i] = fminf(v, 0.f) - LN2 * __builtin_amdgcn_logf(1.f + __builtin_amdgcn_exp2f(-fabsf(v) * 1.4426950408889634f));
                s += (double)lf[i];
            }
            double* tsum = (double*)(ldsg + 100000);
            tsum[tid_] = s;
            __syncthreads();
            double run = 0.0;
            for (int k = 0; k < tid_; ++k) run += tsum[k];
#pragma unroll
            for (int i = 0; i < 8; ++i) { run += (double)lf[i]; cfox[8 * tid_ + i] = (float)run; }
            {
                const bf16_t* Kp = (const bf16_t*)(ws + WS_KCF) + ((size_t)(b * 4 + h) * SEQ + 8 * tid_) * 64;
                float mx2 = 0.f;
                for (int i = 0; i < 8; ++i) {
                    float s2 = 0.f;
#pragma unroll
                    for (int d8 = 0; d8 < 8; ++d8) {
                        const uint4 w = *(const uint4*)(Kp + i * 64 + d8 * 8);
                        const unsigned ww[4] = {w.x, w.y, w.z, w.w};
#pragma unroll
                        for (int e = 0; e < 4; ++e) { const float lo = __uint_as_float(ww[e] << 16), hi = __uint_as_float(ww[e] & 0xffff0000u); s2 += lo * lo + hi * hi; }
                    }
                    mx2 = fmaxf(mx2, s2);
                }
                __syncthreads();
                float* tmx = (float*)(ldsg + 100000);
                tmx[tid_] = mx2;
                __syncthreads();
                if (tid_ < 64) { float m8 = 0.f; for (int k = 0; k < 8; ++k) m8 = fmaxf(m8, tmx[tid_ * 8 + k]); m8 = wave_max(m8); if (tid_ == 0) ((float*)(ws + WS_KMAX))[b * 4 + h] = sqrtf(m8) * 1.01f; }
            }
            flag_publish(flg + 32 + x); have_next = false;
        } else if (type == 4) {
            TBEG(11, lds3, wid0);
            att::sb_unit(ws, ldsg, x >> 2, x & 3, q, wid0, ctr, qslot); have_next = true;
            TEND(11, lds3, wid0);
        } else if (type == 1) {
            flag_wait2(flg + (x), flg + 16 + (x));
            TEND(6, lds3, wid0);
            TBEG(14, lds3, wid0);
            att::nsa_unit(p, ws, ldsg, x >> 1, x & 1, q, wid0, ctr, qslot); have_next = true;
            TEND(14, lds3, wid0);
        } else {
            flag_wait2(flg + 32 + x, flg + 32 + x);
            TEND(6, lds3, wid0);
            TBEG(10, lds3, wid0);
            att::fox_unit(ws, ldsg, x >> 2, x & 3, q, wid0, ctr, qslot); have_next = true;
            TEND(10, lds3, wid0);
        }
    }
}

__global__ void __launch_bounds__(NTHREADS, 2) mega(Params p) {
    cg::grid_group grid = cg::this_grid();
    extern __shared__ __attribute__((aligned(16))) unsigned char lds[];
    PG8_LAS unsigned char* lds3 = (PG8_LAS unsigned char*)lds;
    const int wid0 = __builtin_amdgcn_readfirstlane((int)(threadIdx.x >> 6));
#if PROBE_TIME
    if (threadIdx.x == 0) *(volatile long long*)(lds + (157184 + 16)) = 0;
#endif
    if (threadIdx.x < 2) ((volatile LAS unsigned*)(lds3 + LDS_BAR_OFF))[threadIdx.x] = 0u;
    __syncthreads();
    const XcdBarrier xbar = xcd_barrier_post((unsigned*)(p.ws + WS_BAR), (volatile LAS unsigned*)(lds3 + LDS_BAR_OFF));

    if (blockIdx.x == 0) for (int i = threadIdx.x; i < 1024; i += NTHREADS) ((unsigned*)(p.ws + WS_CTR))[i] = 0u;
    TBEG(16, lds3, wid0);
    for (int rep_ = 0; rep_ < PROBE_P0; ++rep_) p0_weights(p, lds, wid0);
    TEND(16, lds3, wid0);
    TBEG(17, lds3, wid0);
    for (int rep_ = 0; rep_ < PROBE_CVT; ++rep_) phase_convert_x(p.x, (bf16_t*)(p.ws + WS_XB), (float*)(p.ws + WS_SS), wid0);
    TEND(17, lds3, wid0);
    if (p.out == nullptr) grid.sync();
    xcd_barrier(xbar);
    for (int layer = 0; layer < DEPTH; ++layer) {
        unsigned char* ws = opq(p.ws);
        bf16_t* xb = (bf16_t*)(ws + WS_XB); bf16_t* cat = (bf16_t*)(ws + WS_CAT); float* ss = (float*)(ws + WS_SS);
        {
            pg8::Gemm g{xb, (const bf16_t*)(ws + WS_WTIN) + (size_t)layer * NPAD * DM, MTOK, NPAD, DM, DM, DM};
            pg8::StaticOrder S; S.init(MTOK, NPAD, (int)gridDim.x, (int)blockIdx.x);
            pg8::EpiInProj E{ws, ss};
            TBEG(18, lds3, wid0);
            for (int rep_ = 0; rep_ < PROBE_INP; ++rep_) pg8::gemm_phase<pg8::EpiInProj, pg8::StaticOrder, true, true>(lds3, g, S, E, wid0);
            TEND(18, lds3, wid0);
        }
        xcd_barrier(xbar);
        TBEG(15, lds3, wid0);
        for (int rep_ = 0; rep_ < PROBE_ATT; ++rep_) { phase_work(p, layer, ws, lds, lds3, wid0, rep_); if (rep_ + 1 < PROBE_ATT) xcd_barrier(xbar); }
        TEND(15, lds3, wid0);
        TBEG(13, lds3, wid0);
        xcd_barrier(xbar);
        TEND(13, lds3, wid0);
        {
            pg8::Gemm g{cat, (const bf16_t*)(ws + WS_WTOUT) + (size_t)layer * DM * DM, MTOK, DM, DM, DM, DM};
            pg8::StaticOrder S; S.init(MTOK, DM, (int)gridDim.x, (int)blockIdx.x);
            TBEG(19, lds3, wid0);
            if (layer == 0) { pg8::EpiOutProj<true> E{p.x, xb, ss}; for (int rep_ = 0; rep_ < PROBE_OUT; ++rep_) pg8::gemm_phase<pg8::EpiOutProj<true>, pg8::StaticOrder, true, true>(lds3, g, S, E, wid0); }
            else { pg8::EpiOutProj<false> E{nullptr, xb, nullptr}; pg8::gemm_phase<pg8::EpiOutProj<false>, pg8::StaticOrder, true, true>(lds3, g, S, E, wid0); }
            TEND(19, lds3, wid0);
        }
        xcd_barrier(xbar);
    }
    for (int rep_ = 0; rep_ < PROBE_SYNC; ++rep_) xcd_barrier(xbar);
#if PROBE_TIME
    if (blockIdx.x == 0 && wid0 == 0) { const long long w_ = __builtin_amdgcn_readfirstlane((int)(*(volatile long long*)(lds + (157184 + 16)) >> 8)); const long long s_ = clock64(); while (((clock64() - s_) >> 8) < w_) __builtin_amdgcn_s_sleep(8); }
    __syncthreads();
#endif
    phase_final_norm((const bf16_t*)(p.ws + WS_XB), p.out, p.final_g, wid0);
}

extern "C" void kernel_launch(void* const* d_in, const int* in_sizes, int n_in, void* d_out, int out_size, void* d_ws, size_t ws_size, hipStream_t stream) {
    static int grid_blocks = 0;
    if (!grid_blocks) {
        if (ws_size < WS_END) { fprintf(stderr, "kernel_launch: workspace too small (%zu < %zu)\n", ws_size, (size_t)WS_END); grid_blocks = -1; return; }
        int dev = 0, cus = 0, per_cu = 0;
        (void)hipGetDevice(&dev);
        (void)hipDeviceGetAttribute(&cus, hipDeviceAttributeMultiprocessorCount, dev);
        (void)hipFuncSetAttribute((const void*)mega, hipFuncAttributeMaxDynamicSharedMemorySize, LDS_BYTES);
        (void)hipOccupancyMaxActiveBlocksPerMultiprocessor(&per_cu, mega, NTHREADS, LDS_BYTES);
        if (per_cu < 1) { fprintf(stderr, "kernel_launch: occupancy query says %d blocks/CU\n", per_cu); per_cu = 1; }
        grid_blocks = cus;
    }
    if (grid_blocks < 0) return;
    Params p{};
    p.x = (const float*)d_in[0]; p.norm_g = (const float*)d_in[1]; p.w_in = (const float*)d_in[2]; p.w_out = (const float*)d_in[3];
    p.forget_b = (const float*)d_in[4]; p.cmp_w1 = (const float*)d_in[5]; p.cmp_b1 = (const float*)d_in[6]; p.cmp_w2 = (const float*)d_in[7];
    p.cmp_pe = (const float*)d_in[8]; p.rel_bias = (const float*)d_in[9]; p.final_g = (const float*)d_in[10];
    p.out = (float*)d_out; p.ws = (unsigned char*)d_ws;
    (void)hipMemsetAsync((char*)d_ws + WS_BIAS1, 0, 4 * 256 * sizeof(float) + XCD_BAR_WORDS * sizeof(unsigned), stream);
    void* args[] = {&p};
    hipError_t e = hipLaunchCooperativeKernel((void*)mega, dim3(grid_blocks), dim3(NTHREADS), args, LDS_BYTES, stream);
    if (e != hipSuccess) fprintf(stderr, "cooperative launch failed: %s (grid %d)\n", hipGetErrorString(e), grid_blocks);
}
```
